# Optimizing an MI355X kernel written in HIP

```python
import jax, jax.numpy as jnp
from jax import lax
import numpy as np

D_MODEL = 1024
BATCH = 1
SEQ = 16384
DEPTH = 2

HEAD_DIM = 64
N_HEADS = D_MODEL // HEAD_DIM
N_SB_HEADS = N_HEADS // 2
N_MOBA_HEADS = N_HEADS - N_SB_HEADS
N_FOX_HEADS = N_HEADS
Q_BLOCK = 128
MOBA_BLOCK = 256
MOBA_TOPK = 3
ROPE_THETA = 10000.0
MEM_LEN = 256
XA_HEADS = 4
XA_HEAD_DIM = 64
XA_DIM = XA_HEADS * XA_HEAD_DIM
D_FF = 2816
CONV_WIDTH = 3
RMS_EPS = 1e-6
NEG_INF = -1e9
N_EVEN = (DEPTH + 1) // 2
N_ODD = DEPTH // 2

kernel_name = "hybrid_stickbreak_moba_fox_convffn"


def rmsnorm(x, g):
    xf = x.astype(jnp.float32)
    y = xf * lax.rsqrt(jnp.mean(xf * xf, axis=-1, keepdims=True) + RMS_EPS)
    return (y * g.astype(jnp.float32)).astype(x.dtype)


def rope(x, positions):
    half = HEAD_DIM // 2
    inv_freq = ROPE_THETA ** (-jnp.arange(half, dtype=jnp.float32) / half)
    ang = positions.astype(jnp.float32)[:, None, :, None] * inv_freq
    cos, sin = jnp.cos(ang), jnp.sin(ang)
    xf = x.astype(jnp.float32)
    x1, x2 = xf[..., :half], xf[..., half:]
    return jnp.concatenate([x1 * cos - x2 * sin, x2 * cos + x1 * sin], axis=-1).astype(x.dtype)


def to_chunks(a):
    B, H, S = a.shape[:3]
    a = a.reshape((B, H, S // Q_BLOCK, Q_BLOCK) + a.shape[3:])
    return jnp.moveaxis(a, 2, 0)


def from_chunks(o):
    n, B, H, qb, dh = o.shape
    return jnp.moveaxis(o, 0, 2).reshape(B, H, n * qb, dh)


def stick_breaking_attention(q, k, v):
    S, dh = q.shape[2], q.shape[3]
    scale = dh ** -0.5
    key_pos = jnp.arange(S)

    def block(args):
        qb, start = args
        z = jnp.einsum('bhtd,bhsd->bhts', qb, k).astype(jnp.float32) * scale
        qpos = start + jnp.arange(Q_BLOCK)
        past = key_pos[None, :] < qpos[:, None]
        log_beta = jax.nn.log_sigmoid(z)
        log_1mb = jnp.where(past, log_beta - z, 0.0)
        tail = lax.cumsum(log_1mb, axis=3, reverse=True) - log_1mb
        a = jnp.where(past, jnp.exp(log_beta + tail), 0.0)
        return jnp.einsum('bhts,bhsd->bhtd', a.astype(v.dtype), v)

    starts = jnp.arange(S // Q_BLOCK) * Q_BLOCK
    return from_chunks(lax.map(block, (to_chunks(q), starts)))


def moba_attention(q, k, v):
    B, H, S, dh = q.shape
    scale = dh ** -0.5
    nb = -(-S // MOBA_BLOCK)
    pad = nb * MOBA_BLOCK - S
    kb = jnp.pad(k, ((0, 0), (0, 0), (0, pad), (0, 0))).reshape(B, H, nb, MOBA_BLOCK, dh)
    vb = jnp.pad(v, ((0, 0), (0, 0), (0, pad), (0, 0))).reshape(B, H, nb, MOBA_BLOCK, dh)
    k_mean = jnp.mean(kb.astype(jnp.float32), axis=3)
    n_sel = min(MOBA_TOPK, nb)
    bi = jnp.arange(B)[:, None, None, None]
    hi = jnp.arange(H)[None, :, None, None]
    blk_ids = jnp.arange(nb)

    def block(args):
        qb, start = args
        own = start // MOBA_BLOCK
        qpos = start + jnp.arange(Q_BLOCK)
        gate = jnp.einsum('bhtd,bhnd->bhtn', qb.astype(jnp.float32), k_mean)
        gate = jnp.where(blk_ids < own, gate, NEG_INF)
        _, idx = lax.top_k(gate, n_sel)
        valid = jnp.arange(n_sel) < own
        kg = kb[bi, hi, idx]
        vg = vb[bi, hi, idx]
        s_sel = jnp.einsum('bhtd,bhtnkd->bhtnk', qb, kg).astype(jnp.float32) * scale
        s_sel = jnp.where(valid[:, None], s_sel, NEG_INF).reshape(B, H, Q_BLOCK, n_sel * MOBA_BLOCK)
        k_own = lax.dynamic_index_in_dim(kb, own, axis=2, keepdims=False)
        v_own = lax.dynamic_index_in_dim(vb, own, axis=2, keepdims=False)
        s_own = jnp.einsum('bhtd,bhkd->bhtk', qb, k_own).astype(jnp.float32) * scale
        own_pos = own * MOBA_BLOCK + jnp.arange(MOBA_BLOCK)
        s_own = jnp.where(own_pos[None, :] <= qpos[:, None], s_own, NEG_INF)
        p = jax.nn.softmax(jnp.concatenate([s_sel, s_own], axis=-1), axis=-1).astype(v.dtype)
        p_sel = p[..., :n_sel * MOBA_BLOCK].reshape(B, H, Q_BLOCK, n_sel, MOBA_BLOCK)
        p_own = p[..., n_sel * MOBA_BLOCK:]
        return (jnp.einsum('bhtnk,bhtnkd->bhtd', p_sel, vg)
                + jnp.einsum('bhtk,bhkd->bhtd', p_own, v_own))

    starts = jnp.arange(S // Q_BLOCK) * Q_BLOCK
    return from_chunks(lax.map(block, (to_chunks(q), starts)))


def forgetting_attention(q, k, v, log_f):
    S, dh = q.shape[2], q.shape[3]
    scale = dh ** -0.5
    key_pos = jnp.arange(S)
    c = lax.cumsum(log_f, axis=2)

    def block(args):
        qb, cb, start = args
        qpos = start + jnp.arange(Q_BLOCK)
        s = (jnp.einsum('bhtd,bhsd->bhts', qb, k).astype(jnp.float32) * scale
             + cb[..., None] - c[:, :, None, :])
        s = jnp.where(key_pos[None, :] <= qpos[:, None], s, NEG_INF)
        p = jax.nn.softmax(s, axis=-1).astype(v.dtype)
        return jnp.einsum('bhts,bhsd->bhtd', p, v)

    starts = jnp.arange(S // Q_BLOCK) * Q_BLOCK
    return from_chunks(lax.map(block, (to_chunks(q), to_chunks(c), starts)))


def split_heads(a, n_heads):
    B, S, _ = a.shape
    return a.reshape(B, S, n_heads, HEAD_DIM).transpose(0, 2, 1, 3)


def merge_heads(o):
    B, H, S, dh = o.shape
    return o.transpose(0, 2, 1, 3).reshape(B, S, H * dh)


def sb_moba_mixer(h, positions, w_in, w_out):
    qkv = h @ w_in
    q = split_heads(qkv[..., :D_MODEL], N_HEADS)
    k = split_heads(qkv[..., D_MODEL:2 * D_MODEL], N_HEADS)
    v = split_heads(qkv[..., 2 * D_MODEL:], N_HEADS)
    o_sb = stick_breaking_attention(q[:, :N_SB_HEADS], k[:, :N_SB_HEADS], v[:, :N_SB_HEADS])
    o_moba = moba_attention(rope(q[:, N_SB_HEADS:], positions),
                            rope(k[:, N_SB_HEADS:], positions), v[:, N_SB_HEADS:])
    return merge_heads(jnp.concatenate([o_sb, o_moba], axis=1)) @ w_out


def fox_mixer(h, w_in, b_f, w_out):
    proj = h @ w_in
    q = split_heads(proj[..., :D_MODEL], N_FOX_HEADS)
    k = split_heads(proj[..., D_MODEL:2 * D_MODEL], N_FOX_HEADS)
    v = split_heads(proj[..., 2 * D_MODEL:3 * D_MODEL], N_FOX_HEADS)
    f_logit = (proj[..., 3 * D_MODEL:] + b_f).astype(jnp.float32)
    log_f = jax.nn.log_sigmoid(f_logit).transpose(0, 2, 1)
    return merge_heads(forgetting_attention(q, k, v, log_f)) @ w_out


def memory_cross_attention(h, mem_h, w_q, w_kv, w_out):
    B, S, _ = h.shape
    M = mem_h.shape[1]
    q = (h @ w_q).reshape(B, S, XA_HEADS, XA_HEAD_DIM)
    kv = (mem_h @ w_kv).reshape(B, M, 2, XA_HEADS, XA_HEAD_DIM)
    k, v = kv[:, :, 0], kv[:, :, 1]
    s = jnp.einsum('bshd,bmhd->bhsm', q, k).astype(jnp.float32) * (XA_HEAD_DIM ** -0.5)
    p = jax.nn.softmax(s, axis=-1).astype(h.dtype)
    o = jnp.einsum('bhsm,bmhd->bshd', p, v).reshape(B, S, XA_DIM)
    return o @ w_out


def conv_ffn(h, w_up, conv_w, conv_b, w_down):
    S = h.shape[1]
    u = h @ w_up
    up = jnp.pad(u, ((0, 0), (CONV_WIDTH - 1, 0), (0, 0)))
    c = conv_b
    for i in range(CONV_WIDTH):
        c = c + up[:, i:i + S] * conv_w[i]
    gate, val = c[..., :D_FF], c[..., D_FF:]
    return (jax.nn.silu(gate) * val) @ w_down


def setup_inputs(seed: int = 0) -> dict:
    key = jax.random.key(seed)
    ks = jax.random.split(key, 24)
    nrm = lambda k, shape, s: jax.random.normal(k, shape, jnp.float32) * s
    D = D_MODEL
    positions = jnp.broadcast_to(jnp.arange(SEQ, dtype=jnp.int32)[None, :], (BATCH, SEQ))
    fox_b_f = (jnp.broadcast_to(jnp.linspace(1.0, 4.0, N_FOX_HEADS, dtype=jnp.float32), (N_ODD, N_FOX_HEADS))
               + nrm(ks[9], (N_ODD, N_FOX_HEADS), 0.1))
    return {
        "x": nrm(ks[0], (BATCH, SEQ, D), 1.0),
        "mem": nrm(ks[1], (BATCH, MEM_LEN, D), 1.0),
        "positions": positions,
        "norm_mix_g": 1.0 + nrm(ks[2], (DEPTH, D), 0.02),
        "norm_xa_g": 1.0 + nrm(ks[3], (DEPTH, D), 0.02),
        "norm_mem_g": 1.0 + nrm(ks[4], (DEPTH, D), 0.02),
        "norm_ffn_g": 1.0 + nrm(ks[5], (DEPTH, D), 0.02),
        "ab_w_in": nrm(ks[6], (N_EVEN, D, 3 * D), D ** -0.5),
        "ab_w_out": nrm(ks[7], (N_EVEN, D, D), D ** -0.5),
        "fox_w_in": nrm(ks[8], (N_ODD, D, 3 * D + N_FOX_HEADS), D ** -0.5),
        "fox_b_f": fox_b_f,
        "fox_w_out": nrm(ks[10], (N_ODD, D, D), D ** -0.5),
        "xa_w_q": nrm(ks[11], (DEPTH, D, XA_DIM), D ** -0.5),
        "xa_w_kv": nrm(ks[12], (DEPTH, D, 2 * XA_DIM), D ** -0.5),
        "xa_w_out": nrm(ks[13], (DEPTH, XA_DIM, D), XA_DIM ** -0.5),
        "ffn_w_up": nrm(ks[14], (DEPTH, D, 2 * D_FF), D ** -0.5),
        "ffn_conv_w": nrm(ks[15], (DEPTH, CONV_WIDTH, 2 * D_FF), CONV_WIDTH ** -0.5),
        "ffn_conv_b": nrm(ks[16], (DEPTH, 2 * D_FF), 0.02),
        "ffn_w_down": nrm(ks[17], (DEPTH, D_FF, D), D_FF ** -0.5),
        "final_norm_g": 1.0 + nrm(ks[18], (D,), 0.02),
    }


def reference(x, mem, positions, norm_mix_g, norm_xa_g, norm_mem_g, norm_ffn_g,
              ab_w_in, ab_w_out, fox_w_in, fox_b_f, fox_w_out,
              xa_w_q, xa_w_kv, xa_w_out, ffn_w_up, ffn_conv_w, ffn_conv_b, ffn_w_down,
              final_norm_g):
    h = x
    for layer in range(DEPTH):
        n = layer // 2
        hn = rmsnorm(h, norm_mix_g[layer])
        if layer % 2 == 0:
            h = h + sb_moba_mixer(hn, positions, ab_w_in[n], ab_w_out[n])
        else:
            h = h + fox_mixer(hn, fox_w_in[n], fox_b_f[n], fox_w_out[n])
        h = h + memory_cross_attention(rmsnorm(h, norm_xa_g[layer]), rmsnorm(mem, norm_mem_g[layer]),
                                       xa_w_q[layer], xa_w_kv[layer], xa_w_out[layer])
        h = h + conv_ffn(rmsnorm(h, norm_ffn_g[layer]), ffn_w_up[layer], ffn_conv_w[layer],
                         ffn_conv_b[layer], ffn_w_down[layer])
    return rmsnorm(h, final_norm_g)
```

```cpp
#include <hip/hip_runtime.h>
#include <hip/hip_cooperative_groups.h>
#include <cstdio>
#include <cstdint>
namespace cg = cooperative_groups;
namespace pg8 {
#define PG8_LAS __attribute__((address_space(3)))
typedef unsigned short bf16_t;
typedef short bf16x8 __attribute__((ext_vector_type(8)));
typedef float f32x4 __attribute__((ext_vector_type(4)));
typedef unsigned u32x4 __attribute__((ext_vector_type(4)));
constexpr int BM = 256, BK = 64, HALF = 128, HTB = HALF * BK * 2  , STAGE_BYTES = 8 * HTB, NXCD = 8, WGM = 8;

__host__ __device__ __forceinline__ int lds_byte(int r, int c) { const int st = (r >> 4) * 2 + (c >> 5), rr = r & 15, cc = c & 31, ob = rr * 64 + cc * 2; return st * 1024 + (ob ^ (((ob >> 9) & 1) << 5)); }
__host__ __device__ __forceinline__ void stage_rc(int b, int& R, int& C) { const int st = b / 1024, sb = b % 1024, swz = sb ^ (((sb >> 9) & 1) << 5); R = (st >> 1) * 16 + swz / 64; C = (st & 1) * 32 + (swz % 64) / 2; }
__host__ __device__ __forceinline__ int perm32(int rho) { const int n = rho >> 4, i = rho & 15; return 8 * (i >> 2) + 4 * n + (i & 3); }

struct Unit { int pm, pn; };
struct Gemm { const bf16_t* A; const bf16_t* Bt; int M, N, K; int a_w1, a_h, a_t; };

struct StaticOrder {
    int nM, nN, nwg, G, c;
    __host__ __device__ void init(int M, int N, int G_, int c_) { nM = M / BM; nN = N / BM; nwg = nM * nN; G = G_; c = c_; }
    __host__ __device__ bool next(int i, Unit& u) const {
        const long L = (long)i * G + c; if (L >= nwg) return false;
        int wgid = (int)L; { const int q = nwg / NXCD, r = nwg % NXCD, xcd = wgid % NXCD, off = wgid / NXCD; wgid = (xcd < r ? xcd * (q + 1) : r * (q + 1) + (xcd - r) * q) + off; }
        const int nig = WGM * nN, gid = wgid / nig, fm = gid * WGM, gsz = (nM - fm) < WGM ? (nM - fm) : WGM;
        u.pm = fm + ((wgid % nig) % gsz); u.pn = (wgid % nig) / gsz; return true;
    }
    __device__ __forceinline__ void a_ready(const Unit&) const {}
    __device__ __forceinline__ void done(const Unit&) const {}
};

typedef unsigned u32x2 __attribute__((ext_vector_type(2)));
__device__ __forceinline__ unsigned cvt_pk_bf16(float lo, float hi) { unsigned r; asm volatile("v_cvt_pk_bf16_f32 %0, %1, %2" : "=v"(r) : "v"(lo), "v"(hi)); return r; }
__device__ __forceinline__ void store4(bf16_t* p, f32x4 v) { u32x2 w; w.x = cvt_pk_bf16(v[0], v[1]); w.y = cvt_pk_bf16(v[2], v[3]); *(u32x2*)p = w; }
__device__ __forceinline__ void store8(bf16_t* p, f32x4 a, f32x4 b) { u32x4 w; w.x = cvt_pk_bf16(a[0], a[1]); w.y = cvt_pk_bf16(a[2], a[3]); w.z = cvt_pk_bf16(b[0], b[1]); w.w = cvt_pk_bf16(b[2], b[3]); *(u32x4*)p = w; }
__device__ __forceinline__ float rstd_of(const float* ssq, int row) { return rsqrtf(ssq[row] * (1.0f / 1024.0f) + 1e-6f); }
constexpr int SEQ = 16384;

struct EpiQKV0 {
    static constexpr bool PERM = false, AFTER_DRAIN = false;
    bf16_t* Q; size_t tstride; const float* ssq; const float* ropec; const float* ropes; float* kpart;
    __device__ __forceinline__ void operator()(const f32x4 (&acc)[2][2][4][2], const Unit& u, int wr, int wc, int fr, int fq) const {
        const int t = u.pn >> 2, pq = u.pn & 3;
        bf16_t* base = Q + (size_t)t * tstride;
        const bool rope = (t < 2) && (pq >= 2);
#pragma unroll
        for (int ai = 0; ai < 2; ++ai) {
            f32x4 ks00 = (f32x4){0.f, 0.f, 0.f, 0.f}, ks01 = ks00, ks10 = ks00, ks11 = ks00;
#pragma unroll
            for (int m = 0; m < 4; ++m) {
                const int row = u.pm * 256 + ai * 128 + wr * 64 + m * 16 + fr;
                const float rs = rstd_of(ssq, row);
#pragma unroll
                for (int bj = 0; bj < 2; ++bj) {
                    const int hcol = pq * 256 + bj * 128 + (wc >> 1) * 64;
                    const f32x4 v0 = acc[ai][bj][m][0] * rs, v1 = acc[ai][bj][m][1] * rs;
                    bf16_t* rp = base + (size_t)row * 1024 + hcol;
                    if (rope) {
                        const int i0 = 16 * (wc & 1) + 4 * fq;
                        const f32x4 c = *(const f32x4*)(ropec + (size_t)row * 32 + i0), s = *(const f32x4*)(ropes + (size_t)row * 32 + i0);
                        const f32x4 o1 = v0 * c - v1 * s, o2 = v1 * c + v0 * s;
                        store4(rp + i0, o1); store4(rp + 32 + i0, o2);
                        if (bj == 0) { ks00 += o1; ks01 += o2; } else { ks10 += o1; ks11 += o2; }
                    } else {
                        const int d0 = 32 * (wc & 1) + 4 * fq;
                        store4(rp + d0, v0); store4(rp + d0 + 16, v1);
                    }
                }
            }
            if (rope && t == 1) {
#define KSRED(s_, bj_, n_) do { f32x4 s = s_; _Pragma("unroll") for (int o = 1; o < 16; o <<= 1) { s[0] += __shfl_xor(s[0], o); s[1] += __shfl_xor(s[1], o); s[2] += __shfl_xor(s[2], o); s[3] += __shfl_xor(s[3], o); } \
                if (fr == 0) { const int h8 = (pq - 2) * 4 + (bj_) * 2 + (wc >> 1); *(f32x4*)(kpart + (((size_t)h8 * 64 + u.pm) * 4 + ai * 2 + wr) * 64 + 32 * (n_) + 16 * (wc & 1) + 4 * fq) = s; } } while (0)
                KSRED(ks00, 0, 0); KSRED(ks01, 0, 1); KSRED(ks10, 1, 0); KSRED(ks11, 1, 1);
#undef KSRED
            }
        }
    }
};

struct EpiBf {
    static constexpr bool PERM = true, AFTER_DRAIN = false;
    bf16_t* O; int ldc; const float* ssq; int split_tiles; size_t split_stride; float* logf; const float* bfg; unsigned* kmx;
    __device__ __forceinline__ void operator()(const f32x4 (&acc)[2][2][4][2], const Unit& u, int wr, int wc, int fr, int fq) const {
        int pn = u.pn; bf16_t* base = O; int t = 0;
        if (split_tiles) { t = pn / split_tiles; pn -= t * split_tiles; base += (size_t)t * split_stride; }
        if (logf && t == 3) {
            if (wc == 0 && fq < 2) {
#pragma unroll
                for (int ai = 0; ai < 2; ++ai)
#pragma unroll
                    for (int m = 0; m < 4; ++m) { const int row = u.pm * 256 + ai * 128 + wr * 64 + m * 16 + fr; const float rs = rstd_of(ssq, row);
#pragma unroll
                        for (int n = 0; n < 2; ++n)
#pragma unroll
                            for (int j = 0; j < 4; ++j) { const int h = 8 * fq + 4 * n + j; const float x = acc[ai][0][m][n][j] * rs + bfg[h];
                                logf[(size_t)h * SEQ + row] = fminf(x, 0.f) - log1pf(expf(-fabsf(x))); } }
            }
            return;
        }
        const bool domax = (kmx != nullptr) && (t == 1);
        float mx0 = 0.f, mx1 = 0.f;
#pragma unroll
        for (int ai = 0; ai < 2; ++ai)
#pragma unroll
            for (int m = 0; m < 4; ++m) { const int row = u.pm * 256 + ai * 128 + wr * 64 + m * 16 + fr; const float rs = ssq ? rstd_of(ssq, row) : 1.0f;
                bf16_t* rp = base + (size_t)row * ldc + pn * 256 + wc * 32 + 8 * fq;
#pragma unroll
                for (int bj = 0; bj < 2; ++bj) { const f32x4 v0 = acc[ai][bj][m][0] * rs, v1 = acc[ai][bj][m][1] * rs; store8(rp + bj * 128, v0, v1);
                    if (domax) { float q = (v0[0] * v0[0] + v0[1] * v0[1]) + (v0[2] * v0[2] + v0[3] * v0[3]) + (v1[0] * v1[0] + v1[1] * v1[1]) + (v1[2] * v1[2] + v1[3] * v1[3]);
                        q += __shfl_xor(q, 16); q += __shfl_xor(q, 32); if (bj == 0) mx0 = fmaxf(mx0, q); else mx1 = fmaxf(mx1, q); } }
            }
        if (domax) {
#pragma unroll
            for (int o = 1; o < 16; o <<= 1) { mx0 = fmaxf(mx0, __shfl_xor(mx0, o)); mx1 = fmaxf(mx1, __shfl_xor(mx1, o)); }
            if (fr == 0 && fq == 0) { const int h0 = pn * 4 + (wc >> 1);
                atomicMax(kmx + (h0 * 2 + (wc & 1)), __float_as_uint(mx0)); atomicMax(kmx + ((h0 + 2) * 2 + (wc & 1)), __float_as_uint(mx1)); }
        }
    }
};

struct EpiRes {
    static constexpr bool PERM = false, AFTER_DRAIN = false;
    const float* Hin; float* Hout; bf16_t* XB; float* ssq; float sc;
    __device__ __forceinline__ void operator()(const f32x4 (&acc)[2][2][4][2], const Unit& u, int wr, int wc, int fr, int fq) const {
#pragma unroll
        for (int ai = 0; ai < 2; ++ai)
#pragma unroll
            for (int m = 0; m < 4; ++m) { const int row = u.pm * 256 + ai * 128 + wr * 64 + m * 16 + fr; float sq = 0.f;
                const size_t off = (size_t)row * 1024 + u.pn * 256 + wc * 32 + 4 * fq;
#pragma unroll
                for (int bj = 0; bj < 2; ++bj)
#pragma unroll
                    for (int n = 0; n < 2; ++n) { const size_t o = off + bj * 128 + n * 16; const f32x4 h = *(const f32x4*)(Hin + o) + acc[ai][bj][m][n] * sc;
                        *(f32x4*)(Hout + o) = h; if (XB) store4(XB + o, h); sq += (h[0] * h[0] + h[1] * h[1]) + (h[2] * h[2] + h[3] * h[3]); }
                sq += __shfl_xor(sq, 16); sq += __shfl_xor(sq, 32);
                if (fq == 0) __hip_atomic_fetch_add(ssq + row, sq, __ATOMIC_RELAXED, __HIP_MEMORY_SCOPE_AGENT);
            }
    }
};

__device__ __forceinline__ float dpp_ror1(float x) { float r; asm volatile("s_nop 1\n\tv_mov_b32_dpp %0, %1 row_ror:1 row_mask:0xf bank_mask:0xf" : "=v"(r) : "v"(x)); return r; }
__device__ __forceinline__ float dpp_ror2(float x) { float r; asm volatile("s_nop 1\n\tv_mov_b32_dpp %0, %1 row_ror:2 row_mask:0xf bank_mask:0xf" : "=v"(r) : "v"(x)); return r; }
struct EpiUpConv {
    static constexpr bool PERM = true, AFTER_DRAIN = false;
    bf16_t* ACT; const float* ssq; const float* cw; const float* cb;
    __device__ __forceinline__ void operator()(const f32x4 (&acc)[2][2][4][2], const Unit& u, int wr, int wc, int fr, int fq) const {
        const int g0 = 252 * u.pm - 2 + 126 * wr + fr;
        float rs[8];
#pragma unroll
        for (int q = 0; q < 8; ++q) { int r = g0 + 16 * q; r = r < 0 ? 0 : (r > SEQ - 1 ? SEQ - 1 : r); rs[q] = rstd_of(ssq, r); }
#pragma unroll
        for (int n = 0; n < 2; ++n) {
            const int col = 128 * u.pn + 32 * wc + 8 * fq + 4 * n;
            const f32x4 wg0 = *(const f32x4*)(cw + col), wg1 = *(const f32x4*)(cw + 5632 + col), wg2 = *(const f32x4*)(cw + 2 * 5632 + col), bg = *(const f32x4*)(cb + col);
            const f32x4 wv0 = *(const f32x4*)(cw + 2816 + col), wv1 = *(const f32x4*)(cw + 5632 + 2816 + col), wv2 = *(const f32x4*)(cw + 2 * 5632 + 2816 + col), bv = *(const f32x4*)(cb + 2816 + col);
            f32x4 pg = (f32x4){0.f, 0.f, 0.f, 0.f}, pv = (f32x4){0.f, 0.f, 0.f, 0.f};
#pragma unroll
            for (int q = 0; q < 8; ++q) {
                const f32x4 ug = acc[q >> 2][0][q & 3][n] * rs[q], uv = acc[q >> 2][1][q & 3][n] * rs[q];
                f32x4 res;
#pragma unroll
                for (int j = 0; j < 4; ++j) {
                    const float ga1 = dpp_ror1(ug[j]), gb1 = dpp_ror1(pg[j]), ga2 = dpp_ror2(ug[j]), gb2 = dpp_ror2(pg[j]);
                    const float va1 = dpp_ror1(uv[j]), vb1 = dpp_ror1(pv[j]), va2 = dpp_ror2(uv[j]), vb2 = dpp_ror2(pv[j]);
                    const float g1 = fr >= 1 ? ga1 : gb1, g2 = fr >= 2 ? ga2 : gb2, v1 = fr >= 1 ? va1 : vb1, v2 = fr >= 2 ? va2 : vb2;
                    const float cgv = bg[j] + wg0[j] * g2 + wg1[j] * g1 + wg2[j] * ug[j];
                    const float cvv = bv[j] + wv0[j] * v2 + wv1[j] * v1 + wv2[j] * uv[j];
                    res[j] = cgv * __builtin_amdgcn_rcpf(1.0f + __builtin_amdgcn_exp2f(-1.44269504f * cgv)) * cvv;
                }
                pg = ug; pv = uv;
                const int row = g0 + 16 * q;
                if ((q > 0 || fr >= 2) && row < SEQ) store4(ACT + (size_t)row * 2816 + col, res);
            }
        }
    }
};
template <class Epi, class Sched, bool ALIGN_EPI = false, bool SP2 = false>
__device__ __forceinline__ void gemm_phase(PG8_LAS unsigned char* lds, const Gemm g, const Sched& S, const Epi& E) {
    int tid_ = threadIdx.x; asm volatile("" : "+v"(tid_)); const int tid = tid_, wid = __builtin_amdgcn_readfirstlane(tid >> 6), lane = tid & 63, wr = wid >> 2, wc = wid & 3, fr = lane & 15, fq = lane >> 4;
    const int K = g.K, nt = K / BK;
    unsigned voffA[2], voffB[2];
#pragma unroll
    for (int i = 0; i < 2; ++i) { int R, C; stage_rc(tid * 16 + i * 8192, R, C); const int Rb = Epi::PERM ? ((R & ~31) + perm32(R & 31)) : R;
        voffA[i] = (unsigned)(((R >= 64 ? g.a_w1 : 0) + (R & 63)) * K + C) * 2u; voffB[i] = (unsigned)(Rb * K + C) * 2u; }
    const size_t kstep = (size_t)(BK * 2);
    const size_t hstep = (size_t)HALF * K * 2;
    const size_t tstep = 2 * hstep; const size_t hstepA = (size_t)g.a_h * K * 2, tstepA = (size_t)g.a_t * K * 2;
    const unsigned ldsw = (unsigned)wid * 1024u;
    const int aoff = lds_byte(wr * 64 + fr, fq * 8), boff = lds_byte(wc * 32 + fr, fq * 8);
#define PG8_SA(b, h) (((b) * 2 + (h)) * HTB)
#define PG8_SB(b, h) ((4 + (b) * 2 + (h)) * HTB)
#define PG8_STAGE(bufoff, gbase, voff) do { _Pragma("unroll") for (int _i = 0; _i < 2; ++_i) \
        __builtin_amdgcn_global_load_lds((const unsigned*)((const char*)(gbase) + (voff)[_i]), (PG8_LAS unsigned*)(lds + (bufoff) + ldsw + _i * 8192), 16, 0, 0); } while (0)
#define PG8_LDA(dst, b, h) do { _Pragma("unroll") for (int m = 0; m < 4; ++m) _Pragma("unroll") for (int k = 0; k < 2; ++k) dst[m][k] = *(const PG8_LAS bf16x8*)(lds + PG8_SA(b, h) + aoff + m * 2048 + k * 1024); } while (0)
#define PG8_LDB(dst, b, h) do { _Pragma("unroll") for (int n = 0; n < 2; ++n) _Pragma("unroll") for (int k = 0; k < 2; ++k) dst[n][k] = *(const PG8_LAS bf16x8*)(lds + PG8_SB(b, h) + boff + n * 2048 + k * 1024); } while (0)
#define PG8_MMA(ai, bj, At, Bt) do { __builtin_amdgcn_s_setprio(1); _Pragma("unroll") for (int m = 0; m < 4; ++m) _Pragma("unroll") for (int n = 0; n < 2; ++n) _Pragma("unroll") for (int k = 0; k < 2; ++k) \
        acc[ai][bj][m][n] = __builtin_amdgcn_mfma_f32_16x16x32_bf16(Bt[n][k], At[m][k], acc[ai][bj][m][n], 0, 0, 0); __builtin_amdgcn_s_setprio(0); } while (0)
#define PG8_WAIT_V(n) asm volatile("s_waitcnt vmcnt(" #n ")" ::: "memory")
#define PG8_WAIT_L(n) asm volatile("s_waitcnt lgkmcnt(" #n ")" ::: "memory")
#define PG8_BAR __builtin_amdgcn_s_barrier()
#define PG8_SCHED __builtin_amdgcn_sched_barrier(0)
    Unit cur, nxt; int ui = 0;
    if (!S.next(0, cur)) return;
    f32x4 acc[2][2][4][2];
#pragma unroll
    for (int a = 0; a < 2; ++a)
#pragma unroll
        for (int b = 0; b < 2; ++b)
#pragma unroll
            for (int m = 0; m < 4; ++m)
#pragma unroll
                for (int n = 0; n < 2; ++n) acc[a][b][m][n] = (f32x4){0.f, 0.f, 0.f, 0.f};
    bf16x8 At[4][2], B0[2][2], B1[2][2];
    const char* cA = (const char*)g.A + (size_t)cur.pm * tstepA; const char* cB = (const char*)g.Bt + (size_t)cur.pn * tstep;
    S.a_ready(cur);
    if constexpr (SP2) {
        PG8_STAGE(PG8_SB(0, 0), cB, voffB); PG8_STAGE(PG8_SB(0, 1), cB + hstep, voffB); PG8_STAGE(PG8_SA(0, 0), cA, voffA); PG8_STAGE(PG8_SA(0, 1), cA + hstepA, voffA);
        if (wr == 1) PG8_BAR;
        PG8_WAIT_V(2); PG8_BAR;
        PG8_STAGE(PG8_SB(1, 0), cB + kstep, voffB); PG8_STAGE(PG8_SA(1, 0), cA + kstep, voffA); PG8_STAGE(PG8_SB(1, 1), cB + hstep + kstep, voffB);
        PG8_WAIT_V(6); PG8_BAR;
    } else {
        PG8_STAGE(PG8_SB(0, 0), cB, voffB); PG8_STAGE(PG8_SA(0, 0), cA, voffA); PG8_STAGE(PG8_SB(0, 1), cB + hstep, voffB); PG8_STAGE(PG8_SA(0, 1), cA + hstepA, voffA);
        if (wr == 1) PG8_BAR;
        PG8_WAIT_V(4); PG8_BAR;
        PG8_STAGE(PG8_SB(1, 0), cB + kstep, voffB); PG8_STAGE(PG8_SA(1, 0), cA + kstep, voffA); PG8_STAGE(PG8_SB(1, 1), cB + hstep + kstep, voffB);
        PG8_WAIT_V(6); PG8_BAR;
    }
    for (;;) {
        const bool has_next = S.next(ui + 1, nxt);
        const char* nA = has_next ? (const char*)g.A + (size_t)nxt.pm * tstepA : cA; const char* nB = has_next ? (const char*)g.Bt + (size_t)nxt.pn * tstep : cB;
        for (int t = 0; t < nt; t += 2) {
            const bool last = (t == nt - 2);
            const char* a1 = cA + (size_t)(t + 1) * kstep;
            const char* a2 = last ? nA : cA + (size_t)(t + 2) * kstep; const char* b2 = last ? nB : cB + (size_t)(t + 2) * kstep;
            const char* a3 = a2 + kstep; const char* b3 = b2 + kstep;
            if (last && has_next) S.a_ready(nxt);
            if constexpr (SP2) {
            PG8_LDB(B0, 0, 0); PG8_LDB(B1, 0, 1); PG8_SCHED; PG8_LDA(At, 0, 0); PG8_STAGE(PG8_SA(1, 1), a1 + hstepA, voffA);
            PG8_WAIT_V(8); PG8_WAIT_L(0); PG8_BAR; PG8_MMA(0, 0, At, B0); PG8_MMA(0, 1, At, B1); PG8_BAR; PG8_SCHED;
            PG8_LDA(At, 0, 1); PG8_STAGE(PG8_SB(0, 0), b2, voffB); PG8_STAGE(PG8_SB(0, 1), b2 + hstep, voffB); PG8_STAGE(PG8_SA(0, 0), a2, voffA);
            PG8_WAIT_V(8); PG8_WAIT_L(0); PG8_BAR; PG8_MMA(1, 0, At, B0); PG8_MMA(1, 1, At, B1); PG8_BAR; PG8_SCHED;
            PG8_LDB(B0, 1, 0); PG8_LDB(B1, 1, 1); PG8_SCHED; PG8_LDA(At, 1, 0); PG8_STAGE(PG8_SA(0, 1), a2 + hstepA, voffA);
            PG8_WAIT_V(8); PG8_WAIT_L(0); PG8_BAR; PG8_MMA(0, 0, At, B0); PG8_MMA(0, 1, At, B1); PG8_BAR; PG8_SCHED;
            PG8_LDA(At, 1, 1); PG8_STAGE(PG8_SB(1, 0), b3, voffB); PG8_STAGE(PG8_SB(1, 1), b3 + hstep, voffB); PG8_STAGE(PG8_SA(1, 0), a3, voffA);
            PG8_WAIT_V(8); PG8_WAIT_L(0); PG8_BAR; PG8_MMA(1, 0, At, B0); PG8_MMA(1, 1, At, B1); PG8_BAR; PG8_SCHED;
            } else {
            PG8_LDB(B0, 0, 0); PG8_SCHED; PG8_LDA(At, 0, 0); PG8_STAGE(PG8_SA(1, 1), a1 + hstepA, voffA);
            PG8_WAIT_L(8); PG8_BAR; PG8_WAIT_L(0); PG8_MMA(0, 0, At, B0); PG8_BAR; PG8_SCHED;
            PG8_LDB(B1, 0, 1); PG8_STAGE(PG8_SB(0, 0), b2, voffB);
            PG8_BAR; PG8_WAIT_L(0); PG8_MMA(0, 1, At, B1); PG8_BAR;
            PG8_LDA(At, 0, 1); PG8_STAGE(PG8_SA(0, 0), a2, voffA);
            PG8_BAR; PG8_WAIT_L(0); PG8_MMA(1, 0, At, B0); PG8_BAR; PG8_SCHED;
            PG8_STAGE(PG8_SB(0, 1), b2 + hstep, voffB);
            PG8_WAIT_V(6); PG8_BAR; PG8_MMA(1, 1, At, B1); PG8_BAR;
            PG8_LDB(B0, 1, 0); PG8_SCHED; PG8_LDA(At, 1, 0); PG8_STAGE(PG8_SA(0, 1), a2 + hstepA, voffA);
            PG8_WAIT_L(8); PG8_BAR; PG8_WAIT_L(0); PG8_MMA(0, 0, At, B0); PG8_BAR; PG8_SCHED;
            PG8_LDB(B1, 1, 1); PG8_STAGE(PG8_SB(1, 0), b3, voffB);
            PG8_BAR; PG8_WAIT_L(0); PG8_MMA(0, 1, At, B1); PG8_BAR;
            PG8_LDA(At, 1, 1); PG8_STAGE(PG8_SA(1, 0), a3, voffA);
            PG8_BAR; PG8_WAIT_L(0); PG8_MMA(1, 0, At, B0); PG8_BAR; PG8_SCHED;
            PG8_STAGE(PG8_SB(1, 1), b3 + hstep, voffB);
            PG8_WAIT_V(6); PG8_BAR; PG8_MMA(1, 1, At, B1); PG8_BAR;
            }
        }
        if constexpr (ALIGN_EPI) { if (wr == 0) PG8_BAR; }
        if constexpr (!Epi::AFTER_DRAIN) { E(acc, cur, wr, wc, fr, fq); S.done(cur); }
        if (!has_next) break;
#pragma unroll
        for (int a = 0; a < 2; ++a)
#pragma unroll
            for (int b = 0; b < 2; ++b)
#pragma unroll
                for (int m = 0; m < 4; ++m)
#pragma unroll
                    for (int n = 0; n < 2; ++n) acc[a][b][m][n] = (f32x4){0.f, 0.f, 0.f, 0.f};
        cur = nxt; cA = nA; cB = nB; ++ui;
        if constexpr (ALIGN_EPI) { if (wr == 1) PG8_BAR; }
    }
    PG8_WAIT_V(0);
    if constexpr (!ALIGN_EPI) { if (wr == 0) PG8_BAR; }
    PG8_BAR;
    if constexpr (Epi::AFTER_DRAIN) { E.fused(acc, cur, wr, wc, fr, fq, lds, wid, lane); S.done(cur); }
#undef PG8_SA
#undef PG8_SB
#undef PG8_STAGE
#undef PG8_LDA
#undef PG8_LDB
#undef PG8_MMA
#undef PG8_WAIT_V
#undef PG8_WAIT_L
#undef PG8_BAR
#undef PG8_SCHED
}
}
namespace att {
#define LAS __attribute__((address_space(3)))
using pg8::bf16_t; using pg8::bf16x8; using pg8::f32x4; using pg8::u32x4; using pg8::SEQ;
typedef float f32x16 __attribute__((ext_vector_type(16)));
constexpr int KB_BYTES = 8192, VT_STRIDE = 144, VT_BYTES = 64 * VT_STRIDE, BUF_BYTES = KB_BYTES + VT_BYTES + 256;
constexpr int VOTE_OFF = 3 * BUF_BYTES, KM_OFF = 57344;
constexpr float LOG2E = 1.4426950408889634f, C2 = 0.125f * 1.4426950408889634f;
enum { M_SB = 0, M_MOBA = 1, M_FOX = 2, M_XA = 3 };
__device__ __forceinline__ bf16x8 pack8(const f32x16& p, int b) {
    u32x4 w; w.x = pg8::cvt_pk_bf16(p[b + 0], p[b + 1]); w.y = pg8::cvt_pk_bf16(p[b + 2], p[b + 3]); w.z = pg8::cvt_pk_bf16(p[b + 4], p[b + 5]); w.w = pg8::cvt_pk_bf16(p[b + 6], p[b + 7]);
    return __builtin_bit_cast(bf16x8, w);
}
__device__ __forceinline__ float bf2f(short s) { return __uint_as_float(((unsigned)(unsigned short)s) << 16); }

struct AttnArgs { const bf16_t* Q; int ldq; const bf16_t* K; const bf16_t* V; int ldkv; bf16_t* O; int ldo; const float* cf; float kmax2; const float* kpart; int* sel; float* lse; };

template <int MODE>
__device__ __forceinline__ void attn_unit(LAS unsigned char* lds, const AttnArgs& A, int qb) {
    int tid_ = threadIdx.x; asm volatile("" : "+v"(tid_)); const int tid = tid_, lane = tid & 63, wid = __builtin_amdgcn_readfirstlane(tid >> 6), r32 = lane & 31, hi = lane >> 5;
    const int q0 = qb * 256, w0 = q0 + wid * 32, row = w0 + r32;
    bf16x8 qr[4];
#pragma unroll
    for (int d0 = 0; d0 < 4; ++d0) qr[d0] = *(const bf16x8*)(A.Q + (size_t)row * A.ldq + d0 * 16 + hi * 8);
    int i1 = -1, i2 = -1, i3 = -1; unsigned long long wmask = 0ull;
    if (MODE == M_MOBA) {
        const int own = qb;
        LAS float* km = (LAS float*)(lds + KM_OFF);
        {
            float kp_[8][4];
#pragma unroll
            for (int k = 0; k < 8; ++k) { const int idx = tid + 512 * k; const bool ok = idx < own * 64; const float* p = A.kpart + (size_t)((ok ? idx : 0) >> 6) * 256 + (idx & 63);
                kp_[k][0] = p[0]; kp_[k][1] = p[64]; kp_[k][2] = p[128]; kp_[k][3] = p[192]; }
#pragma unroll
            for (int k = 0; k < 8; ++k) { const int idx = tid + 512 * k; if (idx < own * 64) km[idx] = ((kp_[k][0] + kp_[k][1]) + (kp_[k][2] + kp_[k][3])) * (1.0f / 256.0f); }
        }
        __syncthreads();
        float qf[32];
#pragma unroll
        for (int d0 = 0; d0 < 4; ++d0)
#pragma unroll
            for (int e = 0; e < 8; ++e) qf[d0 * 8 + e] = bf2f(qr[d0][e]);
        float v1 = -INFINITY, v2 = -INFINITY, v3 = -INFINITY;
#pragma unroll 4
        for (int j = 0; j < own; ++j) {
            float g = 0.f;
#pragma unroll
            for (int d0 = 0; d0 < 4; ++d0) { const f32x4 a = *(const LAS f32x4*)(km + j * 64 + d0 * 16 + hi * 8), b = *(const LAS f32x4*)(km + j * 64 + d0 * 16 + hi * 8 + 4);
                g += (qf[d0 * 8 + 0] * a[0] + qf[d0 * 8 + 1] * a[1]) + (qf[d0 * 8 + 2] * a[2] + qf[d0 * 8 + 3] * a[3]) + (qf[d0 * 8 + 4] * b[0] + qf[d0 * 8 + 5] * b[1]) + (qf[d0 * 8 + 6] * b[2] + qf[d0 * 8 + 7] * b[3]); }
            const float go = __shfl_xor(g, 32); g = hi ? (go + g) : (g + go);
            if (g > v1) { v3 = v2; i3 = i2; v2 = v1; i2 = i1; v1 = g; i1 = j; } else if (g > v2) { v3 = v2; i3 = i2; v2 = g; i2 = j; } else if (g > v3) { v3 = g; i3 = j; }
        }
        if (hi == 0) { typedef int i32x4 __attribute__((ext_vector_type(4))); *(i32x4*)(A.sel + (size_t)row * 4) = (i32x4){i1, i2, i3, 0}; }
    }
    float qb2 = 0.f, cq2 = 0.f;
    if (MODE == M_FOX) {
        float s = 0.f;
#pragma unroll
        for (int d0 = 0; d0 < 4; ++d0)
#pragma unroll
            for (int e = 0; e < 8; ++e) { const float x = bf2f(qr[d0][e]); s += x * x; }
        s += __shfl_xor(s, 32);
        qb2 = sqrtf(s * A.kmax2) * C2 * 1.01f;
        cq2 = A.cf[row] * LOG2E;
    }
    const int NT = (MODE == M_XA || MODE == M_MOBA) ? 4 : (q0 / 64 + 4);
    f32x16 o0, o1;
#pragma unroll
    for (int r = 0; r < 16; ++r) { o0[r] = 0.f; o1[r] = 0.f; }
    float m_run = -1e30f, l_run = 0.f, T = 0.f;
    u32x4 k1 = (u32x4){0u, 0u, 0u, 0u}, v1 = k1, k2 = k1, v2 = k1, k3 = k1, v3 = k1; float c1 = 0.f, c2 = 0.f, c3 = 0.f;
#define KEY0(i) ((MODE == M_XA) ? 64 * (i) : (MODE == M_MOBA) ? ((i) < 4 ? q0 + 64 * (i) : 256 * (((i) - 4) >> 2) + 64 * (((i) - 4) & 3)) : (q0 + 192 - 64 * (i)))
#define LOADT(i, kreg, vreg, creg) do { const int k0_ = KEY0(i); kreg = *(const u32x4*)(A.K + (size_t)(k0_ + lane) * A.ldkv + wid * 8); vreg = *(const u32x4*)(A.V + (size_t)(k0_ + lane) * A.ldkv + wid * 8); \
        if (MODE == M_FOX) { if (tid < 64) creg = A.cf[k0_ + tid] * LOG2E; } } while (0)
#define STORET(b, kreg, vreg, creg) do { LAS unsigned char* bb_ = lds + (b) * BUF_BYTES; *(LAS u32x4*)(bb_ + wid * 1024 + lane * 16) = kreg; \
        LAS unsigned short* vt_ = (LAS unsigned short*)(bb_ + KB_BYTES + (8 * wid) * VT_STRIDE + lane * 2); \
        vt_[0 * 72] = (unsigned short)(vreg.x & 0xffffu); vt_[1 * 72] = (unsigned short)(vreg.x >> 16); vt_[2 * 72] = (unsigned short)(vreg.y & 0xffffu); vt_[3 * 72] = (unsigned short)(vreg.y >> 16); \
        vt_[4 * 72] = (unsigned short)(vreg.z & 0xffffu); vt_[5 * 72] = (unsigned short)(vreg.z >> 16); vt_[6 * 72] = (unsigned short)(vreg.w & 0xffffu); vt_[7 * 72] = (unsigned short)(vreg.w >> 16); \
        if (MODE == M_FOX) { if (tid < 64) ((LAS float*)(bb_ + KB_BYTES + VT_BYTES))[tid] = creg; } } while (0)
    LOADT(0, k1, v1, c1); if (NT > 1) LOADT(1, k2, v2, c2); if (NT > 2) LOADT(2, k3, v3, c3);
    STORET(0, k1, v1, c1);
    __syncthreads();
    const int kperm = (r32 & ~15) | (r32 & 3) | ((r32 & 4) << 1) | ((r32 & 8) >> 1);
    bool prev_active = false; int prevbuf = 0; bf16x8 pkP0 = (bf16x8){0, 0, 0, 0, 0, 0, 0, 0}, pkP1 = pkP0, pkP2 = pkP0, pkP3 = pkP0;
    for (int i0 = 0; i0 < NT; i0 += 3) {
        { const int i = i0 + 0; if (i >= NT) break;
        const int key0 = KEY0(i);
        if (i + 3 < NT) LOADT(i + 3, k1, v1, c1);
        LAS unsigned char* buf = lds + 0 * BUF_BYTES;
        bool active;
        if (MODE == M_XA) active = true;
        else if (MODE == M_MOBA) active = (i < 4) ? (key0 <= w0 + 31) : (((wmask >> ((i - 4) >> 2)) & 1ull) != 0ull);
        else active = key0 <= w0 + 31;
        if (active) {
            f32x16 p0, p1;
#pragma unroll
            for (int r = 0; r < 16; ++r) { p0[r] = 0.f; p1[r] = 0.f; }
            LAS unsigned char* kb = buf + kperm * 16 + hi * 1024;
            bf16x8 kf[8];
            if (MODE != M_FOX) {
#pragma unroll
            for (int d0 = 0; d0 < 4; ++d0) {
                const bf16x8 kf0 = *(const LAS bf16x8*)(kb + d0 * 2048), kf1 = *(const LAS bf16x8*)(kb + d0 * 2048 + 512);
                p0 = __builtin_amdgcn_mfma_f32_32x32x16_bf16(kf0, qr[d0], p0, 0, 0, 0);
                p1 = __builtin_amdgcn_mfma_f32_32x32x16_bf16(kf1, qr[d0], p1, 0, 0, 0);
            }
            } else {
#pragma unroll
                for (int d0 = 0; d0 < 4; ++d0) { kf[2 * d0] = *(const LAS bf16x8*)(kb + d0 * 2048); kf[2 * d0 + 1] = *(const LAS bf16x8*)(kb + d0 * 2048 + 512); }
                __builtin_amdgcn_sched_barrier(0);
            }
        if (prev_active) {
            const LAS unsigned char* vb = lds + prevbuf + KB_BYTES + r32 * VT_STRIDE + hi * 16;
#define PVS(s, pk) do { const bf16x8 a0_ = *(const LAS bf16x8*)(vb + (s) * 32), a1_ = *(const LAS bf16x8*)(vb + 32 * VT_STRIDE + (s) * 32); \
            o0 = __builtin_amdgcn_mfma_f32_32x32x16_bf16(a0_, pk, o0, 0, 0, 0); o1 = __builtin_amdgcn_mfma_f32_32x32x16_bf16(a1_, pk, o1, 0, 0, 0); } while (0)
            PVS(0, pkP0); PVS(1, pkP1); PVS(2, pkP2); PVS(3, pkP3);
#undef PVS
        }
            if (MODE == M_FOX) {
                __builtin_amdgcn_sched_barrier(0);
#pragma unroll
                for (int d0 = 0; d0 < 4; ++d0) {
                    p0 = __builtin_amdgcn_mfma_f32_32x32x16_bf16(kf[2 * d0], qr[d0], p0, 0, 0, 0);
                    p1 = __builtin_amdgcn_mfma_f32_32x32x16_bf16(kf[2 * d0 + 1], qr[d0], p1, 0, 0, 0);
                }
            }
            const int kl = key0 + 8 * hi;
            if (MODE == M_SB) {
                const bool nm = key0 + 63 >= w0;
                f32x16 L0, L1; float gt[4];
#pragma unroll
                for (int g = 0; g < 4; ++g) gt[g] = 0.f;
#pragma unroll
                for (int r = 0; r < 16; ++r) {
                    { const float z2 = p0[r] * C2; p0[r] = z2; float l1 = -(fmaxf(z2, 0.f) + __builtin_amdgcn_logf(1.0f + __builtin_amdgcn_exp2f(-fabsf(z2))));
                      if (nm && !(kl + 16 * (r >> 3) + (r & 7) < row)) l1 = 0.f; L0[r] = l1; gt[r >> 3] += l1; }
                    { const float z2 = p1[r] * C2; p1[r] = z2; float l1 = -(fmaxf(z2, 0.f) + __builtin_amdgcn_logf(1.0f + __builtin_amdgcn_exp2f(-fabsf(z2))));
                      if (nm && !(kl + 32 + 16 * (r >> 3) + (r & 7) < row)) l1 = 0.f; L1[r] = l1; gt[2 + (r >> 3)] += l1; }
                }
                float pt[4], after[4]; float run = 0.f;
#pragma unroll
                for (int g = 0; g < 4; ++g) pt[g] = __shfl_xor(gt[g], 32);
#pragma unroll
                for (int g = 3; g >= 0; --g) { after[g] = run + (hi ? 0.f : pt[g]); run += gt[g] + pt[g]; }
#pragma unroll
                for (int g8 = 1; g8 >= 0; --g8) {
                    float s0 = T + after[g8], s1 = T + after[2 + g8];
#pragma unroll
                    for (int e = 7; e >= 0; --e) { const int r = 8 * g8 + e;
                        { const bool valid = !nm || (kl + 16 * g8 + e < row); const float a = valid ? __builtin_amdgcn_exp2f(p0[r] + L0[r] + s0) : 0.f; s0 += L0[r]; p0[r] = a; }
                        { const bool valid = !nm || (kl + 32 + 16 * g8 + e < row); const float a = valid ? __builtin_amdgcn_exp2f(p1[r] + L1[r] + s1) : 0.f; s1 += L1[r]; p1[r] = a; } }
                }
                T += run;
            } else {
                const bool nm = (MODE == M_FOX) ? (key0 + 63 > w0) : ((MODE == M_MOBA) ? (i < 4 && key0 + 63 > w0) : false);
                bool rowsel = true;
                if (MODE == M_MOBA) { if (i >= 4) { const int j = (i - 4) >> 2; rowsel = (i1 == j) | (i2 == j) | (i3 == j); } }
                const LAS float* cl = (const LAS float*)(buf + KB_BYTES + VT_BYTES) + 8 * hi;
                float corr;
                if (nm) {
                    float mx = -INFINITY;
#pragma unroll
                    for (int r = 0; r < 16; ++r) {
                        float t0 = p0[r] * C2, t1 = p1[r] * C2;
                        if (MODE == M_FOX) { t0 += cq2 - cl[16 * (r >> 3) + (r & 7)]; t1 += cq2 - cl[32 + 16 * (r >> 3) + (r & 7)]; }
                        const int k_0 = kl + 16 * (r >> 3) + (r & 7);
                        t0 = (k_0 <= row) ? t0 : -INFINITY; t1 = (k_0 + 32 <= row) ? t1 : -INFINITY;
                        p0[r] = t0; p1[r] = t1; mx = fmaxf(mx, fmaxf(t0, t1));
                    }
                    mx = fmaxf(mx, __shfl_xor(mx, 32));
                    float m_new;
                    if (MODE == M_FOX) { m_run = fmaxf(m_run, mx); m_new = fminf(qb2, 48.0f); corr = 1.0f; }
                    else { m_new = fmaxf(m_run, mx); corr = __builtin_amdgcn_exp2f(m_run - m_new); m_run = m_new; }
                    float sum = 0.f;
#pragma unroll
                    for (int r = 0; r < 16; ++r) { const float e0 = __builtin_amdgcn_exp2f(p0[r] - m_new), e1 = __builtin_amdgcn_exp2f(p1[r] - m_new); sum += e0 + e1; p0[r] = e0; p1[r] = e1; }
                    l_run = l_run * corr + sum;
                } else {
                    if (MODE == M_FOX) {
                        typedef float f32x2 __attribute__((ext_vector_type(2)));
                        const float base = cq2 - fminf(qb2, 48.0f); const f32x2 basev = (f32x2){base, base}, c2v = (f32x2){C2, C2};
                        f32x2 sa = (f32x2){0.f, 0.f}, sb = (f32x2){0.f, 0.f};
#pragma unroll
                        for (int r = 0; r < 16; r += 2) {
                            const f32x2 ca = *(const LAS f32x2*)(cl + 16 * (r >> 3) + (r & 7)), cb = *(const LAS f32x2*)(cl + 32 + 16 * (r >> 3) + (r & 7));
                            const f32x2 ta = (f32x2){p0[r], p0[r + 1]} * c2v + (basev - ca), tb = (f32x2){p1[r], p1[r + 1]} * c2v + (basev - cb);
                            const f32x2 ea = (f32x2){__builtin_amdgcn_exp2f(ta.x), __builtin_amdgcn_exp2f(ta.y)}, eb = (f32x2){__builtin_amdgcn_exp2f(tb.x), __builtin_amdgcn_exp2f(tb.y)};
                            sa += ea; sb += eb; p0[r] = ea.x; p0[r + 1] = ea.y; p1[r] = eb.x; p1[r + 1] = eb.y;
                        }
                        corr = 1.0f; l_run += (sa.x + sa.y) + (sb.x + sb.y);
                    } else {
                    float mx = -INFINITY;
#pragma unroll
                    for (int r = 0; r < 16; ++r) mx = fmaxf(mx, fmaxf(p0[r], p1[r]));
                    mx *= C2;
                    if (MODE == M_MOBA) mx = rowsel ? mx : -INFINITY;
                    mx = fmaxf(mx, __shfl_xor(mx, 32));
                    const float m_new = fmaxf(m_run, mx); corr = __builtin_amdgcn_exp2f(m_run - m_new); m_run = m_new;
                    const float off = (MODE == M_MOBA && !rowsel) ? -INFINITY : -m_new;
                    float s0 = 0.f, s1 = 0.f;
#pragma unroll
                    for (int r = 0; r < 16; ++r) { const float e0 = __builtin_amdgcn_exp2f(fmaf(p0[r], C2, off)), e1 = __builtin_amdgcn_exp2f(fmaf(p1[r], C2, off)); s0 += e0; s1 += e1; p0[r] = e0; p1[r] = e1; }
                    l_run = l_run * corr + (s0 + s1);
                    }
                }
                if (__any(corr != 1.0f)) {
#pragma unroll
                    for (int r = 0; r < 16; ++r) { o0[r] *= corr; o1[r] *= corr; }
                }
            }
            pkP0 = pack8(p0, 0); pkP1 = pack8(p0, 8); pkP2 = pack8(p1, 0); pkP3 = pack8(p1, 8);
            if (MODE == M_FOX) asm volatile("" :: "v"(kf[0]), "v"(kf[1]), "v"(kf[2]), "v"(kf[3]), "v"(kf[4]), "v"(kf[5]), "v"(kf[6]), "v"(kf[7]));
        } else {
        if (prev_active) {
            const LAS unsigned char* vb = lds + prevbuf + KB_BYTES + r32 * VT_STRIDE + hi * 16;
#define PVS(s, pk) do { const bf16x8 a0_ = *(const LAS bf16x8*)(vb + (s) * 32), a1_ = *(const LAS bf16x8*)(vb + 32 * VT_STRIDE + (s) * 32); \
            o0 = __builtin_amdgcn_mfma_f32_32x32x16_bf16(a0_, pk, o0, 0, 0, 0); o1 = __builtin_amdgcn_mfma_f32_32x32x16_bf16(a1_, pk, o1, 0, 0, 0); } while (0)
            PVS(0, pkP0); PVS(1, pkP1); PVS(2, pkP2); PVS(3, pkP3);
#undef PVS
        }
        }
        prev_active = active; prevbuf = 0 * BUF_BYTES;
        if (i + 1 < NT) STORET(1, k2, v2, c2);
        if (MODE == M_SB || MODE == M_FOX) {
            bool vote;
            if (MODE == M_SB) vote = __all(T < -151.0f) != 0;
            else { const float cn = (key0 > 0) ? A.cf[key0 - 1] * LOG2E : 0.f; vote = __all(qb2 + cq2 - cn < m_run - 151.0f) != 0; }
            if (lane == 0) ((LAS unsigned*)(lds + VOTE_OFF))[(i & 1) * 8 + wid] = (active && vote) ? 1u : 0u;
        }
        __syncthreads();
        if (MODE == M_SB || MODE == M_FOX) {
            const LAS unsigned* vv = (const LAS unsigned*)(lds + VOTE_OFF) + (i & 1) * 8;
            const unsigned all8 = (vv[0] & vv[1]) & (vv[2] & vv[3]) & (vv[4] & vv[5]) & (vv[6] & vv[7]);
            if (all8) break;
        }
        }
        { const int i = i0 + 1; if (i >= NT) break;
        const int key0 = KEY0(i);
        if (i + 3 < NT) LOADT(i + 3, k2, v2, c2);
        LAS unsigned char* buf = lds + 1 * BUF_BYTES;
        bool active;
        if (MODE == M_XA) active = true;
        else if (MODE == M_MOBA) active = (i < 4) ? (key0 <= w0 + 31) : (((wmask >> ((i - 4) >> 2)) & 1ull) != 0ull);
        else active = key0 <= w0 + 31;
        if (active) {
            f32x16 p0, p1;
#pragma unroll
            for (int r = 0; r < 16; ++r) { p0[r] = 0.f; p1[r] = 0.f; }
            LAS unsigned char* kb = buf + kperm * 16 + hi * 1024;
            bf16x8 kf[8];
            if (MODE != M_FOX) {
#pragma unroll
            for (int d0 = 0; d0 < 4; ++d0) {
                const bf16x8 kf0 = *(const LAS bf16x8*)(kb + d0 * 2048), kf1 = *(const LAS bf16x8*)(kb + d0 * 2048 + 512);
                p0 = __builtin_amdgcn_mfma_f32_32x32x16_bf16(kf0, qr[d0], p0, 0, 0, 0);
                p1 = __builtin_amdgcn_mfma_f32_32x32x16_bf16(kf1, qr[d0], p1, 0, 0, 0);
            }
            } else {
#pragma unroll
                for (int d0 = 0; d0 < 4; ++d0) { kf[2 * d0] = *(const LAS bf16x8*)(kb + d0 * 2048); kf[2 * d0 + 1] = *(const LAS bf16x8*)(kb + d0 * 2048 + 512); }
                __builtin_amdgcn_sched_barrier(0);
            }
        if (prev_active) {
            const LAS unsigned char* vb = lds + prevbuf + KB_BYTES + r32 * VT_STRIDE + hi * 16;
#define PVS(s, pk) do { const bf16x8 a0_ = *(const LAS bf16x8*)(vb + (s) * 32), a1_ = *(const LAS bf16x8*)(vb + 32 * VT_STRIDE + (s) * 32); \
            o0 = __builtin_amdgcn_mfma_f32_32x32x16_bf16(a0_, pk, o0, 0, 0, 0); o1 = __builtin_amdgcn_mfma_f32_32x32x16_bf16(a1_, pk, o1, 0, 0, 0); } while (0)
            PVS(0, pkP0); PVS(1, pkP1); PVS(2, pkP2); PVS(3, pkP3);
#undef PVS
        }
            if (MODE == M_FOX) {
                __builtin_amdgcn_sched_barrier(0);
#pragma unroll
                for (int d0 = 0; d0 < 4; ++d0) {
                    p0 = __builtin_amdgcn_mfma_f32_32x32x16_bf16(kf[2 * d0], qr[d0], p0, 0, 0, 0);
                    p1 = __builtin_amdgcn_mfma_f32_32x32x16_bf16(kf[2 * d0 + 1], qr[d0], p1, 0, 0, 0);
                }
            }
            const int kl = key0 + 8 * hi;
            if (MODE == M_SB) {
                const bool nm = key0 + 63 >= w0;
                f32x16 L0, L1; float gt[4];
#pragma unroll
                for (int g = 0; g < 4; ++g) gt[g] = 0.f;
#pragma unroll
                for (int r = 0; r < 16; ++r) {
                    { const float z2 = p0[r] * C2; p0[r] = z2; float l1 = -(fmaxf(z2, 0.f) + __builtin_amdgcn_logf(1.0f + __builtin_amdgcn_exp2f(-fabsf(z2))));
                      if (nm && !(kl + 16 * (r >> 3) + (r & 7) < row)) l1 = 0.f; L0[r] = l1; gt[r >> 3] += l1; }
                    { const float z2 = p1[r] * C2; p1[r] = z2; float l1 = -(fmaxf(z2, 0.f) + __builtin_amdgcn_logf(1.0f + __builtin_amdgcn_exp2f(-fabsf(z2))));
                      if (nm && !(kl + 32 + 16 * (r >> 3) + (r & 7) < row)) l1 = 0.f; L1[r] = l1; gt[2 + (r >> 3)] += l1; }
                }
                float pt[4], after[4]; float run = 0.f;
#pragma unroll
                for (int g = 0; g < 4; ++g) pt[g] = __shfl_xor(gt[g], 32);
#pragma unroll
                for (int g = 3; g >= 0; --g) { after[g] = run + (hi ? 0.f : pt[g]); run += gt[g] + pt[g]; }
#pragma unroll
                for (int g8 = 1; g8 >= 0; --g8) {
                    float s0 = T + after[g8], s1 = T + after[2 + g8];
#pragma unroll
                    for (int e = 7; e >= 0; --e) { const int r = 8 * g8 + e;
                        { const bool valid = !nm || (kl + 16 * g8 + e < row); const float a = valid ? __builtin_amdgcn_exp2f(p0[r] + L0[r] + s0) : 0.f; s0 += L0[r]; p0[r] = a; }
                        { const bool valid = !nm || (kl + 32 + 16 * g8 + e < row); const float a = valid ? __builtin_amdgcn_exp2f(p1[r] + L1[r] + s1) : 0.f; s1 += L1[r]; p1[r] = a; } }
                }
                T += run;
            } else {
                const bool nm = (MODE == M_FOX) ? (key0 + 63 > w0) : ((MODE == M_MOBA) ? (i < 4 && key0 + 63 > w0) : false);
                bool rowsel = true;
                if (MODE == M_MOBA) { if (i >= 4) { const int j = (i - 4) >> 2; rowsel = (i1 == j) | (i2 == j) | (i3 == j); } }
                const LAS float* cl = (const LAS float*)(buf + KB_BYTES + VT_BYTES) + 8 * hi;
                float corr;
                if (nm) {
                    float mx = -INFINITY;
#pragma unroll
                    for (int r = 0; r < 16; ++r) {
                        float t0 = p0[r] * C2, t1 = p1[r] * C2;
                        if (MODE == M_FOX) { t0 += cq2 - cl[16 * (r >> 3) + (r & 7)]; t1 += cq2 - cl[32 + 16 * (r >> 3) + (r & 7)]; }
                        const int k_0 = kl + 16 * (r >> 3) + (r & 7);
                        t0 = (k_0 <= row) ? t0 : -INFINITY; t1 = (k_0 + 32 <= row) ? t1 : -INFINITY;
                        p0[r] = t0; p1[r] = t1; mx = fmaxf(mx, fmaxf(t0, t1));
                    }
                    mx = fmaxf(mx, __shfl_xor(mx, 32));
                    float m_new;
                    if (MODE == M_FOX) { m_run = fmaxf(m_run, mx); m_new = fminf(qb2, 48.0f); corr = 1.0f; }
                    else { m_new = fmaxf(m_run, mx); corr = __builtin_amdgcn_exp2f(m_run - m_new); m_run = m_new; }
                    float sum = 0.f;
#pragma unroll
                    for (int r = 0; r < 16; ++r) { const float e0 = __builtin_amdgcn_exp2f(p0[r] - m_new), e1 = __builtin_amdgcn_exp2f(p1[r] - m_new); sum += e0 + e1; p0[r] = e0; p1[r] = e1; }
                    l_run = l_run * corr + sum;
                } else {
                    if (MODE == M_FOX) {
                        typedef float f32x2 __attribute__((ext_vector_type(2)));
                        const float base = cq2 - fminf(qb2, 48.0f); const f32x2 basev = (f32x2){base, base}, c2v = (f32x2){C2, C2};
                        f32x2 sa = (f32x2){0.f, 0.f}, sb = (f32x2){0.f, 0.f};
#pragma unroll
                        for (int r = 0; r < 16; r += 2) {
                            const f32x2 ca = *(const LAS f32x2*)(cl + 16 * (r >> 3) + (r & 7)), cb = *(const LAS f32x2*)(cl + 32 + 16 * (r >> 3) + (r & 7));
                            const f32x2 ta = (f32x2){p0[r], p0[r + 1]} * c2v + (basev - ca), tb = (f32x2){p1[r], p1[r + 1]} * c2v + (basev - cb);
                            const f32x2 ea = (f32x2){__builtin_amdgcn_exp2f(ta.x), __builtin_amdgcn_exp2f(ta.y)}, eb = (f32x2){__builtin_amdgcn_exp2f(tb.x), __builtin_amdgcn_exp2f(tb.y)};
                            sa += ea; sb += eb; p0[r] = ea.x; p0[r + 1] = ea.y; p1[r] = eb.x; p1[r + 1] = eb.y;
                        }
                        corr = 1.0f; l_run += (sa.x + sa.y) + (sb.x + sb.y);
                    } else {
                    float mx = -INFINITY;
#pragma unroll
                    for (int r = 0; r < 16; ++r) mx = fmaxf(mx, fmaxf(p0[r], p1[r]));
                    mx *= C2;
                    if (MODE == M_MOBA) mx = rowsel ? mx : -INFINITY;
                    mx = fmaxf(mx, __shfl_xor(mx, 32));
                    const float m_new = fmaxf(m_run, mx); corr = __builtin_amdgcn_exp2f(m_run - m_new); m_run = m_new;
                    const float off = (MODE == M_MOBA && !rowsel) ? -INFINITY : -m_new;
                    float s0 = 0.f, s1 = 0.f;
#pragma unroll
                    for (int r = 0; r < 16; ++r) { const float e0 = __builtin_amdgcn_exp2f(fmaf(p0[r], C2, off)), e1 = __builtin_amdgcn_exp2f(fmaf(p1[r], C2, off)); s0 += e0; s1 += e1; p0[r] = e0; p1[r] = e1; }
                    l_run = l_run * corr + (s0 + s1);
                    }
                }
                if (__any(corr != 1.0f)) {
#pragma unroll
                    for (int r = 0; r < 16; ++r) { o0[r] *= corr; o1[r] *= corr; }
                }
            }
            pkP0 = pack8(p0, 0); pkP1 = pack8(p0, 8); pkP2 = pack8(p1, 0); pkP3 = pack8(p1, 8);
            if (MODE == M_FOX) asm volatile("" :: "v"(kf[0]), "v"(kf[1]), "v"(kf[2]), "v"(kf[3]), "v"(kf[4]), "v"(kf[5]), "v"(kf[6]), "v"(kf[7]));
        } else {
        if (prev_active) {
            const LAS unsigned char* vb = lds + prevbuf + KB_BYTES + r32 * VT_STRIDE + hi * 16;
#define PVS(s, pk) do { const bf16x8 a0_ = *(const LAS bf16x8*)(vb + (s) * 32), a1_ = *(const LAS bf16x8*)(vb + 32 * VT_STRIDE + (s) * 32); \
            o0 = __builtin_amdgcn_mfma_f32_32x32x16_bf16(a0_, pk, o0, 0, 0, 0); o1 = __builtin_amdgcn_mfma_f32_32x32x16_bf16(a1_, pk, o1, 0, 0, 0); } while (0)
            PVS(0, pkP0); PVS(1, pkP1); PVS(2, pkP2); PVS(3, pkP3);
#undef PVS
        }
        }
        prev_active = active; prevbuf = 1 * BUF_BYTES;
        if (i + 1 < NT) STORET(2, k3, v3, c3);
        if (MODE == M_SB || MODE == M_FOX) {
            bool vote;
            if (MODE == M_SB) vote = __all(T < -151.0f) != 0;
            else { const float cn = (key0 > 0) ? A.cf[key0 - 1] * LOG2E : 0.f; vote = __all(qb2 + cq2 - cn < m_run - 151.0f) != 0; }
            if (lane == 0) ((LAS unsigned*)(lds + VOTE_OFF))[(i & 1) * 8 + wid] = (active && vote) ? 1u : 0u;
        }
        __syncthreads();
        if (MODE == M_SB || MODE == M_FOX) {
            const LAS unsigned* vv = (const LAS unsigned*)(lds + VOTE_OFF) + (i & 1) * 8;
            const unsigned all8 = (vv[0] & vv[1]) & (vv[2] & vv[3]) & (vv[4] & vv[5]) & (vv[6] & vv[7]);
            if (all8) break;
        }
        }
        { const int i = i0 + 2; if (i >= NT) break;
        const int key0 = KEY0(i);
        if (i + 3 < NT) LOADT(i + 3, k3, v3, c3);
        LAS unsigned char* buf = lds + 2 * BUF_BYTES;
        bool active;
        if (MODE == M_XA) active = true;
        else if (MODE == M_MOBA) active = (i < 4) ? (key0 <= w0 + 31) : (((wmask >> ((i - 4) >> 2)) & 1ull) != 0ull);
        else active = key0 <= w0 + 31;
        if (active) {
            f32x16 p0, p1;
#pragma unroll
            for (int r = 0; r < 16; ++r) { p0[r] = 0.f; p1[r] = 0.f; }
            LAS unsigned char* kb = buf + kperm * 16 + hi * 1024;
            bf16x8 kf[8];
            if (MODE != M_FOX) {
#pragma unroll
            for (int d0 = 0; d0 < 4; ++d0) {
                const bf16x8 kf0 = *(const LAS bf16x8*)(kb + d0 * 2048), kf1 = *(const LAS bf16x8*)(kb + d0 * 2048 + 512);
                p0 = __builtin_amdgcn_mfma_f32_32x32x16_bf16(kf0, qr[d0], p0, 0, 0, 0);
                p1 = __builtin_amdgcn_mfma_f32_32x32x16_bf16(kf1, qr[d0], p1, 0, 0, 0);
            }
            } else {
#pragma unroll
                for (int d0 = 0; d0 < 4; ++d0) { kf[2 * d0] = *(const LAS bf16x8*)(kb + d0 * 2048); kf[2 * d0 + 1] = *(const LAS bf16x8*)(kb + d0 * 2048 + 512); }
                __builtin_amdgcn_sched_barrier(0);
            }
        if (prev_active) {
            const LAS unsigned char* vb = lds + prevbuf + KB_BYTES + r32 * VT_STRIDE + hi * 16;
#define PVS(s, pk) do { const bf16x8 a0_ = *(const LAS bf16x8*)(vb + (s) * 32), a1_ = *(const LAS bf16x8*)(vb + 32 * VT_STRIDE + (s) * 32); \
            o0 = __builtin_amdgcn_mfma_f32_32x32x16_bf16(a0_, pk, o0, 0, 0, 0); o1 = __builtin_amdgcn_mfma_f32_32x32x16_bf16(a1_, pk, o1, 0, 0, 0); } while (0)
            PVS(0, pkP0); PVS(1, pkP1); PVS(2, pkP2); PVS(3, pkP3);
#undef PVS
        }
            if (MODE == M_FOX) {
                __builtin_amdgcn_sched_barrier(0);
#pragma unroll
                for (int d0 = 0; d0 < 4; ++d0) {
                    p0 = __builtin_amdgcn_mfma_f32_32x32x16_bf16(kf[2 * d0], qr[d0], p0, 0, 0, 0);
                    p1 = __builtin_amdgcn_mfma_f32_32x32x16_bf16(kf[2 * d0 + 1], qr[d0], p1, 0, 0, 0);
                }
            }
            const int kl = key0 + 8 * hi;
            if (MODE == M_SB) {
                const bool nm = key0 + 63 >= w0;
                f32x16 L0, L1; float gt[4];
#pragma unroll
                for (int g = 0; g < 4; ++g) gt[g] = 0.f;
#pragma unroll
                for (int r = 0; r < 16; ++r) {
                    { const float z2 = p0[r] * C2; p0[r] = z2; float l1 = -(fmaxf(z2, 0.f) + __builtin_amdgcn_logf(1.0f + __builtin_amdgcn_exp2f(-fabsf(z2))));
                      if (nm && !(kl + 16 * (r >> 3) + (r & 7) < row)) l1 = 0.f; L0[r] = l1; gt[r >> 3] += l1; }
                    { const float z2 = p1[r] * C2; p1[r] = z2; float l1 = -(fmaxf(z2, 0.f) + __builtin_amdgcn_logf(1.0f + __builtin_amdgcn_exp2f(-fabsf(z2))));
                      if (nm && !(kl + 32 + 16 * (r >> 3) + (r & 7) < row)) l1 = 0.f; L1[r] = l1; gt[2 + (r >> 3)] += l1; }
                }
                float pt[4], after[4]; float run = 0.f;
#pragma unroll
                for (int g = 0; g < 4; ++g) pt[g] = __shfl_xor(gt[g], 32);
#pragma unroll
                for (int g = 3; g >= 0; --g) { after[g] = run + (hi ? 0.f : pt[g]); run += gt[g] + pt[g]; }
#pragma unroll
                for (int g8 = 1; g8 >= 0; --g8) {
                    float s0 = T + after[g8], s1 = T + after[2 + g8];
#pragma unroll
                    for (int e = 7; e >= 0; --e) { const int r = 8 * g8 + e;
                        { const bool valid = !nm || (kl + 16 * g8 + e < row); const float a = valid ? __builtin_amdgcn_exp2f(p0[r] + L0[r] + s0) : 0.f; s0 += L0[r]; p0[r] = a; }
                        { const bool valid = !nm || (kl + 32 + 16 * g8 + e < row); const float a = valid ? __builtin_amdgcn_exp2f(p1[r] + L1[r] + s1) : 0.f; s1 += L1[r]; p1[r] = a; } }
                }
                T += run;
            } else {
                const bool nm = (MODE == M_FOX) ? (key0 + 63 > w0) : ((MODE == M_MOBA) ? (i < 4 && key0 + 63 > w0) : false);
                bool rowsel = true;
                if (MODE == M_MOBA) { if (i >= 4) { const int j = (i - 4) >> 2; rowsel = (i1 == j) | (i2 == j) | (i3 == j); } }
                const LAS float* cl = (const LAS float*)(buf + KB_BYTES + VT_BYTES) + 8 * hi;
                float corr;
                if (nm) {
                    float mx = -INFINITY;
#pragma unroll
                    for (int r = 0; r < 16; ++r) {
                        float t0 = p0[r] * C2, t1 = p1[r] * C2;
                        if (MODE == M_FOX) { t0 += cq2 - cl[16 * (r >> 3) + (r & 7)]; t1 += cq2 - cl[32 + 16 * (r >> 3) + (r & 7)]; }
                        const int k_0 = kl + 16 * (r >> 3) + (r & 7);
                        t0 = (k_0 <= row) ? t0 : -INFINITY; t1 = (k_0 + 32 <= row) ? t1 : -INFINITY;
                        p0[r] = t0; p1[r] = t1; mx = fmaxf(mx, fmaxf(t0, t1));
                    }
                    mx = fmaxf(mx, __shfl_xor(mx, 32));
                    float m_new;
                    if (MODE == M_FOX) { m_run = fmaxf(m_run, mx); m_new = fminf(qb2, 48.0f); corr = 1.0f; }
                    else { m_new = fmaxf(m_run, mx); corr = __builtin_amdgcn_exp2f(m_run - m_new); m_run = m_new; }
                    float sum = 0.f;
#pragma unroll
                    for (int r = 0; r < 16; ++r) { const float e0 = __builtin_amdgcn_exp2f(p0[r] - m_new), e1 = __builtin_amdgcn_exp2f(p1[r] - m_new); sum += e0 + e1; p0[r] = e0; p1[r] = e1; }
                    l_run = l_run * corr + sum;
                } else {
                    if (MODE == M_FOX) {
                        typedef float f32x2 __attribute__((ext_vector_type(2)));
                        const float base = cq2 - fminf(qb2, 48.0f); const f32x2 basev = (f32x2){base, base}, c2v = (f32x2){C2, C2};
                        f32x2 sa = (f32x2){0.f, 0.f}, sb = (f32x2){0.f, 0.f};
#pragma unroll
                        for (int r = 0; r < 16; r += 2) {
                            const f32x2 ca = *(const LAS f32x2*)(cl + 16 * (r >> 3) + (r & 7)), cb = *(const LAS f32x2*)(cl + 32 + 16 * (r >> 3) + (r & 7));
                            const f32x2 ta = (f32x2){p0[r], p0[r + 1]} * c2v + (basev - ca), tb = (f32x2){p1[r], p1[r + 1]} * c2v + (basev - cb);
                            const f32x2 ea = (f32x2){__builtin_amdgcn_exp2f(ta.x), __builtin_amdgcn_exp2f(ta.y)}, eb = (f32x2){__builtin_amdgcn_exp2f(tb.x), __builtin_amdgcn_exp2f(tb.y)};
                            sa += ea; sb += eb; p0[r] = ea.x; p0[r + 1] = ea.y; p1[r] = eb.x; p1[r + 1] = eb.y;
                        }
                        corr = 1.0f; l_run += (sa.x + sa.y) + (sb.x + sb.y);
                    } else {
                    float mx = -INFINITY;
#pragma unroll
                    for (int r = 0; r < 16; ++r) mx = fmaxf(mx, fmaxf(p0[r], p1[r]));
                    mx *= C2;
                    if (MODE == M_MOBA) mx = rowsel ? mx : -INFINITY;
                    mx = fmaxf(mx, __shfl_xor(mx, 32));
                    const float m_new = fmaxf(m_run, mx); corr = __builtin_amdgcn_exp2f(m_run - m_new); m_run = m_new;
                    const float off = (MODE == M_MOBA && !rowsel) ? -INFINITY : -m_new;
                    float s0 = 0.f, s1 = 0.f;
#pragma unroll
                    for (int r = 0; r < 16; ++r) { const float e0 = __builtin_amdgcn_exp2f(fmaf(p0[r], C2, off)), e1 = __builtin_amdgcn_exp2f(fmaf(p1[r], C2, off)); s0 += e0; s1 += e1; p0[r] = e0; p1[r] = e1; }
                    l_run = l_run * corr + (s0 + s1);
                    }
                }
                if (__any(corr != 1.0f)) {
#pragma unroll
                    for (int r = 0; r < 16; ++r) { o0[r] *= corr; o1[r] *= corr; }
                }
            }
            pkP0 = pack8(p0, 0); pkP1 = pack8(p0, 8); pkP2 = pack8(p1, 0); pkP3 = pack8(p1, 8);
            if (MODE == M_FOX) asm volatile("" :: "v"(kf[0]), "v"(kf[1]), "v"(kf[2]), "v"(kf[3]), "v"(kf[4]), "v"(kf[5]), "v"(kf[6]), "v"(kf[7]));
        } else {
        if (prev_active) {
            const LAS unsigned char* vb = lds + prevbuf + KB_BYTES + r32 * VT_STRIDE + hi * 16;
#define PVS(s, pk) do { const bf16x8 a0_ = *(const LAS bf16x8*)(vb + (s) * 32), a1_ = *(const LAS bf16x8*)(vb + 32 * VT_STRIDE + (s) * 32); \
            o0 = __builtin_amdgcn_mfma_f32_32x32x16_bf16(a0_, pk, o0, 0, 0, 0); o1 = __builtin_amdgcn_mfma_f32_32x32x16_bf16(a1_, pk, o1, 0, 0, 0); } while (0)
            PVS(0, pkP0); PVS(1, pkP1); PVS(2, pkP2); PVS(3, pkP3);
#undef PVS
        }
        }
        prev_active = active; prevbuf = 2 * BUF_BYTES;
        if (i + 1 < NT) STORET(0, k1, v1, c1);
        if (MODE == M_SB || MODE == M_FOX) {
            bool vote;
            if (MODE == M_SB) vote = __all(T < -151.0f) != 0;
            else { const float cn = (key0 > 0) ? A.cf[key0 - 1] * LOG2E : 0.f; vote = __all(qb2 + cq2 - cn < m_run - 151.0f) != 0; }
            if (lane == 0) ((LAS unsigned*)(lds + VOTE_OFF))[(i & 1) * 8 + wid] = (active && vote) ? 1u : 0u;
        }
        __syncthreads();
        if (MODE == M_SB || MODE == M_FOX) {
            const LAS unsigned* vv = (const LAS unsigned*)(lds + VOTE_OFF) + (i & 1) * 8;
            const unsigned all8 = (vv[0] & vv[1]) & (vv[2] & vv[3]) & (vv[4] & vv[5]) & (vv[6] & vv[7]);
            if (all8) break;
        }
        }
    }
#undef KEY0
#undef LOADT
#undef STORET
    if (prev_active) {
        const LAS unsigned char* vb = lds + prevbuf + KB_BYTES + r32 * VT_STRIDE + hi * 16;
#define PVS(s, pk) do { const bf16x8 a0_ = *(const LAS bf16x8*)(vb + (s) * 32), a1_ = *(const LAS bf16x8*)(vb + 32 * VT_STRIDE + (s) * 32); \
        o0 = __builtin_amdgcn_mfma_f32_32x32x16_bf16(a0_, pk, o0, 0, 0, 0); o1 = __builtin_amdgcn_mfma_f32_32x32x16_bf16(a1_, pk, o1, 0, 0, 0); } while (0)
        PVS(0, pkP0); PVS(1, pkP1); PVS(2, pkP2); PVS(3, pkP3);
#undef PVS
    }
    float inv = 1.0f;
    if (MODE != M_SB) { const float l = l_run + __shfl_xor(l_run, 32); inv = 1.0f / l; if (MODE == M_MOBA) { if (hi == 0) A.lse[(size_t)row * 32] = m_run + __builtin_amdgcn_logf(l); } }
    bf16_t* op = A.O + (size_t)row * A.ldo + 4 * hi;
#pragma unroll
    for (int g = 0; g < 4; ++g) {
        pg8::store4(op + 8 * g, (f32x4){o0[4 * g] * inv, o0[4 * g + 1] * inv, o0[4 * g + 2] * inv, o0[4 * g + 3] * inv});
        pg8::store4(op + 32 + 8 * g, (f32x4){o1[4 * g] * inv, o1[4 * g + 1] * inv, o1[4 * g + 2] * inv, o1[4 * g + 3] * inv});
    }
}

__device__ __forceinline__ void moba_routed_unit(LAS unsigned char* lds, const bf16_t* Qh, const bf16_t* Kh, const bf16_t* Vh, const int* selh, bf16_t* parth, float* lseh, int j, int b0, int b1) {
    int tid_ = threadIdx.x; asm volatile("" : "+v"(tid_)); const int tid = tid_, lane = tid & 63, wid = __builtin_amdgcn_readfirstlane(tid >> 6), r32 = lane & 31, hi = lane >> 5;
    LAS int* list = (LAS int*)(lds + 71680); LAS int* cnt = (LAS int*)(lds + 71680 + 16384);
    if (tid == 0) *cnt = 0;
    u32x4 kk[4], vv[4];
#pragma unroll
    for (int tl = 0; tl < 4; ++tl) { const size_t ro = (size_t)(256 * j + 64 * tl + lane) * 1024 + wid * 8; kk[tl] = *(const u32x4*)(Kh + ro); vv[tl] = *(const u32x4*)(Vh + ro); }
    __syncthreads();
    typedef int i32x4 __attribute__((ext_vector_type(4)));
    for (int t = 256 * b0 + tid; t < 256 * b1; t += 512) {
        const i32x4 s = *(const i32x4*)(selh + (size_t)t * 4);
        if (s.x == j) { const int p = __hip_atomic_fetch_add(cnt, 1, __ATOMIC_RELAXED, __HIP_MEMORY_SCOPE_WORKGROUP); list[p] = t; }
        if (s.y == j) { const int p = __hip_atomic_fetch_add(cnt, 1, __ATOMIC_RELAXED, __HIP_MEMORY_SCOPE_WORKGROUP); list[p] = t | (1 << 16); }
        if (s.z == j) { const int p = __hip_atomic_fetch_add(cnt, 1, __ATOMIC_RELAXED, __HIP_MEMORY_SCOPE_WORKGROUP); list[p] = t | (2 << 16); }
    }
#pragma unroll
    for (int tl = 0; tl < 4; ++tl) { LAS unsigned char* bb_ = lds + tl * BUF_BYTES; *(LAS u32x4*)(bb_ + wid * 1024 + lane * 16) = kk[tl];
        LAS unsigned short* vt_ = (LAS unsigned short*)(bb_ + KB_BYTES + (8 * wid) * VT_STRIDE + lane * 2); const u32x4 vreg = vv[tl];
        vt_[0 * 72] = (unsigned short)(vreg.x & 0xffffu); vt_[1 * 72] = (unsigned short)(vreg.x >> 16); vt_[2 * 72] = (unsigned short)(vreg.y & 0xffffu); vt_[3 * 72] = (unsigned short)(vreg.y >> 16);
        vt_[4 * 72] = (unsigned short)(vreg.z & 0xffffu); vt_[5 * 72] = (unsigned short)(vreg.z >> 16); vt_[6 * 72] = (unsigned short)(vreg.w & 0xffffu); vt_[7 * 72] = (unsigned short)(vreg.w >> 16); }
    __syncthreads();
    const int n = *cnt;
    const int kperm = (r32 & ~15) | (r32 & 3) | ((r32 & 4) << 1) | ((r32 & 8) >> 1);
    for (int g = wid; g * 32 < n; g += 8) {
        const int mi = g * 32 + r32; const bool valid = mi < n; const int e = list[valid ? mi : 0]; const int t = e & 0xffff, slot = e >> 16;
        bf16x8 qr[4];
#pragma unroll
        for (int d0 = 0; d0 < 4; ++d0) qr[d0] = *(const bf16x8*)(Qh + (size_t)t * 1024 + d0 * 16 + hi * 8);
        f32x16 o0, o1;
#pragma unroll
        for (int r = 0; r < 16; ++r) { o0[r] = 0.f; o1[r] = 0.f; }
        float m_run = -1e30f, l_run = 0.f;
#pragma unroll 1
        for (int tl = 0; tl < 4; ++tl) {
            LAS unsigned char* buf = lds + tl * BUF_BYTES;
            f32x16 p0, p1;
#pragma unroll
            for (int r = 0; r < 16; ++r) { p0[r] = 0.f; p1[r] = 0.f; }
            LAS unsigned char* kb = buf + kperm * 16 + hi * 1024;
#pragma unroll
            for (int d0 = 0; d0 < 4; ++d0) {
                const bf16x8 kf0 = *(const LAS bf16x8*)(kb + d0 * 2048), kf1 = *(const LAS bf16x8*)(kb + d0 * 2048 + 512);
                p0 = __builtin_amdgcn_mfma_f32_32x32x16_bf16(kf0, qr[d0], p0, 0, 0, 0);
                p1 = __builtin_amdgcn_mfma_f32_32x32x16_bf16(kf1, qr[d0], p1, 0, 0, 0);
            }
            float mx = -INFINITY;
#pragma unroll
            for (int r = 0; r < 16; ++r) mx = fmaxf(mx, fmaxf(p0[r], p1[r]));
            mx *= C2; mx = fmaxf(mx, __shfl_xor(mx, 32));
            const float m_new = fmaxf(m_run, mx), corr = __builtin_amdgcn_exp2f(m_run - m_new); m_run = m_new;
            float s0 = 0.f, s1 = 0.f;
#pragma unroll
            for (int r = 0; r < 16; ++r) { const float e0 = __builtin_amdgcn_exp2f(fmaf(p0[r], C2, -m_new)), e1 = __builtin_amdgcn_exp2f(fmaf(p1[r], C2, -m_new)); s0 += e0; s1 += e1; p0[r] = e0; p1[r] = e1; }
            l_run = l_run * corr + (s0 + s1);
            if (__any(corr != 1.0f)) {
#pragma unroll
                for (int r = 0; r < 16; ++r) { o0[r] *= corr; o1[r] *= corr; }
            }
            const bf16x8 pk0 = pack8(p0, 0), pk1 = pack8(p0, 8), pk2 = pack8(p1, 0), pk3 = pack8(p1, 8);
            const LAS unsigned char* vb = buf + KB_BYTES + r32 * VT_STRIDE + hi * 16;
#define PVS(s, pk) do { const bf16x8 a0_ = *(const LAS bf16x8*)(vb + (s) * 32), a1_ = *(const LAS bf16x8*)(vb + 32 * VT_STRIDE + (s) * 32); \
            o0 = __builtin_amdgcn_mfma_f32_32x32x16_bf16(a0_, pk, o0, 0, 0, 0); o1 = __builtin_amdgcn_mfma_f32_32x32x16_bf16(a1_, pk, o1, 0, 0, 0); } while (0)
            PVS(0, pk0); PVS(1, pk1); PVS(2, pk2); PVS(3, pk3);
#undef PVS
        }
        const float l = l_run + __shfl_xor(l_run, 32), inv = 1.0f / l;
        if (valid) {
            bf16_t* op = parth + ((size_t)t * 32 + slot) * 64 + 4 * hi;
#pragma unroll
            for (int g4 = 0; g4 < 4; ++g4) {
                pg8::store4(op + 8 * g4, (f32x4){o0[4 * g4] * inv, o0[4 * g4 + 1] * inv, o0[4 * g4 + 2] * inv, o0[4 * g4 + 3] * inv});
                pg8::store4(op + 32 + 8 * g4, (f32x4){o1[4 * g4] * inv, o1[4 * g4 + 1] * inv, o1[4 * g4 + 2] * inv, o1[4 * g4 + 3] * inv});
            }
            if (hi == 0) lseh[(size_t)t * 32 + slot] = m_run + __builtin_amdgcn_logf(l);
        }
    }
    __syncthreads();
}
}
using pg8::bf16_t; using pg8::f32x4; using pg8::u32x4;
constexpr int S = 16384, D = 1024, DFF = 2816, NUP = 5632, MEM = 256;
constexpr size_t MiB = 1u << 20;
constexpr size_t WS_SSQ = 0;
constexpr size_t WS_KPART = 512 * 1024;
constexpr size_t WS_KMX = 1 * MiB;
constexpr size_t WS_WFT = 1 * MiB + 196608;
constexpr size_t WS_DUMMY = 1 * MiB + 131072;
constexpr size_t WS_CNT = 1 * MiB + 4096;
constexpr size_t WS_BAR = 1 * MiB + 65536;
constexpr size_t WS_LOGF = 2 * MiB, WS_CF = 3 * MiB;
constexpr size_t WS_ROPEC = 4 * MiB, WS_ROPES = 6 * MiB;
constexpr size_t WS_MN = 8 * MiB;
constexpr size_t WS_MKV = 9 * MiB;
constexpr size_t WS_XQ = 10 * MiB, WS_XO = 18 * MiB;
constexpr size_t WS_WIN0 = 26 * MiB, WS_WOUT0 = 32 * MiB, WS_WIN1 = 34 * MiB, WS_WOUT1 = WS_WIN1 + 3328 * 1024 * 2, WS_WXQ = WS_WOUT1 + 2 * MiB, WS_WXKV = WS_WXQ + 1 * MiB, WS_WXO = WS_WXKV + 2 * MiB,
                 WS_WUP = WS_WXO + 1 * MiB, WS_WDN = WS_WUP + 22 * MiB, WS_WEND = WS_WDN + 11 * MiB;
static_assert(WS_WEND <= 80 * MiB, "weights");
constexpr size_t WS_XB = 81 * MiB;
constexpr size_t WS_SEL = 242 * MiB, WS_LSE = 244 * MiB;
constexpr size_t WS_Q = 114 * MiB, WS_K = 146 * MiB, WS_V = 178 * MiB, WS_O = 210 * MiB, WS_ACT = 114 * MiB, WS_END = 246 * MiB;

#ifndef SC_MIX0
#define SC_MIX0 1.0f
#endif
#ifndef SC_MIX1
#define SC_MIX1 1.0f
#endif
#ifndef SC_XA
#define SC_XA 1.0f
#endif
#ifndef SC_FFN
#define SC_FFN 1.0f
#endif
#define RLX_AGENT __ATOMIC_RELAXED, __HIP_MEMORY_SCOPE_AGENT
#define XB_TMO      128
#define XB_XCNT(j)  (256  + 64 * (j))
#define XB_XSUB(j)  (1280 + 64 * (j))
#define XB_XGEN(j)  (2304 + 64 * (j))
#define XB_TOP      3328
#define XB_TOPGEN   3392
#define XCD_BAR_WORDS 3456
#define XB_SPIN_CAP (1u << 18)

__device__ __forceinline__ unsigned xb_ld(unsigned* p)              { return __hip_atomic_load(p, __ATOMIC_RELAXED, __HIP_MEMORY_SCOPE_AGENT); }
__device__ __forceinline__ unsigned xb_add(unsigned* p, unsigned v) { return __hip_atomic_fetch_add(p, v, __ATOMIC_RELAXED, __HIP_MEMORY_SCOPE_AGENT); }
__device__ __forceinline__ unsigned xb_xcc_id() { return (unsigned)__builtin_amdgcn_s_getreg((3 << 11) | 20) & 0xFu; }
#define XB_SPIN(cond, bar) do { unsigned _sp = 0; while (cond) { __builtin_amdgcn_s_sleep(1); \
    if ((++_sp & 255u) == 0u) { if (xb_ld(&(bar)[XB_TMO])) break; if (_sp > XB_SPIN_CAP) { atomicAdd(&(bar)[XB_TMO], 1u); break; } } } } while (0)

struct XcdBarrier {
    unsigned* bar; unsigned x;
    volatile LAS unsigned* st;
};

__device__ __forceinline__ XcdBarrier xcd_barrier_post(unsigned* bar, volatile LAS unsigned* st) {
    XcdBarrier b; b.bar = bar; b.x = xb_xcc_id(); b.st = st;
    if (threadIdx.x == 0) (void)xb_add(&bar[XB_XCNT(b.x)], 1u);
    return b;
}
__device__ __forceinline__ void xcd_barrier_complete(unsigned* bar, unsigned x, unsigned& nloc, unsigned& nx) {
    const unsigned G = gridDim.x * gridDim.y * gridDim.z;
    unsigned sum, cnt, mine, sp = 0u;
    for (;;) {
        sum = 0u; cnt = 0u; mine = 0u;
#pragma unroll
        for (unsigned j = 0; j < 16; ++j) { const unsigned c = xb_ld(&bar[XB_XCNT(j)]); sum += c; cnt += (c > 0u) ? 1u : 0u; mine = (j == x) ? c : mine; }
        if (sum == G) break;
        __builtin_amdgcn_s_sleep(1);
        if ((++sp & 255u) == 0u) { if (xb_ld(&bar[XB_TMO])) break; if (sp > XB_SPIN_CAP) { atomicAdd(&bar[XB_TMO], 1u); break; } }
    }
    nloc = mine > 0u ? mine : 1u; nx = cnt > 0u ? cnt : 1u;
}

__device__ __forceinline__ void xcd_barrier(const XcdBarrier& b) {
    asm volatile("s_waitcnt vmcnt(0)" ::: "memory");
    __syncthreads();
    if (threadIdx.x == 0) {
        unsigned* bar = b.bar;
        __builtin_amdgcn_s_waitcnt(0);
        unsigned nloc = b.st[0], nx = b.st[1];
        if (nloc == 0u) { xcd_barrier_complete(bar, b.x, nloc, nx); b.st[0] = nloc; b.st[1] = nx; }
        const unsigned old = xb_add(&bar[XB_XSUB(b.x)], 1u);
        const unsigned gen = old / nloc;
        if (old + 1u == (gen + 1u) * nloc) {
            __builtin_amdgcn_fence(__ATOMIC_RELEASE, "agent");
            asm volatile("s_waitcnt vmcnt(0)" ::: "memory");
            const unsigned og = xb_add(&bar[XB_TOP], 1u);
            const unsigned tg = og / nx;
            if (og + 1u == (tg + 1u) * nx) xb_add(&bar[XB_TOPGEN], 1u);
            else XB_SPIN(xb_ld(&bar[XB_TOPGEN]) == tg, bar);
            __builtin_amdgcn_fence(__ATOMIC_ACQUIRE, "agent");
            xb_add(&bar[XB_XGEN(b.x)], 1u);
            asm volatile("s_waitcnt vmcnt(0)" ::: "memory");
        } else {
            XB_SPIN(xb_ld(&bar[XB_XGEN(b.x)]) == gen, bar);
            __builtin_amdgcn_fence(__ATOMIC_ACQUIRE, "agent");
            asm volatile("s_waitcnt vmcnt(0)" ::: "memory");
        }
    }
    __syncthreads();
}

#ifndef REP_OUT
#define REP_OUT 1
#endif
#ifndef REP_XQ
#define REP_XQ 1
#endif
#ifndef REP_XO
#define REP_XO 1
#endif
#ifndef REP_DN
#define REP_DN 1
#endif
#ifndef REP_PRO
#define REP_PRO 1
#endif
#ifndef REP_QKV
#define REP_QKV 1
#endif
#ifndef REP_ATT0
#define REP_ATT0 1
#endif
#ifndef REP_FOX
#define REP_FOX 1
#endif
#ifndef REP_UP
#define REP_UP 1
#endif
#ifndef REP_SYNC
#define REP_SYNC 1
#endif
#ifndef REP_XA
#define REP_XA 1
#endif
struct Args { const float* in[20]; float* out; unsigned char* ws; };

__device__ __forceinline__ unsigned f2bf(float f) { unsigned u = __builtin_bit_cast(unsigned, f); return (u + 0x7fffu + ((u >> 16) & 1u)) >> 16; }
__device__ __forceinline__ unsigned pk2(float lo, float hi) { return f2bf(lo) | (f2bf(hi) << 16); }
__device__ __forceinline__ float wave_sum(float v) {
#pragma unroll
    for (int o = 1; o < 64; o <<= 1) v += __shfl_xor(v, o);
    return v;
}
__device__ __forceinline__ int colmap(int mode, int p) {
    if (mode == 1) { if ((p >= 512 && p < 1024) || (p >= 1536 && p < 2048)) { const int w = p & 63; return (p & ~63) + 32 * ((w >> 4) & 1) + 16 * (w >> 5) + (w & 15); } return p; }
    if (mode == 2) return ((p >> 7) & 1) * 2816 + (p >> 8) * 128 + (p & 127);
    return p;
}
__device__ __forceinline__ void conv_weight(const float* W, int ldw, int K, int Nphys, int Nvalid, int mode, const float* g, bf16_t* WT, LAS float* scr, int gw, int NGW, int lane, int& rot) {
    const int nblk = Nphys / 32, items = (K / 64) * nblk;
    const int g0 = (gw - rot % NGW + NGW) % NGW; rot += items;
    for (int it = g0; it < items; it += NGW) {
        const int kb = it / nblk, nb = it % nblk, k0 = 64 * kb, n0 = 32 * nb;
        const int prow = n0 + (lane & 31); const bool ok = prow < Nvalid; const int col = ok ? colmap(mode, prow) : 0;
        float wv_[32];
#pragma unroll
        for (int i = 0; i < 32; ++i) { const int kk = 2 * i + (lane >> 5); wv_[i] = ok ? W[(size_t)(k0 + kk) * ldw + col] : 0.f; }
#pragma unroll
        for (int i = 0; i < 32; ++i) { const int kk = 2 * i + (lane >> 5); float v = wv_[i]; if (g) v *= g[k0 + kk]; scr[kk * 33 + (lane & 31)] = v; }
        asm volatile("s_waitcnt lgkmcnt(0)" ::: "memory");
        const int c = lane & 7;
#pragma unroll
        for (int j = 0; j < 4; ++j) { const int n = (lane >> 3) + 8 * j; const LAS float* s = scr + (8 * c) * 33 + n;
            u32x4 o; o.x = pk2(s[0 * 33], s[1 * 33]); o.y = pk2(s[2 * 33], s[3 * 33]); o.z = pk2(s[4 * 33], s[5 * 33]); o.w = pk2(s[6 * 33], s[7 * 33]);
            *(u32x4*)(WT + (size_t)(n0 + n) * K + k0 + 8 * c) = o; }
        asm volatile("s_waitcnt lgkmcnt(0)" ::: "memory");
    }
}

template <class Epi>
__device__ __forceinline__ void run_gemm(LAS unsigned char* lds, const bf16_t* A, const bf16_t* Bt, int Mtiles, int N, int K, int a_w1, int a_h, int a_t, const Epi& E, int cshift = 0) {
    pg8::Gemm g{A, Bt, Mtiles * 256, N, K, a_w1, a_h, a_t};
    pg8::StaticOrder So; So.init(Mtiles * 256, N, (int)gridDim.x, (int)blockIdx.x - cshift);
    pg8::gemm_phase<Epi, pg8::StaticOrder, true, true>(lds, g, So, E);
}

template <int MODE>
__device__ __forceinline__ void attn_units(LAS unsigned char* lds, unsigned* counter, int idx0, int nunits, int nheads, int head0, bool head_major, const bf16_t* Q, int ldq, const bf16_t* K, const bf16_t* V, int ldkv, bf16_t* O, int ldo,
                                           const float* cf, const unsigned* kmx, const float* kpart, int* sel = nullptr, float* lse = nullptr) {
    LAS int* slot = (LAS int*)(lds + 147456 - 128);
    for (;;) {
        int idx;
        if (counter) {
            if (threadIdx.x == 0) *slot = (int)__hip_atomic_fetch_add(counter, 1u, __ATOMIC_RELAXED, __HIP_MEMORY_SCOPE_AGENT);
            __syncthreads(); idx = *slot - idx0; __syncthreads();
            if (idx >= nunits) break;
            if (idx < 0) continue;
        } else { idx = (int)blockIdx.x; if (idx >= nunits) break; }
        const int h = head_major ? (nheads - 1 - idx / 64) : (idx % nheads), qb = head_major ? (63 - idx % 64) : (63 - idx / nheads), hh = head0 + h;
        att::AttnArgs a; a.Q = Q + hh * 64; a.ldq = ldq; a.K = K + hh * 64; a.V = V + hh * 64; a.ldkv = ldkv; a.O = O + hh * 64; a.ldo = ldo;
        a.cf = cf ? cf + (size_t)hh * S : nullptr; a.kmax2 = kmx ? (__uint_as_float(kmx[2 * hh]) + __uint_as_float(kmx[2 * hh + 1])) * 1.02f : 0.f;
        a.kpart = kpart ? kpart + (size_t)h * 64 * 256 : nullptr;
        a.sel = sel ? sel + (size_t)h * S * 4 : nullptr; a.lse = lse ? lse + h * 4 + 3 : nullptr;
        if (MODE == att::M_MOBA) { a.O = O + (h * 4 + 3) * 64; }
        att::attn_unit<MODE>(lds, a, qb);
        if (!counter) break;
    }
}

typedef const __attribute__((address_space(4))) char* kargp_t;
__device__ __forceinline__ const void* kin(int i) { size_t o = (size_t)i * 8; asm volatile("" : "+s"(o)); return *(const void* const __attribute__((address_space(4)))*)((kargp_t)__builtin_amdgcn_kernarg_segment_ptr() + o); }
__device__ __forceinline__ unsigned char* wsoff(size_t off) { unsigned char* w = (unsigned char*)kin(21); asm volatile("" : "+s"(off)); return w + off; }
#define INF(i) ((const float*)kin(i))
#define OUTP ((float*)kin(20))
#define WSP(T, off) ((T*)wsoff(off))

#define GSYNC() do { XcdBarrier b_; b_.bar = WSP(unsigned, WS_BAR); b_.x = xb_xcc_id(); b_.st = (volatile LAS unsigned*)(lds + 147456 - 64); xcd_barrier(b_); } while (0)
__global__ void __launch_bounds__(512, 2) fwd_kernel(Args args) {
    extern __shared__ __attribute__((aligned(16))) unsigned char lds_raw[];
    LAS unsigned char* lds = (LAS unsigned char*)lds_raw;
    cg::grid_group grid = cg::this_grid();
    (void)args;
    if (threadIdx.x == 0) { volatile LAS unsigned* st_ = (volatile LAS unsigned*)(lds + 147456 - 64); st_[0] = 0u; st_[1] = 0u; }
#pragma unroll 1
    for (int rep_ = 0; rep_ < REP_PRO; ++rep_) {
        int tid_ = threadIdx.x; asm volatile("" : "+v"(tid_)); const int tid = tid_, lane = tid & 63, wave = __builtin_amdgcn_readfirstlane(tid >> 6);
        const int G = (int)gridDim.x, gw = (int)blockIdx.x * 8 + wave, NGW = G * 8, gt = (int)blockIdx.x * 512 + tid, NGT = G * 512;
        LAS float* scr = (LAS float*)(lds + wave * 16384); int rot = 0;
        conv_weight(INF(7), 3072, 1024, 3072, 3072, 1, INF(3), WSP(bf16_t, WS_WIN0), scr, gw, NGW, lane, rot);
        conv_weight(INF(8), 1024, 1024, 1024, 1024, 0, nullptr, WSP(bf16_t, WS_WOUT0), scr, gw, NGW, lane, rot);
        conv_weight(INF(9), 3088, 1024, 3072, 3072, 0, INF(3) + 1024, WSP(bf16_t, WS_WIN1), scr, gw, NGW, lane, rot);
        { const float* wi = INF(9); const float* gm = INF(3) + 1024; bf16_t* wf = WSP(bf16_t, WS_WFT);
          for (int idx = gt; idx < 32 * 1024; idx += NGT) { const int n = idx >> 10, k = idx & 1023; wf[idx] = (bf16_t)f2bf(n < 16 ? gm[k] * wi[(size_t)k * 3088 + 3072 + n] : 0.f); } }
        conv_weight(INF(11), 1024, 1024, 1024, 1024, 0, nullptr, WSP(bf16_t, WS_WOUT1), scr, gw, NGW, lane, rot);
#pragma unroll 1
        for (int l = 0; l < 2; ++l) {
            conv_weight(INF(12) + (size_t)l * 1024 * 256, 256, 1024, 256, 256, 0, INF(4) + l * 1024, WSP(bf16_t, WS_WXQ) + (size_t)l * 256 * 1024, scr, gw, NGW, lane, rot);
            conv_weight(INF(13) + (size_t)l * 1024 * 512, 512, 1024, 512, 512, 0, nullptr, WSP(bf16_t, WS_WXKV) + (size_t)l * 512 * 1024, scr, gw, NGW, lane, rot);
            conv_weight(INF(14) + (size_t)l * 256 * 1024, 1024, 256, 1024, 1024, 0, nullptr, WSP(bf16_t, WS_WXO) + (size_t)l * 1024 * 256, scr, gw, NGW, lane, rot);
            conv_weight(INF(15) + (size_t)l * 1024 * NUP, NUP, 1024, NUP, NUP, 2, INF(6) + l * 1024, WSP(bf16_t, WS_WUP) + (size_t)l * NUP * 1024, scr, gw, NGW, lane, rot);
            conv_weight(INF(18) + (size_t)l * DFF * 1024, 1024, DFF, 1024, 1024, 0, nullptr, WSP(bf16_t, WS_WDN) + (size_t)l * 1024 * DFF, scr, gw, NGW, lane, rot);
        }
        {
            const float* x = INF(0); float* ssq = WSP(float, WS_SSQ); bf16_t* XB = WSP(bf16_t, WS_XB);
            for (int m = gw; m < S; m += NGW) {
                const f32x4* xr = (const f32x4*)(x + (size_t)m * D) + lane; f32x4 v[4]; float s = 0.f;
#pragma unroll
                for (int j = 0; j < 4; ++j) { v[j] = xr[64 * j]; s += (v[j][0] * v[j][0] + v[j][1] * v[j][1]) + (v[j][2] * v[j][2] + v[j][3] * v[j][3]); }
                s = wave_sum(s); if (lane == 0) ssq[m] = s;
                unsigned long long* o8 = (unsigned long long*)(XB + (size_t)m * D) + lane;
#pragma unroll
                for (int j = 0; j < 4; ++j) o8[64 * j] = (unsigned long long)pk2(v[j][0], v[j][1]) | ((unsigned long long)pk2(v[j][2], v[j][3]) << 32);
            }
            for (int idx = gt; idx < 6 * S; idx += NGT) ssq[S + idx] = 0.f;
            for (int idx = gt; idx < 2 * D / 2; idx += NGT) ((unsigned*)(XB - 2 * D))[idx] = 0u;
            for (int idx = gt; idx < 256 * D / 2; idx += NGT) ((unsigned*)(XB + (size_t)S * D))[idx] = 0u;
            if (gt < 32) WSP(unsigned, WS_KMX)[gt] = 0u;
            if (gt < 128) WSP(unsigned, WS_CNT)[gt] = 0u;
            for (int idx = gt; idx < XCD_BAR_WORDS; idx += NGT) WSP(unsigned, WS_BAR)[idx] = 0u;
        }
        {
            const float* mem = INF(1); const float* g_mem = INF(5); bf16_t* MN = WSP(bf16_t, WS_MN);
            for (int m = gw; m < MEM; m += NGW) {
                const f32x4* xr = (const f32x4*)(mem + (size_t)m * D) + lane; f32x4 v[4]; float s = 0.f;
#pragma unroll
                for (int j = 0; j < 4; ++j) { v[j] = xr[64 * j]; s += (v[j][0] * v[j][0] + v[j][1] * v[j][1]) + (v[j][2] * v[j][2] + v[j][3] * v[j][3]); }
                s = wave_sum(s); const float rs = rsqrtf(s * (1.0f / 1024.0f) + 1e-6f);
#pragma unroll
                for (int l = 0; l < 2; ++l) { unsigned long long* o8 = (unsigned long long*)(MN + ((size_t)l * MEM + m) * D) + lane;
#pragma unroll
                    for (int j = 0; j < 4; ++j) { const f32x4 gg = ((const f32x4*)(g_mem + l * 1024) + lane)[64 * j];
                        o8[64 * j] = (unsigned long long)pk2(v[j][0] * rs * gg[0], v[j][1] * rs * gg[1]) | ((unsigned long long)pk2(v[j][2] * rs * gg[2], v[j][3] * rs * gg[3]) << 32); } }
            }
        }
        {
            const int* pos = (const int*)kin(2); float* ropec = WSP(float, WS_ROPEC); float* ropes = WSP(float, WS_ROPES);
            for (int idx = gt; idx < S * 32; idx += NGT) {
                const int t = idx >> 5, i = idx & 31;
                const float invf = (float)exp2(-(double)i * (13.287712379549449 / 32.0));
                const float ang = (float)pos[t] * invf;
                const double a = (double)ang; const double n = rint(a * 0.63661977236758134308); double rr = fma(-n, 1.57079632679489655800e+00, a); rr = fma(-n, 6.12323399573676603587e-17, rr);
                const double r2 = rr * rr;
                const double sn = rr * (1.0 + r2 * (-1.0 / 6 + r2 * (1.0 / 120 + r2 * (-1.0 / 5040 + r2 * (1.0 / 362880 + r2 * (-1.0 / 39916800 + r2 * (1.0 / 6227020800.0)))))));
                const double cs = 1.0 + r2 * (-0.5 + r2 * (1.0 / 24 + r2 * (-1.0 / 720 + r2 * (1.0 / 40320 + r2 * (-1.0 / 3628800 + r2 * (1.0 / 479001600.0 + r2 * (-1.0 / 87178291200.0)))))));
                const int qd = ((int)(long long)n) & 3;
                const double co = (qd == 0) ? cs : (qd == 1) ? -sn : (qd == 2) ? -cs : sn, si = (qd == 0) ? sn : (qd == 1) ? cs : (qd == 2) ? -sn : -cs;
                ropec[idx] = (float)co; ropes[idx] = (float)si;
            }
        }
    }
    grid.sync();
    if (threadIdx.x == 0) (void)xb_add(&WSP(unsigned, WS_BAR)[XB_XCNT(xb_xcc_id())], 1u);
#pragma unroll 1
    for (int layer = 0; layer < 2; ++layer) {
#pragma unroll 1
        for (int rep_ = 0; rep_ < REP_QKV; ++rep_)
        if (layer == 0) {
            { pg8::EpiQKV0 E{WSP(bf16_t, WS_Q), (size_t)(WS_K - WS_Q) / 2, WSP(float, WS_SSQ), WSP(float, WS_ROPEC), WSP(float, WS_ROPES), WSP(float, WS_KPART)};
              run_gemm(lds, WSP(bf16_t, WS_XB), WSP(bf16_t, WS_WIN0), S / 256, 3072, 1024, 64, 128, 256, E); }
        } else {
            {
                int tid_ = threadIdx.x; asm volatile("" : "+v"(tid_)); const int tid = tid_, lane = tid & 63, wv = __builtin_amdgcn_readfirstlane(tid >> 6), r32 = lane & 31, hi = lane >> 5;
                const bf16_t* XBp = WSP(bf16_t, WS_XB); const bf16_t* WF = WSP(bf16_t, WS_WFT); const float* ssq3 = WSP(float, WS_SSQ) + (size_t)3 * S; const float* bfg = INF(10); float* lf = WSP(float, WS_LOGF);
                LAS float* red = (LAS float*)lds;
                for (int rb = (int)blockIdx.x * 64; rb < S; rb += (int)gridDim.x * 64) {
                    att::f32x16 a0, a1;
#pragma unroll
                    for (int r = 0; r < 16; ++r) { a0[r] = 0.f; a1[r] = 0.f; }
                    pg8::bf16x8 af0[8], af1[8], bfr[8];
#pragma unroll
                    for (int s = 0; s < 8; ++s) { const int ko = wv * 128 + 16 * s + 8 * hi;
                        bfr[s] = *(const pg8::bf16x8*)(WF + (size_t)r32 * 1024 + ko); af0[s] = *(const pg8::bf16x8*)(XBp + (size_t)(rb + r32) * 1024 + ko); af1[s] = *(const pg8::bf16x8*)(XBp + (size_t)(rb + 32 + r32) * 1024 + ko); }
#pragma unroll
                    for (int s = 0; s < 8; ++s) { a0 = __builtin_amdgcn_mfma_f32_32x32x16_bf16(af0[s], bfr[s], a0, 0, 0, 0); a1 = __builtin_amdgcn_mfma_f32_32x32x16_bf16(af1[s], bfr[s], a1, 0, 0, 0); }
                    if (r32 < 16) {
#pragma unroll
                        for (int r = 0; r < 16; ++r) { const int i = (r & 3) + 8 * (r >> 2) + 4 * hi; red[(wv * 64 + i) * 16 + r32] = a0[r]; red[(wv * 64 + 32 + i) * 16 + r32] = a1[r]; }
                    }
                    __syncthreads();
                    for (int o = tid; o < 1024; o += 512) { const int tok = o >> 4, h = o & 15; float sum = 0.f;
#pragma unroll
                        for (int w = 0; w < 8; ++w) sum += red[(w * 64 + tok) * 16 + h];
                        const int row = rb + tok; const float x = sum * pg8::rstd_of(ssq3, row) + bfg[h];
                        lf[(size_t)h * S + row] = fminf(x, 0.f) - log1pf(expf(-fabsf(x))); }
                    __syncthreads();
                }
            }
            pg8::EpiBf E{WSP(bf16_t, WS_Q), 1024, WSP(float, WS_SSQ) + (size_t)3 * S, 4, (size_t)(WS_K - WS_Q) / 2, nullptr, nullptr, WSP(unsigned, WS_KMX)};
            run_gemm(lds, WSP(bf16_t, WS_XB), WSP(bf16_t, WS_WIN1), S / 256, 3072, 1024, 64, 128, 256, E);
        }
        GSYNC();
        if (layer == 0) {
            attn_units<att::M_MOBA>(lds, WSP(unsigned, WS_CNT), 0, 512, 8, 8, false, WSP(bf16_t, WS_Q), 1024, WSP(bf16_t, WS_K), WSP(bf16_t, WS_V), 1024, (bf16_t*)OUTP, 2048, nullptr, nullptr, WSP(float, WS_KPART), WSP(int, WS_SEL), WSP(float, WS_LSE));
            attn_units<att::M_SB>(lds, WSP(unsigned, WS_CNT) + 32, 0, 512, 8, 0, false, WSP(bf16_t, WS_Q), 1024, WSP(bf16_t, WS_K), WSP(bf16_t, WS_V), 1024, WSP(bf16_t, WS_O), 1024, nullptr, nullptr, nullptr);
            GSYNC();
            {
                LAS int* slot = (LAS int*)(lds + 147456 - 128);
                for (;;) {
                    if (threadIdx.x == 0) *slot = (int)__hip_atomic_fetch_add(WSP(unsigned, WS_CNT) + 96, 1u, __ATOMIC_RELAXED, __HIP_MEMORY_SCOPE_AGENT);
                    __syncthreads(); const int idx = *slot; __syncthreads();
                    if (idx >= 1248) break;
                    const int h8 = idx & 7; int u = idx >> 3, j = 0;
                    while (u >= ((63 - j + 15) >> 4)) { u -= ((63 - j + 15) >> 4); ++j; }
                    const int b0 = j + 1 + 16 * u, b1 = (b0 + 16 < 64) ? b0 + 16 : 64;
                    att::moba_routed_unit(lds, WSP(bf16_t, WS_Q) + (8 + h8) * 64, WSP(bf16_t, WS_K) + (8 + h8) * 64, WSP(bf16_t, WS_V) + (8 + h8) * 64, WSP(int, WS_SEL) + (size_t)h8 * S * 4,
                                          (bf16_t*)OUTP + h8 * 4 * 64, WSP(float, WS_LSE) + h8 * 4, j, b0, b1);
                }
            }
            GSYNC();
            {
                int tid_ = threadIdx.x; asm volatile("" : "+v"(tid_)); const int tid = tid_, lane = tid & 63, wave = __builtin_amdgcn_readfirstlane(tid >> 6);
                const int gw = (int)blockIdx.x * 8 + wave, NGW = (int)gridDim.x * 8;
                const bf16_t* part = (const bf16_t*)OUTP; const float* lse = WSP(float, WS_LSE); bf16_t* Ob = WSP(bf16_t, WS_O);
                for (int p = gw * 8 + (lane >> 3); p < S * 8; p += NGW * 8) {
                    const int t = p >> 3, h8 = p & 7, ch = lane & 7; const int own = t >> 8, nv = own < 3 ? own : 3;
                    const f32x4 ls = *(const f32x4*)(lse + (size_t)p * 4);
                    float mx = ls[3];
                    if (nv > 0) mx = fmaxf(mx, ls[0]); if (nv > 1) mx = fmaxf(mx, ls[1]); if (nv > 2) mx = fmaxf(mx, ls[2]);
                    const float w0 = nv > 0 ? __builtin_amdgcn_exp2f(ls[0] - mx) : 0.f, w1 = nv > 1 ? __builtin_amdgcn_exp2f(ls[1] - mx) : 0.f, w2 = nv > 2 ? __builtin_amdgcn_exp2f(ls[2] - mx) : 0.f, w3 = __builtin_amdgcn_exp2f(ls[3] - mx);
                    const float wi = 1.0f / ((w0 + w1) + (w2 + w3));
                    float acc8[8];
#pragma unroll
                    for (int e = 0; e < 8; ++e) acc8[e] = 0.f;
#pragma unroll
                    for (int s = 0; s < 4; ++s) {
                        const float w = (s == 0) ? w0 : (s == 1) ? w1 : (s == 2) ? w2 : w3;
                        if (s == 3 || s < nv) {
                            const pg8::bf16x8 v = *(const pg8::bf16x8*)(part + ((size_t)p * 4 + s) * 64 + ch * 8);
#pragma unroll
                            for (int e = 0; e < 8; ++e) acc8[e] += w * att::bf2f(v[e]);
                        }
                    }
                    pg8::store8(Ob + (size_t)t * 1024 + (8 + h8) * 64 + ch * 8, (f32x4){acc8[0] * wi, acc8[1] * wi, acc8[2] * wi, acc8[3] * wi}, (f32x4){acc8[4] * wi, acc8[5] * wi, acc8[6] * wi, acc8[7] * wi});
                }
            }
        } else {
            {
                int tid_ = threadIdx.x; asm volatile("" : "+v"(tid_)); const int tid = tid_, lane = tid & 63, wv = tid >> 6;
                LAS double* sc = (LAS double*)lds;
                for (int wgi = (int)blockIdx.x; wgi < 256; wgi += (int)gridDim.x) {
                    const int h = wgi >> 4, seg = wgi & 15;
                    const float* src = WSP(float, WS_LOGF) + (size_t)h * S;
                    double part = 0.0;
                    for (int i = tid; i < seg * 1024; i += 512) part += (double)src[i];
#pragma unroll
                    for (int o = 32; o >= 1; o >>= 1) part += __shfl_xor(part, o);
                    const int e0 = seg * 1024 + 2 * tid; const double a = (double)src[e0], b = (double)src[e0 + 1];
                    double incl = a + b;
#pragma unroll
                    for (int o = 1; o < 64; o <<= 1) { const double t = __shfl_up(incl, o); if (lane >= o) incl += t; }
                    if (lane == 0) sc[wv] = part;
                    if (lane == 63) sc[8 + wv] = incl;
                    __syncthreads();
                    double before = 0.0;
#pragma unroll
                    for (int k = 0; k < 8; ++k) before += sc[k];
                    for (int k = 0; k < wv; ++k) before += sc[8 + k];
                    const double excl = before + (incl - (a + b));
                    float* dst = WSP(float, WS_CF) + (size_t)h * S + e0;
                    dst[0] = (float)(excl + a); dst[1] = (float)(excl + a + b);
                    __syncthreads();
                }
            }
            GSYNC();
#pragma unroll 1
            for (int rep_ = 0; rep_ < REP_FOX; ++rep_)
            attn_units<att::M_FOX>(lds, WSP(unsigned, WS_CNT) + 64, 0, 1024, 16, 0, true, WSP(bf16_t, WS_Q), 1024, WSP(bf16_t, WS_K), WSP(bf16_t, WS_V), 1024, WSP(bf16_t, WS_O), 1024, WSP(float, WS_CF), WSP(unsigned, WS_KMX), nullptr);
        }
        GSYNC();
#pragma unroll 1
        for (int rep_ = REP_OUT - 1; rep_ >= 0; --rep_)
        { pg8::EpiRes E{(layer == 0 && rep_ == 0) ? INF(0) : (const float*)OUTP, OUTP, WSP(bf16_t, WS_XB), rep_ ? WSP(float, WS_DUMMY) : WSP(float, WS_SSQ) + (size_t)(3 * layer + 1) * S, rep_ ? 0.0f : (layer == 0 ? SC_MIX0 : SC_MIX1)};
          run_gemm(lds, WSP(bf16_t, WS_O), layer == 0 ? WSP(bf16_t, WS_WOUT0) : WSP(bf16_t, WS_WOUT1), S / 256, 1024, 1024, 64, 128, 256, E); }
        GSYNC();
#pragma unroll 1
        for (int rep_ = 0; rep_ < REP_XQ; ++rep_)
        { pg8::EpiBf E{WSP(bf16_t, WS_XQ), 256, WSP(float, WS_SSQ) + (size_t)(3 * layer + 1) * S, 0, 0, nullptr, nullptr, nullptr};
          run_gemm(lds, WSP(bf16_t, WS_XB), WSP(bf16_t, WS_WXQ) + (size_t)layer * 256 * 1024, S / 256, 256, 1024, 64, 128, 256, E); }
        if (layer == 0 && (int)blockIdx.x >= 64 && (int)blockIdx.x < 68) {
            const int l = ((int)blockIdx.x - 64) >> 1;
            pg8::EpiBf E2{WSP(bf16_t, WS_MKV) + (size_t)l * MEM * 512, 512, nullptr, 0, 0, nullptr, nullptr, nullptr};
            run_gemm(lds, WSP(bf16_t, WS_MN) + (size_t)l * MEM * D, WSP(bf16_t, WS_WXKV) + (size_t)l * 512 * 1024, 1, 512, 1024, 64, 128, 256, E2, 64 + 2 * l);
        }
        GSYNC();
#pragma unroll 1
        for (int rep_ = 0; rep_ < REP_XA; ++rep_)
        attn_units<att::M_XA>(lds, nullptr, 0, 256, 4, 0, false, WSP(bf16_t, WS_XQ), 256, WSP(bf16_t, WS_MKV) + (size_t)layer * MEM * 512, WSP(bf16_t, WS_MKV) + (size_t)layer * MEM * 512 + 256, 512, WSP(bf16_t, WS_XO), 256, nullptr, nullptr, nullptr);
        GSYNC();
#pragma unroll 1
        for (int rep_ = REP_XO - 1; rep_ >= 0; --rep_)
        { pg8::EpiRes E{OUTP, OUTP, WSP(bf16_t, WS_XB), rep_ ? WSP(float, WS_DUMMY) : WSP(float, WS_SSQ) + (size_t)(3 * layer + 2) * S, rep_ ? 0.0f : SC_XA};
          run_gemm(lds, WSP(bf16_t, WS_XO), WSP(bf16_t, WS_WXO) + (size_t)layer * 1024 * 256, S / 256, 1024, 256, 64, 128, 256, E); }
        GSYNC();
#pragma unroll 1
        for (int rep_ = 0; rep_ < REP_UP; ++rep_)
        { pg8::EpiUpConv E{WSP(bf16_t, WS_ACT), WSP(float, WS_SSQ) + (size_t)(3 * layer + 2) * S, INF(16) + (size_t)layer * 3 * NUP, INF(17) + (size_t)layer * NUP};
          run_gemm(lds, WSP(bf16_t, WS_XB) - 2 * D, WSP(bf16_t, WS_WUP) + (size_t)layer * NUP * 1024, 66, NUP, 1024, 126, 64, 252, E); }
        GSYNC();
#pragma unroll 1
        for (int rep_ = REP_DN - 1; rep_ >= 0; --rep_)
        { pg8::EpiRes E{OUTP, OUTP, layer == 1 ? (bf16_t*)nullptr : WSP(bf16_t, WS_XB), rep_ ? WSP(float, WS_DUMMY) : WSP(float, WS_SSQ) + (size_t)(3 * layer + 3) * S, rep_ ? 0.0f : SC_FFN};
          run_gemm(lds, WSP(bf16_t, WS_ACT), WSP(bf16_t, WS_WDN) + (size_t)layer * 1024 * DFF, S / 256, 1024, DFF, 64, 128, 256, E); }
        GSYNC();
#pragma unroll 1
        for (int rep_ = 1; rep_ < REP_SYNC; ++rep_) { GSYNC(); GSYNC(); GSYNC(); GSYNC(); GSYNC(); }
    }
    {
        int tid_ = threadIdx.x; asm volatile("" : "+v"(tid_)); const int tid = tid_, lane = tid & 63, wave = __builtin_amdgcn_readfirstlane(tid >> 6);
        const int gw = (int)blockIdx.x * 8 + wave, NGW = (int)gridDim.x * 8;
        const float* ssq_fin = WSP(float, WS_SSQ) + (size_t)6 * S; const float* gf = INF(19); float* out = OUTP;
        for (int m = gw; m < S; m += NGW) {
            const float rs = rsqrtf(ssq_fin[m] * (1.0f / 1024.0f) + 1e-6f);
            f32x4* xr = (f32x4*)(out + (size_t)m * D) + lane;
#pragma unroll
            for (int j = 0; j < 4; ++j) { const f32x4 gg = ((const f32x4*)gf + lane)[64 * j]; xr[64 * j] = xr[64 * j] * rs * gg; }
        }
    }
}

extern "C" void kernel_launch(void* const* d_in, const int* in_sizes, int n_in, void* d_out, int out_size, void* d_ws, size_t ws_size, hipStream_t stream) {
    static int grid = 0;
    constexpr int LDSB = 147456;
    if (grid == 0) {
        if (n_in != 20 || out_size != S * D || ws_size < WS_END) { fprintf(stderr, "kernel_launch: unexpected shapes (n_in %d out %d ws %zu)\n", n_in, out_size, ws_size); grid = -1; return; }
        int dev = 0, cus = 0, per = 0;
        hipGetDevice(&dev); hipDeviceGetAttribute(&cus, hipDeviceAttributeMultiprocessorCount, dev);
        hipFuncSetAttribute((const void*)fwd_kernel, hipFuncAttributeMaxDynamicSharedMemorySize, LDSB);
        hipOccupancyMaxActiveBlocksPerMultiprocessor(&per, (const void*)fwd_kernel, 512, LDSB);
        (void)hipGetLastError();
        grid = cus;
        if (per < 1) fprintf(stderr, "kernel_launch: occupancy query reports %d blocks/CU\n", per);
    }
    if (grid < 0) return;
    Args a{};
    for (int i = 0; i < 20; ++i) a.in[i] = (const float*)d_in[i];
    a.out = (float*)d_out; a.ws = (unsigned char*)d_ws;
    void* kargs[] = {&a};
    hipError_t e = hipLaunchCooperativeKernel((const void*)fwd_kernel, dim3(grid), dim3(512), kargs, LDSB, stream);
    if (e != hipSuccess) fprintf(stderr, "cooperative launch failed: %s (grid %d)\n", hipGetErrorString(e), grid);
}
```

```cpp
#include <hip/hip_runtime.h>
#include <hip/hip_cooperative_groups.h>
#include <cstdio>
#include <cstdint>
namespace cg = cooperative_groups;
namespace pg8 {
#define PG8_LAS __attribute__((address_space(3)))
typedef unsigned short bf16_t;
typedef short bf16x8 __attribute__((ext_vector_type(8)));
typedef float f32x4 __attribute__((ext_vector_type(4)));
typedef unsigned u32x4 __attribute__((ext_vector_type(4)));
constexpr int BM = 256, BK = 64, HALF = 128, HTB = HALF * BK * 2  , STAGE_BYTES = 8 * HTB, NXCD = 8, WGM = 8;

__host__ __device__ __forceinline__ int lds_byte(int r, int c) { const int st = (r >> 4) * 2 + (c >> 5), rr = r & 15, cc = c & 31, ob = rr * 64 + cc * 2; return st * 1024 + (ob ^ (((ob >> 9) & 1) << 5)); }
__host__ __device__ __forceinline__ void stage_rc(int b, int& R, int& C) { const int st = b / 1024, sb = b % 1024, swz = sb ^ (((sb >> 9) & 1) << 5); R = (st >> 1) * 16 + swz / 64; C = (st & 1) * 32 + (swz % 64) / 2; }
__host__ __device__ __forceinline__ int perm32(int rho) { const int n = rho >> 4, i = rho & 15; return 8 * (i >> 2) + 4 * n + (i & 3); }

struct Unit { int pm, pn; };
struct Gemm { const bf16_t* A; const bf16_t* Bt; int M, N, K; int a_w1, a_h, a_t; };

struct StaticOrder {
    int nM, nN, nwg, G, c;
    __host__ __device__ void init(int M, int N, int G_, int c_) { nM = M / BM; nN = N / BM; nwg = nM * nN; G = G_; c = c_; }
    __host__ __device__ bool next(int i, Unit& u) const {
        const long L = (long)i * G + c; if (L >= nwg) return false;
        int wgid = (int)L; { const int q = nwg / NXCD, r = nwg % NXCD, xcd = wgid % NXCD, off = wgid / NXCD; wgid = (xcd < r ? xcd * (q + 1) : r * (q + 1) + (xcd - r) * q) + off; }
        const int nig = WGM * nN, gid = wgid / nig, fm = gid * WGM, gsz = (nM - fm) < WGM ? (nM - fm) : WGM;
        u.pm = fm + ((wgid % nig) % gsz); u.pn = (wgid % nig) / gsz; return true;
    }
    __device__ __forceinline__ void a_ready(const Unit&) const {}
    __device__ __forceinline__ void done(const Unit&) const {}
};

typedef unsigned u32x2 __attribute__((ext_vector_type(2)));
__device__ __forceinline__ unsigned cvt_pk_bf16(float lo, float hi) { unsigned r; asm volatile("v_cvt_pk_bf16_f32 %0, %1, %2" : "=v"(r) : "v"(lo), "v"(hi)); return r; }
__device__ __forceinline__ void store4(bf16_t* p, f32x4 v) { u32x2 w; w.x = cvt_pk_bf16(v[0], v[1]); w.y = cvt_pk_bf16(v[2], v[3]); *(u32x2*)p = w; }
__device__ __forceinline__ void store8(bf16_t* p, f32x4 a, f32x4 b) { u32x4 w; w.x = cvt_pk_bf16(a[0], a[1]); w.y = cvt_pk_bf16(a[2], a[3]); w.z = cvt_pk_bf16(b[0], b[1]); w.w = cvt_pk_bf16(b[2], b[3]); *(u32x4*)p = w; }
__device__ __forceinline__ float rstd_of(const float* ssq, int row) { return rsqrtf(ssq[row] * (1.0f / 1024.0f) + 1e-6f); }
constexpr int SEQ = 16384;

struct EpiQKV0 {
    static constexpr bool PERM = false, AFTER_DRAIN = false;
    bf16_t* Q; size_t tstride; const float* ssq; const float* ropec; const float* ropes; float* kpart;
    __device__ __forceinline__ void operator()(const f32x4 (&acc)[2][2][4][2], const Unit& u, int wr, int wc, int fr, int fq) const {
        const int t = u.pn >> 2, pq = u.pn & 3;
        bf16_t* base = Q + (size_t)t * tstride;
        const bool rope = (t < 2) && (pq >= 2);
#pragma unroll
        for (int ai = 0; ai < 2; ++ai) {
            f32x4 ks00 = (f32x4){0.f, 0.f, 0.f, 0.f}, ks01 = ks00, ks10 = ks00, ks11 = ks00;
#pragma unroll
            for (int m = 0; m < 4; ++m) {
                const int row = u.pm * 256 + ai * 128 + wr * 64 + m * 16 + fr;
                const float rs = rstd_of(ssq, row);
#pragma unroll
                for (int bj = 0; bj < 2; ++bj) {
                    const int hcol = pq * 256 + bj * 128 + (wc >> 1) * 64;
                    const f32x4 v0 = acc[ai][bj][m][0] * rs, v1 = acc[ai][bj][m][1] * rs;
                    bf16_t* rp = base + (size_t)row * 1024 + hcol;
                    if (rope) {
                        const int i0 = 16 * (wc & 1) + 4 * fq;
                        const f32x4 c = *(const f32x4*)(ropec + (size_t)row * 32 + i0), s = *(const f32x4*)(ropes + (size_t)row * 32 + i0);
                        const f32x4 o1 = v0 * c - v1 * s, o2 = v1 * c + v0 * s;
                        store4(rp + i0, o1); store4(rp + 32 + i0, o2);
                        if (bj == 0) { ks00 += o1; ks01 += o2; } else { ks10 += o1; ks11 += o2; }
                    } else {
                        const int d0 = 32 * (wc & 1) + 4 * fq;
                        store4(rp + d0, v0); store4(rp + d0 + 16, v1);
                    }
                }
            }
            if (rope && t == 1) {
#define KSRED(s_, bj_, n_) do { f32x4 s = s_; _Pragma("unroll") for (int o = 1; o < 16; o <<= 1) { s[0] += __shfl_xor(s[0], o); s[1] += __shfl_xor(s[1], o); s[2] += __shfl_xor(s[2], o); s[3] += __shfl_xor(s[3], o); } \
                if (fr == 0) { const int h8 = (pq - 2) * 4 + (bj_) * 2 + (wc >> 1); *(f32x4*)(kpart + (((size_t)h8 * 64 + u.pm) * 4 + ai * 2 + wr) * 64 + 32 * (n_) + 16 * (wc & 1) + 4 * fq) = s; } } while (0)
                KSRED(ks00, 0, 0); KSRED(ks01, 0, 1); KSRED(ks10, 1, 0); KSRED(ks11, 1, 1);
#undef KSRED
            }
        }
    }
};

struct EpiBf {
    static constexpr bool PERM = true, AFTER_DRAIN = false;
    bf16_t* O; int ldc; const float* ssq; int split_tiles; size_t split_stride; float* logf; const float* bfg; unsigned* kmx;
    __device__ __forceinline__ void operator()(const f32x4 (&acc)[2][2][4][2], const Unit& u, int wr, int wc, int fr, int fq) const {
        int pn = u.pn; bf16_t* base = O; int t = 0;
        if (split_tiles) { t = pn / split_tiles; pn -= t * split_tiles; base += (size_t)t * split_stride; }
        if (logf && t == 3) {
            if (wc == 0 && fq < 2) {
#pragma unroll
                for (int ai = 0; ai < 2; ++ai)
#pragma unroll
                    for (int m = 0; m < 4; ++m) { const int row = u.pm * 256 + ai * 128 + wr * 64 + m * 16 + fr; const float rs = rstd_of(ssq, row);
#pragma unroll
                        for (int n = 0; n < 2; ++n)
#pragma unroll
                            for (int j = 0; j < 4; ++j) { const int h = 8 * fq + 4 * n + j; const float x = acc[ai][0][m][n][j] * rs + bfg[h];
                                logf[(size_t)h * SEQ + row] = fminf(x, 0.f) - log1pf(expf(-fabsf(x))); } }
            }
            return;
        }
        const bool domax = (kmx != nullptr) && (t == 1);
        float mx0 = 0.f, mx1 = 0.f;
#pragma unroll
        for (int ai = 0; ai < 2; ++ai)
#pragma unroll
            for (int m = 0; m < 4; ++m) { const int row = u.pm * 256 + ai * 128 + wr * 64 + m * 16 + fr; const float rs = ssq ? rstd_of(ssq, row) : 1.0f;
                bf16_t* rp = base + (size_t)row * ldc + pn * 256 + wc * 32 + 8 * fq;
#pragma unroll
                for (int bj = 0; bj < 2; ++bj) { const f32x4 v0 = acc[ai][bj][m][0] * rs, v1 = acc[ai][bj][m][1] * rs; store8(rp + bj * 128, v0, v1);
                    if (domax) { float q = (v0[0] * v0[0] + v0[1] * v0[1]) + (v0[2] * v0[2] + v0[3] * v0[3]) + (v1[0] * v1[0] + v1[1] * v1[1]) + (v1[2] * v1[2] + v1[3] * v1[3]);
                        q += __shfl_xor(q, 16); q += __shfl_xor(q, 32); if (bj == 0) mx0 = fmaxf(mx0, q); else mx1 = fmaxf(mx1, q); } }
            }
        if (domax) {
#pragma unroll
            for (int o = 1; o < 16; o <<= 1) { mx0 = fmaxf(mx0, __shfl_xor(mx0, o)); mx1 = fmaxf(mx1, __shfl_xor(mx1, o)); }
            if (fr == 0 && fq == 0) { const int h0 = pn * 4 + (wc >> 1);
                atomicMax(kmx + (h0 * 2 + (wc & 1)), __float_as_uint(mx0)); atomicMax(kmx + ((h0 + 2) * 2 + (wc & 1)), __float_as_uint(mx1)); }
        }
    }
};

struct EpiRes {
    static constexpr bool PERM = false, AFTER_DRAIN = false;
    const float* Hin; float* Hout; bf16_t* XB; float* ssq; float sc;
    __device__ __forceinline__ void operator()(const f32x4 (&acc)[2][2][4][2], const Unit& u, int wr, int wc, int fr, int fq) const {
#pragma unroll
        for (int ai = 0; ai < 2; ++ai)
#pragma unroll
            for (int m = 0; m < 4; ++m) { const int row = u.pm * 256 + ai * 128 + wr * 64 + m * 16 + fr; float sq = 0.f;
                const size_t off = (size_t)row * 1024 + u.pn * 256 + wc * 32 + 4 * fq;
#pragma unroll
                for (int bj = 0; bj < 2; ++bj)
#pragma unroll
                    for (int n = 0; n < 2; ++n) { const size_t o = off + bj * 128 + n * 16; const f32x4 h = *(const f32x4*)(Hin + o) + acc[ai][bj][m][n] * sc;
                        *(f32x4*)(Hout + o) = h; if (XB) store4(XB + o, h); sq += (h[0] * h[0] + h[1] * h[1]) + (h[2] * h[2] + h[3] * h[3]); }
                sq += __shfl_xor(sq, 16); sq += __shfl_xor(sq, 32);
                if (fq == 0) __hip_atomic_fetch_add(ssq + row, sq, __ATOMIC_RELAXED, __HIP_MEMORY_SCOPE_AGENT);
            }
    }
};

__device__ __forceinline__ float dpp_ror1(float x) { float r; asm volatile("s_nop 1\n\tv_mov_b32_dpp %0, %1 row_ror:1 row_mask:0xf bank_mask:0xf" : "=v"(r) : "v"(x)); return r; }
__device__ __forceinline__ float dpp_ror2(float x) { float r; asm volatile("s_nop 1\n\tv_mov_b32_dpp %0, %1 row_ror:2 row_mask:0xf bank_mask:0xf" : "=v"(r) : "v"(x)); return r; }
struct EpiUpConv {
    static constexpr bool PERM = true, AFTER_DRAIN = false;
    bf16_t* ACT; const float* ssq; const float* cw; const float* cb;
    __device__ __forceinline__ void operator()(const f32x4 (&acc)[2][2][4][2], const Unit& u, int wr, int wc, int fr, int fq) const {
        const int g0 = 252 * u.pm - 2 + 126 * wr + fr;
        float rs[8];
#pragma unroll
        for (int q = 0; q < 8; ++q) { int r = g0 + 16 * q; r = r < 0 ? 0 : (r > SEQ - 1 ? SEQ - 1 : r); rs[q] = rstd_of(ssq, r); }
#pragma unroll
        for (int n = 0; n < 2; ++n) {
            const int col = 128 * u.pn + 32 * wc + 8 * fq + 4 * n;
            const f32x4 wg0 = *(const f32x4*)(cw + col), wg1 = *(const f32x4*)(cw + 5632 + col), wg2 = *(const f32x4*)(cw + 2 * 5632 + col), bg = *(const f32x4*)(cb + col);
            const f32x4 wv0 = *(const f32x4*)(cw + 2816 + col), wv1 = *(const f32x4*)(cw + 5632 + 2816 + col), wv2 = *(const f32x4*)(cw + 2 * 5632 + 2816 + col), bv = *(const f32x4*)(cb + 2816 + col);
            f32x4 pg = (f32x4){0.f, 0.f, 0.f, 0.f}, pv = (f32x4){0.f, 0.f, 0.f, 0.f};
#pragma unroll
            for (int q = 0; q < 8; ++q) {
                const f32x4 ug = acc[q >> 2][0][q & 3][n] * rs[q], uv = acc[q >> 2][1][q & 3][n] * rs[q];
                f32x4 res;
#pragma unroll
                for (int j = 0; j < 4; ++j) {
                    const float ga1 = dpp_ror1(ug[j]), gb1 = dpp_ror1(pg[j]), ga2 = dpp_ror2(ug[j]), gb2 = dpp_ror2(pg[j]);
                    const float va1 = dpp_ror1(uv[j]), vb1 = dpp_ror1(pv[j]), va2 = dpp_ror2(uv[j]), vb2 = dpp_ror2(pv[j]);
                    const float g1 = fr >= 1 ? ga1 : gb1, g2 = fr >= 2 ? ga2 : gb2, v1 = fr >= 1 ? va1 : vb1, v2 = fr >= 2 ? va2 : vb2;
                    const float cgv = bg[j] + wg0[j] * g2 + wg1[j] * g1 + wg2[j] * ug[j];
                    const float cvv = bv[j] + wv0[j] * v2 + wv1[j] * v1 + wv2[j] * uv[j];
                    res[j] = cgv * __builtin_amdgcn_rcpf(1.0f + __builtin_amdgcn_exp2f(-1.44269504f * cgv)) * cvv;
                }
                pg = ug; pv = uv;
                const int row = g0 + 16 * q;
                if ((q > 0 || fr >= 2) && row < SEQ) store4(ACT + (size_t)row * 2816 + col, res);
            }
        }
    }
};
template <class Epi, class Sched, bool ALIGN_EPI = false, bool SP2 = false>
__device__ __forceinline__ void gemm_phase(PG8_LAS unsigned char* lds, const Gemm g, const Sched& S, const Epi& E) {
    int tid_ = threadIdx.x; asm volatile("" : "+v"(tid_)); const int tid = tid_, wid = __builtin_amdgcn_readfirstlane(tid >> 6), lane = tid & 63, wr = wid >> 2, wc = wid & 3, fr = lane & 15, fq = lane >> 4;
    const int K = g.K, nt = K / BK;
    unsigned voffA[2], voffB[2];
#pragma unroll
    for (int i = 0; i < 2; ++i) { int R, C; stage_rc(tid * 16 + i * 8192, R, C); const int Rb = Epi::PERM ? ((R & ~31) + perm32(R & 31)) : R;
        voffA[i] = (unsigned)(((R >= 64 ? g.a_w1 : 0) + (R & 63)) * K + C) * 2u; voffB[i] = (unsigned)(Rb * K + C) * 2u; }
    const size_t kstep = (size_t)(BK * 2);
    const size_t hstep = (size_t)HALF * K * 2;
    const size_t tstep = 2 * hstep; const size_t hstepA = (size_t)g.a_h * K * 2, tstepA = (size_t)g.a_t * K * 2;
    const unsigned ldsw = (unsigned)wid * 1024u;
    const int aoff = lds_byte(wr * 64 + fr, fq * 8), boff = lds_byte(wc * 32 + fr, fq * 8);
#define PG8_SA(b, h) (((b) * 2 + (h)) * HTB)
#define PG8_SB(b, h) ((4 + (b) * 2 + (h)) * HTB)
#define PG8_STAGE(bufoff, gbase, voff) do { _Pragma("unroll") for (int _i = 0; _i < 2; ++_i) \
        __builtin_amdgcn_global_load_lds((const unsigned*)((const char*)(gbase) + (voff)[_i]), (PG8_LAS unsigned*)(lds + (bufoff) + ldsw + _i * 8192), 16, 0, 0); } while (0)
#define PG8_LDA(dst, b, h) do { _Pragma("unroll") for (int m = 0; m < 4; ++m) _Pragma("unroll") for (int k = 0; k < 2; ++k) dst[m][k] = *(const PG8_LAS bf16x8*)(lds + PG8_SA(b, h) + aoff + m * 2048 + k * 1024); } while (0)
#define PG8_LDB(dst, b, h) do { _Pragma("unroll") for (int n = 0; n < 2; ++n) _Pragma("unroll") for (int k = 0; k < 2; ++k) dst[n][k] = *(const PG8_LAS bf16x8*)(lds + PG8_SB(b, h) + boff + n * 2048 + k * 1024); } while (0)
#define PG8_MMA(ai, bj, At, Bt) do { __builtin_amdgcn_s_setprio(1); _Pragma("unroll") for (int m = 0; m < 4; ++m) _Pragma("unroll") for (int n = 0; n < 2; ++n) _Pragma("unroll") for (int k = 0; k < 2; ++k) \
        acc[ai][bj][m][n] = __builtin_amdgcn_mfma_f32_16x16x32_bf16(Bt[n][k], At[m][k], acc[ai][bj][m][n], 0, 0, 0); __builtin_amdgcn_s_setprio(0); } while (0)
#define PG8_WAIT_V(n) asm volatile("s_waitcnt vmcnt(" #n ")" ::: "memory")
#define PG8_WAIT_L(n) asm volatile("s_waitcnt lgkmcnt(" #n ")" ::: "memory")
#define PG8_BAR __builtin_amdgcn_s_barrier()
#define PG8_SCHED __builtin_amdgcn_sched_barrier(0)
    Unit cur, nxt; int ui = 0;
    if (!S.next(0, cur)) return;
    f32x4 acc[2][2][4][2];
#pragma unroll
    for (int a = 0; a < 2; ++a)
#pragma unroll
        for (int b = 0; b < 2; ++b)
#pragma unroll
            for (int m = 0; m < 4; ++m)
#pragma unroll
                for (int n = 0; n < 2; ++n) acc[a][b][m][n] = (f32x4){0.f, 0.f, 0.f, 0.f};
    bf16x8 At[4][2], B0[2][2], B1[2][2];
    const char* cA = (const char*)g.A + (size_t)cur.pm * tstepA; const char* cB = (const char*)g.Bt + (size_t)cur.pn * tstep;
    S.a_ready(cur);
    if constexpr (SP2) {
        PG8_STAGE(PG8_SB(0, 0), cB, voffB); PG8_STAGE(PG8_SB(0, 1), cB + hstep, voffB); PG8_STAGE(PG8_SA(0, 0), cA, voffA); PG8_STAGE(PG8_SA(0, 1), cA + hstepA, voffA);
        if (wr == 1) PG8_BAR;
        PG8_WAIT_V(2); PG8_BAR;
        PG8_STAGE(PG8_SB(1, 0), cB + kstep, voffB); PG8_STAGE(PG8_SA(1, 0), cA + kstep, voffA); PG8_STAGE(PG8_SB(1, 1), cB + hstep + kstep, voffB);
        PG8_WAIT_V(6); PG8_BAR;
    } else {
        PG8_STAGE(PG8_SB(0, 0), cB, voffB); PG8_STAGE(PG8_SA(0, 0), cA, voffA); PG8_STAGE(PG8_SB(0, 1), cB + hstep, voffB); PG8_STAGE(PG8_SA(0, 1), cA + hstepA, voffA);
        if (wr == 1) PG8_BAR;
        PG8_WAIT_V(4); PG8_BAR;
        PG8_STAGE(PG8_SB(1, 0), cB + kstep, voffB); PG8_STAGE(PG8_SA(1, 0), cA + kstep, voffA); PG8_STAGE(PG8_SB(1, 1), cB + hstep + kstep, voffB);
        PG8_WAIT_V(6); PG8_BAR;
    }
    for (;;) {
        const bool has_next = S.next(ui + 1, nxt);
        const char* nA = has_next ? (const char*)g.A + (size_t)nxt.pm * tstepA : cA; const char* nB = has_next ? (const char*)g.Bt + (size_t)nxt.pn * tstep : cB;
        for (int t = 0; t < nt; t += 2) {
            const bool last = (t == nt - 2);
            const char* a1 = cA + (size_t)(t + 1) * kstep;
            const char* a2 = last ? nA : cA + (size_t)(t + 2) * kstep; const char* b2 = last ? nB : cB + (size_t)(t + 2) * kstep;
            const char* a3 = a2 + kstep; const char* b3 = b2 + kstep;
            if (last && has_next) S.a_ready(nxt);
            if constexpr (SP2) {
            PG8_LDB(B0, 0, 0); PG8_LDB(B1, 0, 1); PG8_SCHED; PG8_LDA(At, 0, 0); PG8_STAGE(PG8_SA(1, 1), a1 + hstepA, voffA);
            PG8_WAIT_V(8); PG8_WAIT_L(0); PG8_BAR; PG8_MMA(0, 0, At, B0); PG8_MMA(0, 1, At, B1); PG8_BAR; PG8_SCHED;
            PG8_LDA(At, 0, 1); PG8_STAGE(PG8_SB(0, 0), b2, voffB); PG8_STAGE(PG8_SB(0, 1), b2 + hstep, voffB); PG8_STAGE(PG8_SA(0, 0), a2, voffA);
            PG8_WAIT_V(8); PG8_WAIT_L(0); PG8_BAR; PG8_MMA(1, 0, At, B0); PG8_MMA(1, 1, At, B1); PG8_BAR; PG8_SCHED;
            PG8_LDB(B0, 1, 0); PG8_LDB(B1, 1, 1); PG8_SCHED; PG8_LDA(At, 1, 0); PG8_STAGE(PG8_SA(0, 1), a2 + hstepA, voffA);
            PG8_WAIT_V(8); PG8_WAIT_L(0); PG8_BAR; PG8_MMA(0, 0, At, B0); PG8_MMA(0, 1, At, B1); PG8_BAR; PG8_SCHED;
            PG8_LDA(At, 1, 1); PG8_STAGE(PG8_SB(1, 0), b3, voffB); PG8_STAGE(PG8_SB(1, 1), b3 + hstep, voffB); PG8_STAGE(PG8_SA(1, 0), a3, voffA);
            PG8_WAIT_V(8); PG8_WAIT_L(0); PG8_BAR; PG8_MMA(1, 0, At, B0); PG8_MMA(1, 1, At, B1); PG8_BAR; PG8_SCHED;
            } else {
            PG8_LDB(B0, 0, 0); PG8_SCHED; PG8_LDA(At, 0, 0); PG8_STAGE(PG8_SA(1, 1), a1 + hstepA, voffA);
            PG8_WAIT_L(8); PG8_BAR; PG8_WAIT_L(0); PG8_MMA(0, 0, At, B0); PG8_BAR; PG8_SCHED;
            PG8_LDB(B1, 0, 1); PG8_STAGE(PG8_SB(0, 0), b2, voffB);
            PG8_BAR; PG8_WAIT_L(0); PG8_MMA(0, 1, At, B1); PG8_BAR;
            PG8_LDA(At, 0, 1); PG8_STAGE(PG8_SA(0, 0), a2, voffA);
            PG8_BAR; PG8_WAIT_L(0); PG8_MMA(1, 0, At, B0); PG8_BAR; PG8_SCHED;
            PG8_STAGE(PG8_SB(0, 1), b2 + hstep, voffB);
            PG8_WAIT_V(6); PG8_BAR; PG8_MMA(1, 1, At, B1); PG8_BAR;
            PG8_LDB(B0, 1, 0); PG8_SCHED; PG8_LDA(At, 1, 0); PG8_STAGE(PG8_SA(0, 1), a2 + hstepA, voffA);
            PG8_WAIT_L(8); PG8_BAR; PG8_WAIT_L(0); PG8_MMA(0, 0, At, B0); PG8_BAR; PG8_SCHED;
            PG8_LDB(B1, 1, 1); PG8_STAGE(PG8_SB(1, 0), b3, voffB);
            PG8_BAR; PG8_WAIT_L(0); PG8_MMA(0, 1, At, B1); PG8_BAR;
            PG8_LDA(At, 1, 1); PG8_STAGE(PG8_SA(1, 0), a3, voffA);
            PG8_BAR; PG8_WAIT_L(0); PG8_MMA(1, 0, At, B0); PG8_BAR; PG8_SCHED;
            PG8_STAGE(PG8_SB(1, 1), b3 + hstep, voffB);
            PG8_WAIT_V(6); PG8_BAR; PG8_MMA(1, 1, At, B1); PG8_BAR;
            }
        }
        if constexpr (ALIGN_EPI) { if (wr == 0) PG8_BAR; }
        if constexpr (!Epi::AFTER_DRAIN) { E(acc, cur, wr, wc, fr, fq); S.done(cur); }
        if (!has_next) break;
#pragma unroll
        for (int a = 0; a < 2; ++a)
#pragma unroll
            for (int b = 0; b < 2; ++b)
#pragma unroll
                for (int m = 0; m < 4; ++m)
#pragma unroll
                    for (int n = 0; n < 2; ++n) acc[a][b][m][n] = (f32x4){0.f, 0.f, 0.f, 0.f};
        cur = nxt; cA = nA; cB = nB; ++ui;
        if constexpr (ALIGN_EPI) { if (wr == 1) PG8_BAR; }
    }
    PG8_WAIT_V(0);
    if constexpr (!ALIGN_EPI) { if (wr == 0) PG8_BAR; }
    PG8_BAR;
    if constexpr (Epi::AFTER_DRAIN) { E.fused(acc, cur, wr, wc, fr, fq, lds, wid, lane); S.done(cur); }
#undef PG8_SA
#undef PG8_SB
#undef PG8_STAGE
#undef PG8_LDA
#undef PG8_LDB
#undef PG8_MMA
#undef PG8_WAIT_V
#undef PG8_WAIT_L
#undef PG8_BAR
#undef PG8_SCHED
}
}
namespace att {
#define LAS __attribute__((address_space(3)))
using pg8::bf16_t; using pg8::bf16x8; using pg8::f32x4; using pg8::u32x4; using pg8::SEQ;
typedef float f32x16 __attribute__((ext_vector_type(16)));
constexpr int KB_BYTES = 8192, VT_STRIDE = 144, VT_BYTES = 64 * VT_STRIDE, BUF_BYTES = KB_BYTES + VT_BYTES + 256;
constexpr int VOTE_OFF = 3 * BUF_BYTES, KM_OFF = 57344;
constexpr float LOG2E = 1.4426950408889634f, C2 = 0.125f * 1.4426950408889634f;
enum { M_SB = 0, M_MOBA = 1, M_FOX = 2, M_XA = 3 };
__device__ __forceinline__ bf16x8 pack8(const f32x16& p, int b) {
    u32x4 w; w.x = pg8::cvt_pk_bf16(p[b + 0], p[b + 1]); w.y = pg8::cvt_pk_bf16(p[b + 2], p[b + 3]); w.z = pg8::cvt_pk_bf16(p[b + 4], p[b + 5]); w.w = pg8::cvt_pk_bf16(p[b + 6], p[b + 7]);
    return __builtin_bit_cast(bf16x8, w);
}
__device__ __forceinline__ float bf2f(short s) { return __uint_as_float(((unsigned)(unsigned short)s) << 16); }

struct AttnArgs { const bf16_t* Q; int ldq; const bf16_t* K; const bf16_t* V; int ldkv; bf16_t* O; int ldo; const float* cf; float kmax2; const float* kpart; int* sel; float* lse; };

template <int MODE>
__device__ __forceinline__ void attn_unit(LAS unsigned char* lds, const AttnArgs& A, int qb) {
    int tid_ = threadIdx.x; asm volatile("" : "+v"(tid_)); const int tid = tid_, lane = tid & 63, wid = __builtin_amdgcn_readfirstlane(tid >> 6), r32 = lane & 31, hi = lane >> 5;
    const int q0 = qb * 256, w0 = q0 + wid * 32, row = w0 + r32;
    bf16x8 qr[4];
#pragma unroll
    for (int d0 = 0; d0 < 4; ++d0) qr[d0] = *(const bf16x8*)(A.Q + (size_t)row * A.ldq + d0 * 16 + hi * 8);
    int i1 = -1, i2 = -1, i3 = -1; unsigned long long wmask = 0ull;
    if (MODE == M_MOBA) {
        const int own = qb;
        LAS float* km = (LAS float*)(lds + KM_OFF);
        {
            float kp_[8][4];
#pragma unroll
            for (int k = 0; k < 8; ++k) { const int idx = tid + 512 * k; const bool ok = idx < own * 64; const float* p = A.kpart + (size_t)((ok ? idx : 0) >> 6) * 256 + (idx & 63);
                kp_[k][0] = p[0]; kp_[k][1] = p[64]; kp_[k][2] = p[128]; kp_[k][3] = p[192]; }
#pragma unroll
            for (int k = 0; k < 8; ++k) { const int idx = tid + 512 * k; if (idx < own * 64) km[idx] = ((kp_[k][0] + kp_[k][1]) + (kp_[k][2] + kp_[k][3])) * (1.0f / 256.0f); }
        }
        __syncthreads();
        float qf[32];
#pragma unroll
        for (int d0 = 0; d0 < 4; ++d0)
#pragma unroll
            for (int e = 0; e < 8; ++e) qf[d0 * 8 + e] = bf2f(qr[d0][e]);
        float v1 = -INFINITY, v2 = -INFINITY, v3 = -INFINITY;
#pragma unroll 4
        for (int j = 0; j < own; ++j) {
            float g = 0.f;
#pragma unroll
            for (int d0 = 0; d0 < 4; ++d0) { const f32x4 a = *(const LAS f32x4*)(km + j * 64 + d0 * 16 + hi * 8), b = *(const LAS f32x4*)(km + j * 64 + d0 * 16 + hi * 8 + 4);
                g += (qf[d0 * 8 + 0] * a[0] + qf[d0 * 8 + 1] * a[1]) + (qf[d0 * 8 + 2] * a[2] + qf[d0 * 8 + 3] * a[3]) + (qf[d0 * 8 + 4] * b[0] + qf[d0 * 8 + 5] * b[1]) + (qf[d0 * 8 + 6] * b[2] + qf[d0 * 8 + 7] * b[3]); }
            const float go = __shfl_xor(g, 32); g = hi ? (go + g) : (g + go);
            if (g > v1) { v3 = v2; i3 = i2; v2 = v1; i2 = i1; v1 = g; i1 = j; } else if (g > v2) { v3 = v2; i3 = i2; v2 = g; i2 = j; } else if (g > v3) { v3 = g; i3 = j; }
        }
        if (hi == 0) { typedef int i32x4 __attribute__((ext_vector_type(4))); *(i32x4*)(A.sel + (size_t)row * 4) = (i32x4){i1, i2, i3, 0}; }
    }
    float qb2 = 0.f, cq2 = 0.f;
    if (MODE == M_FOX) {
        float s = 0.f;
#pragma unroll
        for (int d0 = 0; d0 < 4; ++d0)
#pragma unroll
            for (int e = 0; e < 8; ++e) { const float x = bf2f(qr[d0][e]); s += x * x; }
        s += __shfl_xor(s, 32);
        qb2 = sqrtf(s * A.kmax2) * C2 * 1.01f;
        cq2 = A.cf[row] * LOG2E;
    }
    const int NT = (MODE == M_XA || MODE == M_MOBA) ? 4 : (q0 / 64 + 4);
    f32x16 o0, o1;
#pragma unroll
    for (int r = 0; r < 16; ++r) { o0[r] = 0.f; o1[r] = 0.f; }
    float m_run = -1e30f, l_run = 0.f, T = 0.f;
    u32x4 k1 = (u32x4){0u, 0u, 0u, 0u}, v1 = k1, k2 = k1, v2 = k1, k3 = k1, v3 = k1; float c1 = 0.f, c2 = 0.f, c3 = 0.f;
#define KEY0(i) ((MODE == M_XA) ? 64 * (i) : (MODE == M_MOBA) ? ((i) < 4 ? q0 + 64 * (i) : 256 * (((i) - 4) >> 2) + 64 * (((i) - 4) & 3)) : (q0 + 192 - 64 * (i)))
#define LOADT(i, kreg, vreg, creg) do { const int k0_ = KEY0(i); kreg = *(const u32x4*)(A.K + (size_t)(k0_ + lane) * A.ldkv + wid * 8); vreg = *(const u32x4*)(A.V + (size_t)(k0_ + lane) * A.ldkv + wid * 8); \
        if (MODE == M_FOX) { if (tid < 64) creg = A.cf[k0_ + tid] * LOG2E; } } while (0)
#define STORET(b, kreg, vreg, creg) do { LAS unsigned char* bb_ = lds + (b) * BUF_BYTES; *(LAS u32x4*)(bb_ + wid * 1024 + lane * 16) = kreg; \
        LAS unsigned short* vt_ = (LAS unsigned short*)(bb_ + KB_BYTES + (8 * wid) * VT_STRIDE + lane * 2); \
        vt_[0 * 72] = (unsigned short)(vreg.x & 0xffffu); vt_[1 * 72] = (unsigned short)(vreg.x >> 16); vt_[2 * 72] = (unsigned short)(vreg.y & 0xffffu); vt_[3 * 72] = (unsigned short)(vreg.y >> 16); \
        vt_[4 * 72] = (unsigned short)(vreg.z & 0xffffu); vt_[5 * 72] = (unsigned short)(vreg.z >> 16); vt_[6 * 72] = (unsigned short)(vreg.w & 0xffffu); vt_[7 * 72] = (unsigned short)(vreg.w >> 16); \
        if (MODE == M_FOX) { if (tid < 64) ((LAS float*)(bb_ + KB_BYTES + VT_BYTES))[tid] = creg; } } while (0)
    LOADT(0, k1, v1, c1); if (NT > 1) LOADT(1, k2, v2, c2); if (NT > 2) LOADT(2, k3, v3, c3);
    STORET(0, k1, v1, c1);
    __syncthreads();
    const int kperm = (r32 & ~15) | (r32 & 3) | ((r32 & 4) << 1) | ((r32 & 8) >> 1);
    bool prev_active = false; int prevbuf = 0; bf16x8 pkP0 = (bf16x8){0, 0, 0, 0, 0, 0, 0, 0}, pkP1 = pkP0, pkP2 = pkP0, pkP3 = pkP0;
    for (int i0 = 0; i0 < NT; i0 += 3) {
        { const int i = i0 + 0; if (i >= NT) break;
        const int key0 = KEY0(i);
        if (i + 3 < NT) LOADT(i + 3, k1, v1, c1);
        LAS unsigned char* buf = lds + 0 * BUF_BYTES;
        bool active;
        if (MODE == M_XA) active = true;
        else if (MODE == M_MOBA) active = (i < 4) ? (key0 <= w0 + 31) : (((wmask >> ((i - 4) >> 2)) & 1ull) != 0ull);
        else active = key0 <= w0 + 31;
        if (active) {
            f32x16 p0, p1;
#pragma unroll
            for (int r = 0; r < 16; ++r) { p0[r] = 0.f; p1[r] = 0.f; }
            LAS unsigned char* kb = buf + kperm * 16 + hi * 1024;
            bf16x8 kf[8];
            if (MODE != M_FOX) {
#pragma unroll
            for (int d0 = 0; d0 < 4; ++d0) {
                const bf16x8 kf0 = *(const LAS bf16x8*)(kb + d0 * 2048), kf1 = *(const LAS bf16x8*)(kb + d0 * 2048 + 512);
                p0 = __builtin_amdgcn_mfma_f32_32x32x16_bf16(kf0, qr[d0], p0, 0, 0, 0);
                p1 = __builtin_amdgcn_mfma_f32_32x32x16_bf16(kf1, qr[d0], p1, 0, 0, 0);
            }
            } else {
#pragma unroll
                for (int d0 = 0; d0 < 4; ++d0) { kf[2 * d0] = *(const LAS bf16x8*)(kb + d0 * 2048); kf[2 * d0 + 1] = *(const LAS bf16x8*)(kb + d0 * 2048 + 512); }
                __builtin_amdgcn_sched_barrier(0);
            }
        if (prev_active) {
            const LAS unsigned char* vb = lds + prevbuf + KB_BYTES + r32 * VT_STRIDE + hi * 16;
#define PVS(s, pk) do { const bf16x8 a0_ = *(const LAS bf16x8*)(vb + (s) * 32), a1_ = *(const LAS bf16x8*)(vb + 32 * VT_STRIDE + (s) * 32); \
            o0 = __builtin_amdgcn_mfma_f32_32x32x16_bf16(a0_, pk, o0, 0, 0, 0); o1 = __builtin_amdgcn_mfma_f32_32x32x16_bf16(a1_, pk, o1, 0, 0, 0); } while (0)
            PVS(0, pkP0); PVS(1, pkP1); PVS(2, pkP2); PVS(3, pkP3);
#undef PVS
        }
            if (MODE == M_FOX) {
                __builtin_amdgcn_sched_barrier(0);
#pragma unroll
                for (int d0 = 0; d0 < 4; ++d0) {
                    p0 = __builtin_amdgcn_mfma_f32_32x32x16_bf16(kf[2 * d0], qr[d0], p0, 0, 0, 0);
                    p1 = __builtin_amdgcn_mfma_f32_32x32x16_bf16(kf[2 * d0 + 1], qr[d0], p1, 0, 0, 0);
                }
            }
            const int kl = key0 + 8 * hi;
            if (MODE == M_SB) {
                const bool nm = key0 + 63 >= w0;
                f32x16 L0, L1; float gt[4];
#pragma unroll
                for (int g = 0; g < 4; ++g) gt[g] = 0.f;
#pragma unroll
                for (int r = 0; r < 16; ++r) {
                    { const float z2 = p0[r] * C2; p0[r] = z2; float l1 = -(fmaxf(z2, 0.f) + __builtin_amdgcn_logf(1.0f + __builtin_amdgcn_exp2f(-fabsf(z2))));
                      if (nm && !(kl + 16 * (r >> 3) + (r & 7) < row)) l1 = 0.f; L0[r] = l1; gt[r >> 3] += l1; }
                    { const float z2 = p1[r] * C2; p1[r] = z2; float l1 = -(fmaxf(z2, 0.f) + __builtin_amdgcn_logf(1.0f + __builtin_amdgcn_exp2f(-fabsf(z2))));
                      if (nm && !(kl + 32 + 16 * (r >> 3) + (r & 7) < row)) l1 = 0.f; L1[r] = l1; gt[2 + (r >> 3)] += l1; }
                }
                float pt[4], after[4]; float run = 0.f;
#pragma unroll
                for (int g = 0; g < 4; ++g) pt[g] = __shfl_xor(gt[g], 32);
#pragma unroll
                for (int g = 3; g >= 0; --g) { after[g] = run + (hi ? 0.f : pt[g]); run += gt[g] + pt[g]; }
#pragma unroll
                for (int g8 = 1; g8 >= 0; --g8) {
                    float s0 = T + after[g8], s1 = T + after[2 + g8];
#pragma unroll
                    for (int e = 7; e >= 0; --e) { const int r = 8 * g8 + e;
                        { const bool valid = !nm || (kl + 16 * g8 + e < row); const float a = valid ? __builtin_amdgcn_exp2f(p0[r] + L0[r] + s0) : 0.f; s0 += L0[r]; p0[r] = a; }
                        { const bool valid = !nm || (kl + 32 + 16 * g8 + e < row); const float a = valid ? __builtin_amdgcn_exp2f(p1[r] + L1[r] + s1) : 0.f; s1 += L1[r]; p1[r] = a; } }
                }
                T += run;
            } else {
                const bool nm = (MODE == M_FOX) ? (key0 + 63 > w0) : ((MODE == M_MOBA) ? (i < 4 && key0 + 63 > w0) : false);
                bool rowsel = true;
                if (MODE == M_MOBA) { if (i >= 4) { const int j = (i - 4) >> 2; rowsel = (i1 == j) | (i2 == j) | (i3 == j); } }
                const LAS float* cl = (const LAS float*)(buf + KB_BYTES + VT_BYTES) + 8 * hi;
                float corr;
                if (nm) {
                    float mx = -INFINITY;
#pragma unroll
                    for (int r = 0; r < 16; ++r) {
                        float t0 = p0[r] * C2, t1 = p1[r] * C2;
                        if (MODE == M_FOX) { t0 += cq2 - cl[16 * (r >> 3) + (r & 7)]; t1 += cq2 - cl[32 + 16 * (r >> 3) + (r & 7)]; }
                        const int k_0 = kl + 16 * (r >> 3) + (r & 7);
                        t0 = (k_0 <= row) ? t0 : -INFINITY; t1 = (k_0 + 32 <= row) ? t1 : -INFINITY;
                        p0[r] = t0; p1[r] = t1; mx = fmaxf(mx, fmaxf(t0, t1));
                    }
                    mx = fmaxf(mx, __shfl_xor(mx, 32));
                    float m_new;
                    if (MODE == M_FOX) { m_run = fmaxf(m_run, mx); m_new = fminf(qb2, 48.0f); corr = 1.0f; }
                    else { m_new = fmaxf(m_run, mx); corr = __builtin_amdgcn_exp2f(m_run - m_new); m_run = m_new; }
                    float sum = 0.f;
#pragma unroll
                    for (int r = 0; r < 16; ++r) { const float e0 = __builtin_amdgcn_exp2f(p0[r] - m_new), e1 = __builtin_amdgcn_exp2f(p1[r] - m_new); sum += e0 + e1; p0[r] = e0; p1[r] = e1; }
                    l_run = l_run * corr + sum;
                } else {
                    if (MODE == M_FOX) {
                        typedef float f32x2 __attribute__((ext_vector_type(2)));
                        const float base = cq2 - fminf(qb2, 48.0f); const f32x2 basev = (f32x2){base, base}, c2v = (f32x2){C2, C2};
                        f32x2 sa = (f32x2){0.f, 0.f}, sb = (f32x2){0.f, 0.f};
#pragma unroll
                        for (int r = 0; r < 16; r += 2) {
                            const f32x2 ca = *(const LAS f32x2*)(cl + 16 * (r >> 3) + (r & 7)), cb = *(const LAS f32x2*)(cl + 32 + 16 * (r >> 3) + (r & 7));
                            const f32x2 ta = (f32x2){p0[r], p0[r + 1]} * c2v + (basev - ca), tb = (f32x2){p1[r], p1[r + 1]} * c2v + (basev - cb);
                            const f32x2 ea = (f32x2){__builtin_amdgcn_exp2f(ta.x), __builtin_amdgcn_exp2f(ta.y)}, eb = (f32x2){__builtin_amdgcn_exp2f(tb.x), __builtin_amdgcn_exp2f(tb.y)};
                            sa += ea; sb += eb; p0[r] = ea.x; p0[r + 1] = ea.y; p1[r] = eb.x; p1[r + 1] = eb.y;
                        }
                        corr = 1.0f; l_run += (sa.x + sa.y) + (sb.x + sb.y);
                    } else {
                    float mx = -INFINITY;
#pragma unroll
                    for (int r = 0; r < 16; ++r) mx = fmaxf(mx, fmaxf(p0[r], p1[r]));
                    mx *= C2;
                    if (MODE == M_MOBA) mx = rowsel ? mx : -INFINITY;
                    mx = fmaxf(mx, __shfl_xor(mx, 32));
                    const float m_new = fmaxf(m_run, mx); corr = __builtin_amdgcn_exp2f(m_run - m_new); m_run = m_new;
                    const float off = (MODE == M_MOBA && !rowsel) ? -INFINITY : -m_new;
                    float s0 = 0.f, s1 = 0.f;
#pragma unroll
                    for (int r = 0; r < 16; ++r) { const float e0 = __builtin_amdgcn_exp2f(fmaf(p0[r], C2, off)), e1 = __builtin_amdgcn_exp2f(fmaf(p1[r], C2, off)); s0 += e0; s1 += e1; p0[r] = e0; p1[r] = e1; }
                    l_run = l_run * corr + (s0 + s1);
                    }
                }
                if (__any(corr != 1.0f)) {
#pragma unroll
                    for (int r = 0; r < 16; ++r) { o0[r] *= corr; o1[r] *= corr; }
                }
            }
            pkP0 = pack8(p0, 0); pkP1 = pack8(p0, 8); pkP2 = pack8(p1, 0); pkP3 = pack8(p1, 8);
            if (MODE == M_FOX) asm volatile("" :: "v"(kf[0]), "v"(kf[1]), "v"(kf[2]), "v"(kf[3]), "v"(kf[4]), "v"(kf[5]), "v"(kf[6]), "v"(kf[7]));
        } else {
        if (prev_active) {
            const LAS unsigned char* vb = lds + prevbuf + KB_BYTES + r32 * VT_STRIDE + hi * 16;
#define PVS(s, pk) do { const bf16x8 a0_ = *(const LAS bf16x8*)(vb + (s) * 32), a1_ = *(const LAS bf16x8*)(vb + 32 * VT_STRIDE + (s) * 32); \
            o0 = __builtin_amdgcn_mfma_f32_32x32x16_bf16(a0_, pk, o0, 0, 0, 0); o1 = __builtin_amdgcn_mfma_f32_32x32x16_bf16(a1_, pk, o1, 0, 0, 0); } while (0)
            PVS(0, pkP0); PVS(1, pkP1); PVS(2, pkP2); PVS(3, pkP3);
#undef PVS
        }
        }
        prev_active = active; prevbuf = 0 * BUF_BYTES;
        if (i + 1 < NT) STORET(1, k2, v2, c2);
        if (MODE == M_SB || MODE == M_FOX) {
            bool vote;
            if (MODE == M_SB) vote = __all(T < -151.0f) != 0;
            else { const float cn = (key0 > 0) ? A.cf[key0 - 1] * LOG2E : 0.f; vote = __all(qb2 + cq2 - cn < m_run - 151.0f) != 0; }
            if (lane == 0) ((LAS unsigned*)(lds + VOTE_OFF))[(i & 1) * 8 + wid] = (active && vote) ? 1u : 0u;
        }
        __syncthreads();
        if (MODE == M_SB || MODE == M_FOX) {
            const LAS unsigned* vv = (const LAS unsigned*)(lds + VOTE_OFF) + (i & 1) * 8;
            const unsigned all8 = (vv[0] & vv[1]) & (vv[2] & vv[3]) & (vv[4] & vv[5]) & (vv[6] & vv[7]);
            if (all8) break;
        }
        }
        { const int i = i0 + 1; if (i >= NT) break;
        const int key0 = KEY0(i);
        if (i + 3 < NT) LOADT(i + 3, k2, v2, c2);
        LAS unsigned char* buf = lds + 1 * BUF_BYTES;
        bool active;
        if (MODE == M_XA) active = true;
        else if (MODE == M_MOBA) active = (i < 4) ? (key0 <= w0 + 31) : (((wmask >> ((i - 4) >> 2)) & 1ull) != 0ull);
        else active = key0 <= w0 + 31;
        if (active) {
            f32x16 p0, p1;
#pragma unroll
            for (int r = 0; r < 16; ++r) { p0[r] = 0.f; p1[r] = 0.f; }
            LAS unsigned char* kb = buf + kperm * 16 + hi * 1024;
            bf16x8 kf[8];
            if (MODE != M_FOX) {
#pragma unroll
            for (int d0 = 0; d0 < 4; ++d0) {
                const bf16x8 kf0 = *(const LAS bf16x8*)(kb + d0 * 2048), kf1 = *(const LAS bf16x8*)(kb + d0 * 2048 + 512);
                p0 = __builtin_amdgcn_mfma_f32_32x32x16_bf16(kf0, qr[d0], p0, 0, 0, 0);
                p1 = __builtin_amdgcn_mfma_f32_32x32x16_bf16(kf1, qr[d0], p1, 0, 0, 0);
            }
            } else {
#pragma unroll
                for (int d0 = 0; d0 < 4; ++d0) { kf[2 * d0] = *(const LAS bf16x8*)(kb + d0 * 2048); kf[2 * d0 + 1] = *(const LAS bf16x8*)(kb + d0 * 2048 + 512); }
                __builtin_amdgcn_sched_barrier(0);
            }
        if (prev_active) {
            const LAS unsigned char* vb = lds + prevbuf + KB_BYTES + r32 * VT_STRIDE + hi * 16;
#define PVS(s, pk) do { const bf16x8 a0_ = *(const LAS bf16x8*)(vb + (s) * 32), a1_ = *(const LAS bf16x8*)(vb + 32 * VT_STRIDE + (s) * 32); \
            o0 = __builtin_amdgcn_mfma_f32_32x32x16_bf16(a0_, pk, o0, 0, 0, 0); o1 = __builtin_amdgcn_mfma_f32_32x32x16_bf16(a1_, pk, o1, 0, 0, 0); } while (0)
            PVS(0, pkP0); PVS(1, pkP1); PVS(2, pkP2); PVS(3, pkP3);
#undef PVS
        }
            if (MODE == M_FOX) {
                __builtin_amdgcn_sched_barrier(0);
#pragma unroll
                for (int d0 = 0; d0 < 4; ++d0) {
                    p0 = __builtin_amdgcn_mfma_f32_32x32x16_bf16(kf[2 * d0], qr[d0], p0, 0, 0, 0);
                    p1 = __builtin_amdgcn_mfma_f32_32x32x16_bf16(kf[2 * d0 + 1], qr[d0], p1, 0, 0, 0);
                }
            }
            const int kl = key0 + 8 * hi;
            if (MODE == M_SB) {
                const bool nm = key0 + 63 >= w0;
                f32x16 L0, L1; float gt[4];
#pragma unroll
                for (int g = 0; g < 4; ++g) gt[g] = 0.f;
#pragma unroll
                for (int r = 0; r < 16; ++r) {
                    { const float z2 = p0[r] * C2; p0[r] = z2; float l1 = -(fmaxf(z2, 0.f) + __builtin_amdgcn_logf(1.0f + __builtin_amdgcn_exp2f(-fabsf(z2))));
                      if (nm && !(kl + 16 * (r >> 3) + (r & 7) < row)) l1 = 0.f; L0[r] = l1; gt[r >> 3] += l1; }
                    { const float z2 = p1[r] * C2; p1[r] = z2; float l1 = -(fmaxf(z2, 0.f) + __builtin_amdgcn_logf(1.0f + __builtin_amdgcn_exp2f(-fabsf(z2))));
                      if (nm && !(kl + 32 + 16 * (r >> 3) + (r & 7) < row)) l1 = 0.f; L1[r] = l1; gt[2 + (r >> 3)] += l1; }
                }
                float pt[4], after[4]; float run = 0.f;
#pragma unroll
                for (int g = 0; g < 4; ++g) pt[g] = __shfl_xor(gt[g], 32);
#pragma unroll
                for (int g = 3; g >= 0; --g) { after[g] = run + (hi ? 0.f : pt[g]); run += gt[g] + pt[g]; }
#pragma unroll
                for (int g8 = 1; g8 >= 0; --g8) {
                    float s0 = T + after[g8], s1 = T + after[2 + g8];
#pragma unroll
                    for (int e = 7; e >= 0; --e) { const int r = 8 * g8 + e;
                        { const bool valid = !nm || (kl + 16 * g8 + e < row); const float a = valid ? __builtin_amdgcn_exp2f(p0[r] + L0[r] + s0) : 0.f; s0 += L0[r]; p0[r] = a; }
                        { const bool valid = !nm || (kl + 32 + 16 * g8 + e < row); const float a = valid ? __builtin_amdgcn_exp2f(p1[r] + L1[r] + s1) : 0.f; s1 += L1[r]; p1[r] = a; } }
                }
                T += run;
            } else {
                const bool nm = (MODE == M_FOX) ? (key0 + 63 > w0) : ((MODE == M_MOBA) ? (i < 4 && key0 + 63 > w0) : false);
                bool rowsel = true;
                if (MODE == M_MOBA) { if (i >= 4) { const int j = (i - 4) >> 2; rowsel = (i1 == j) | (i2 == j) | (i3 == j); } }
                const LAS float* cl = (const LAS float*)(buf + KB_BYTES + VT_BYTES) + 8 * hi;
                float corr;
                if (nm) {
                    float mx = -INFINITY;
#pragma unroll
                    for (int r = 0; r < 16; ++r) {
                        float t0 = p0[r] * C2, t1 = p1[r] * C2;
                        if (MODE == M_FOX) { t0 += cq2 - cl[16 * (r >> 3) + (r & 7)]; t1 += cq2 - cl[32 + 16 * (r >> 3) + (r & 7)]; }
                        const int k_0 = kl + 16 * (r >> 3) + (r & 7);
                        t0 = (k_0 <= row) ? t0 : -INFINITY; t1 = (k_0 + 32 <= row) ? t1 : -INFINITY;
                        p0[r] = t0; p1[r] = t1; mx = fmaxf(mx, fmaxf(t0, t1));
                    }
                    mx = fmaxf(mx, __shfl_xor(mx, 32));
                    float m_new;
                    if (MODE == M_FOX) { m_run = fmaxf(m_run, mx); m_new = fminf(qb2, 48.0f); corr = 1.0f; }
                    else { m_new = fmaxf(m_run, mx); corr = __builtin_amdgcn_exp2f(m_run - m_new); m_run = m_new; }
                    float sum = 0.f;
#pragma unroll
                    for (int r = 0; r < 16; ++r) { const float e0 = __builtin_amdgcn_exp2f(p0[r] - m_new), e1 = __builtin_amdgcn_exp2f(p1[r] - m_new); sum += e0 + e1; p0[r] = e0; p1[r] = e1; }
                    l_run = l_run * corr + sum;
                } else {
                    if (MODE == M_FOX) {
                        typedef float f32x2 __attribute__((ext_vector_type(2)));
                        const float base = cq2 - fminf(qb2, 48.0f); const f32x2 basev = (f32x2){base, base}, c2v = (f32x2){C2, C2};
                        f32x2 sa = (f32x2){0.f, 0.f}, sb = (f32x2){0.f, 0.f};
#pragma unroll
                        for (int r = 0; r < 16; r += 2) {
                            const f32x2 ca = *(const LAS f32x2*)(cl + 16 * (r >> 3) + (r & 7)), cb = *(const LAS f32x2*)(cl + 32 + 16 * (r >> 3) + (r & 7));
                            const f32x2 ta = (f32x2){p0[r], p0[r + 1]} * c2v + (basev - ca), tb = (f32x2){p1[r], p1[r + 1]} * c2v + (basev - cb);
                            const f32x2 ea = (f32x2){__builtin_amdgcn_exp2f(ta.x), __builtin_amdgcn_exp2f(ta.y)}, eb = (f32x2){__builtin_amdgcn_exp2f(tb.x), __builtin_amdgcn_exp2f(tb.y)};
                            sa += ea; sb += eb; p0[r] = ea.x; p0[r + 1] = ea.y; p1[r] = eb.x; p1[r + 1] = eb.y;
                        }
                        corr = 1.0f; l_run += (sa.x + sa.y) + (sb.x + sb.y);
                    } else {
                    float mx = -INFINITY;
#pragma unroll
                    for (int r = 0; r < 16; ++r) mx = fmaxf(mx, fmaxf(p0[r], p1[r]));
                    mx *= C2;
                    if (MODE == M_MOBA) mx = rowsel ? mx : -INFINITY;
                    mx = fmaxf(mx, __shfl_xor(mx, 32));
                    const float m_new = fmaxf(m_run, mx); corr = __builtin_amdgcn_exp2f(m_run - m_new); m_run = m_new;
                    const float off = (MODE == M_MOBA && !rowsel) ? -INFINITY : -m_new;
                    float s0 = 0.f, s1 = 0.f;
#pragma unroll
                    for (int r = 0; r < 16; ++r) { const float e0 = __builtin_amdgcn_exp2f(fmaf(p0[r], C2, off)), e1 = __builtin_amdgcn_exp2f(fmaf(p1[r], C2, off)); s0 += e0; s1 += e1; p0[r] = e0; p1[r] = e1; }
                    l_run = l_run * corr + (s0 + s1);
                    }
                }
                if (__any(corr != 1.0f)) {
#pragma unroll
                    for (int r = 0; r < 16; ++r) { o0[r] *= corr; o1[r] *= corr; }
                }
            }
            pkP0 = pack8(p0, 0); pkP1 = pack8(p0, 8); pkP2 = pack8(p1, 0); pkP3 = pack8(p1, 8);
            if (MODE == M_FOX) asm volatile("" :: "v"(kf[0]), "v"(kf[1]), "v"(kf[2]), "v"(kf[3]), "v"(kf[4]), "v"(kf[5]), "v"(kf[6]), "v"(kf[7]));
        } else {
        if (prev_active) {
            const LAS unsigned char* vb = lds + prevbuf + KB_BYTES + r32 * VT_STRIDE + hi * 16;
#define PVS(s, pk) do { const bf16x8 a0_ = *(const LAS bf16x8*)(vb + (s) * 32), a1_ = *(const LAS bf16x8*)(vb + 32 * VT_STRIDE + (s) * 32); \
            o0 = __builtin_amdgcn_mfma_f32_32x32x16_bf16(a0_, pk, o0, 0, 0, 0); o1 = __builtin_amdgcn_mfma_f32_32x32x16_bf16(a1_, pk, o1, 0, 0, 0); } while (0)
            PVS(0, pkP0); PVS(1, pkP1); PVS(2, pkP2); PVS(3, pkP3);
#undef PVS
        }
        }
        prev_active = active; prevbuf = 1 * BUF_BYTES;
        if (i + 1 < NT) STORET(2, k3, v3, c3);
        if (MODE == M_SB || MODE == M_FOX) {
            bool vote;
            if (MODE == M_SB) vote = __all(T < -151.0f) != 0;
            else { const float cn = (key0 > 0) ? A.cf[key0 - 1] * LOG2E : 0.f; vote = __all(qb2 + cq2 - cn < m_run - 151.0f) != 0; }
            if (lane == 0) ((LAS unsigned*)(lds + VOTE_OFF))[(i & 1) * 8 + wid] = (active && vote) ? 1u : 0u;
        }
        __syncthreads();
        if (MODE == M_SB || MODE == M_FOX) {
            const LAS unsigned* vv = (const LAS unsigned*)(lds + VOTE_OFF) + (i & 1) * 8;
            const unsigned all8 = (vv[0] & vv[1]) & (vv[2] & vv[3]) & (vv[4] & vv[5]) & (vv[6] & vv[7]);
            if (all8) break;
        }
        }
        { const int i = i0 + 2; if (i >= NT) break;
        const int key0 = KEY0(i);
        if (i + 3 < NT) LOADT(i + 3, k3, v3, c3);
        LAS unsigned char* buf = lds + 2 * BUF_BYTES;
        bool active;
        if (MODE == M_XA) active = true;
        else if (MODE == M_MOBA) active = (i < 4) ? (key0 <= w0 + 31) : (((wmask >> ((i - 4) >> 2)) & 1ull) != 0ull);
        else active = key0 <= w0 + 31;
        if (active) {
            f32x16 p0, p1;
#pragma unroll
            for (int r = 0; r < 16; ++r) { p0[r] = 0.f; p1[r] = 0.f; }
            LAS unsigned char* kb = buf + kperm * 16 + hi * 1024;
            bf16x8 kf[8];
            if (MODE != M_FOX) {
#pragma unroll
            for (int d0 = 0; d0 < 4; ++d0) {
                const bf16x8 kf0 = *(const LAS bf16x8*)(kb + d0 * 2048), kf1 = *(const LAS bf16x8*)(kb + d0 * 2048 + 512);
                p0 = __builtin_amdgcn_mfma_f32_32x32x16_bf16(kf0, qr[d0], p0, 0, 0, 0);
                p1 = __builtin_amdgcn_mfma_f32_32x32x16_bf16(kf1, qr[d0], p1, 0, 0, 0);
            }
            } else {
#pragma unroll
                for (int d0 = 0; d0 < 4; ++d0) { kf[2 * d0] = *(const LAS bf16x8*)(kb + d0 * 2048); kf[2 * d0 + 1] = *(const LAS bf16x8*)(kb + d0 * 2048 + 512); }
                __builtin_amdgcn_sched_barrier(0);
            }
        if (prev_active) {
            const LAS unsigned char* vb = lds + prevbuf + KB_BYTES + r32 * VT_STRIDE + hi * 16;
#define PVS(s, pk) do { const bf16x8 a0_ = *(const LAS bf16x8*)(vb + (s) * 32), a1_ = *(const LAS bf16x8*)(vb + 32 * VT_STRIDE + (s) * 32); \
            o0 = __builtin_amdgcn_mfma_f32_32x32x16_bf16(a0_, pk, o0, 0, 0, 0); o1 = __builtin_amdgcn_mfma_f32_32x32x16_bf16(a1_, pk, o1, 0, 0, 0); } while (0)
            PVS(0, pkP0); PVS(1, pkP1); PVS(2, pkP2); PVS(3, pkP3);
#undef PVS
        }
            if (MODE == M_FOX) {
                __builtin_amdgcn_sched_barrier(0);
#pragma unroll
                for (int d0 = 0; d0 < 4; ++d0) {
                    p0 = __builtin_amdgcn_mfma_f32_32x32x16_bf16(kf[2 * d0], qr[d0], p0, 0, 0, 0);
                    p1 = __builtin_amdgcn_mfma_f32_32x32x16_bf16(kf[2 * d0 + 1], qr[d0], p1, 0, 0, 0);
                }
            }
            const int kl = key0 + 8 * hi;
            if (MODE == M_SB) {
                const bool nm = key0 + 63 >= w0;
                f32x16 L0, L1; float gt[4];
#pragma unroll
                for (int g = 0; g < 4; ++g) gt[g] = 0.f;
#pragma unroll
                for (int r = 0; r < 16; ++r) {
                    { const float z2 = p0[r] * C2; p0[r] = z2; float l1 = -(fmaxf(z2, 0.f) + __builtin_amdgcn_logf(1.0f + __builtin_amdgcn_exp2f(-fabsf(z2))));
                      if (nm && !(kl + 16 * (r >> 3) + (r & 7) < row)) l1 = 0.f; L0[r] = l1; gt[r >> 3] += l1; }
                    { const float z2 = p1[r] * C2; p1[r] = z2; float l1 = -(fmaxf(z2, 0.f) + __builtin_amdgcn_logf(1.0f + __builtin_amdgcn_exp2f(-fabsf(z2))));
                      if (nm && !(kl + 32 + 16 * (r >> 3) + (r & 7) < row)) l1 = 0.f; L1[r] = l1; gt[2 + (r >> 3)] += l1; }
                }
                float pt[4], after[4]; float run = 0.f;
#pragma unroll
                for (int g = 0; g < 4; ++g) pt[g] = __shfl_xor(gt[g], 32);
#pragma unroll
                for (int g = 3; g >= 0; --g) { after[g] = run + (hi ? 0.f : pt[g]); run += gt[g] + pt[g]; }
#pragma unroll
                for (int g8 = 1; g8 >= 0; --g8) {
                    float s0 = T + after[g8], s1 = T + after[2 + g8];
#pragma unroll
                    for (int e = 7; e >= 0; --e) { const int r = 8 * g8 + e;
                        { const bool valid = !nm || (kl + 16 * g8 + e < row); const float a = valid ? __builtin_amdgcn_exp2f(p0[r] + L0[r] + s0) : 0.f; s0 += L0[r]; p0[r] = a; }
                        { const bool valid = !nm || (kl + 32 + 16 * g8 + e < row); const float a = valid ? __builtin_amdgcn_exp2f(p1[r] + L1[r] + s1) : 0.f; s1 += L1[r]; p1[r] = a; } }
                }
                T += run;
            } else {
                const bool nm = (MODE == M_FOX) ? (key0 + 63 > w0) : ((MODE == M_MOBA) ? (i < 4 && key0 + 63 > w0) : false);
                bool rowsel = true;
                if (MODE == M_MOBA) { if (i >= 4) { const int j = (i - 4) >> 2; rowsel = (i1 == j) | (i2 == j) | (i3 == j); } }
                const LAS float* cl = (const LAS float*)(buf + KB_BYTES + VT_BYTES) + 8 * hi;
                float corr;
                if (nm) {
                    float mx = -INFINITY;
#pragma unroll
                    for (int r = 0; r < 16; ++r) {
                        float t0 = p0[r] * C2, t1 = p1[r] * C2;
                        if (MODE == M_FOX) { t0 += cq2 - cl[16 * (r >> 3) + (r & 7)]; t1 += cq2 - cl[32 + 16 * (r >> 3) + (r & 7)]; }
                        const int k_0 = kl + 16 * (r >> 3) + (r & 7);
                        t0 = (k_0 <= row) ? t0 : -INFINITY; t1 = (k_0 + 32 <= row) ? t1 : -INFINITY;
                        p0[r] = t0; p1[r] = t1; mx = fmaxf(mx, fmaxf(t0, t1));
                    }
                    mx = fmaxf(mx, __shfl_xor(mx, 32));
                    float m_new;
                    if (MODE == M_FOX) { m_run = fmaxf(m_run, mx); m_new = fminf(qb2, 48.0f); corr = 1.0f; }
                    else { m_new = fmaxf(m_run, mx); corr = __builtin_amdgcn_exp2f(m_run - m_new); m_run = m_new; }
                    float sum = 0.f;
#pragma unroll
                    for (int r = 0; r < 16; ++r) { const float e0 = __builtin_amdgcn_exp2f(p0[r] - m_new), e1 = __builtin_amdgcn_exp2f(p1[r] - m_new); sum += e0 + e1; p0[r] = e0; p1[r] = e1; }
                    l_run = l_run * corr + sum;
                } else {
                    if (MODE == M_FOX) {
                        typedef float f32x2 __attribute__((ext_vector_type(2)));
                        const float base = cq2 - fminf(qb2, 48.0f); const f32x2 basev = (f32x2){base, base}, c2v = (f32x2){C2, C2};
                        f32x2 sa = (f32x2){0.f, 0.f}, sb = (f32x2){0.f, 0.f};
#pragma unroll
                        for (int r = 0; r < 16; r += 2) {
                            const f32x2 ca = *(const LAS f32x2*)(cl + 16 * (r >> 3) + (r & 7)), cb = *(const LAS f32x2*)(cl + 32 + 16 * (r >> 3) + (r & 7));
                            const f32x2 ta = (f32x2){p0[r], p0[r + 1]} * c2v + (basev - ca), tb = (f32x2){p1[r], p1[r + 1]} * c2v + (basev - cb);
                            const f32x2 ea = (f32x2){__builtin_amdgcn_exp2f(ta.x), __builtin_amdgcn_exp2f(ta.y)}, eb = (f32x2){__builtin_amdgcn_exp2f(tb.x), __builtin_amdgcn_exp2f(tb.y)};
                            sa += ea; sb += eb; p0[r] = ea.x; p0[r + 1] = ea.y; p1[r] = eb.x; p1[r + 1] = eb.y;
                        }
                        corr = 1.0f; l_run += (sa.x + sa.y) + (sb.x + sb.y);
                    } else {
                    float mx = -INFINITY;
#pragma unroll
                    for (int r = 0; r < 16; ++r) mx = fmaxf(mx, fmaxf(p0[r], p1[r]));
                    mx *= C2;
                    if (MODE == M_MOBA) mx = rowsel ? mx : -INFINITY;
                    mx = fmaxf(mx, __shfl_xor(mx, 32));
                    const float m_new = fmaxf(m_run, mx); corr = __builtin_amdgcn_exp2f(m_run - m_new); m_run = m_new;
                    const float off = (MODE == M_MOBA && !rowsel) ? -INFINITY : -m_new;
                    float s0 = 0.f, s1 = 0.f;
#pragma unroll
                    for (int r = 0; r < 16; ++r) { const float e0 = __builtin_amdgcn_exp2f(fmaf(p0[r], C2, off)), e1 = __builtin_amdgcn_exp2f(fmaf(p1[r], C2, off)); s0 += e0; s1 += e1; p0[r] = e0; p1[r] = e1; }
                    l_run = l_run * corr + (s0 + s1);
                    }
                }
                if (__any(corr != 1.0f)) {
#pragma unroll
                    for (int r = 0; r < 16; ++r) { o0[r] *= corr; o1[r] *= corr; }
                }
            }
            pkP0 = pack8(p0, 0); pkP1 = pack8(p0, 8); pkP2 = pack8(p1, 0); pkP3 = pack8(p1, 8);
            if (MODE == M_FOX) asm volatile("" :: "v"(kf[0]), "v"(kf[1]), "v"(kf[2]), "v"(kf[3]), "v"(kf[4]), "v"(kf[5]), "v"(kf[6]), "v"(kf[7]));
        } else {
        if (prev_active) {
            const LAS unsigned char* vb = lds + prevbuf + KB_BYTES + r32 * VT_STRIDE + hi * 16;
#define PVS(s, pk) do { const bf16x8 a0_ = *(const LAS bf16x8*)(vb + (s) * 32), a1_ = *(const LAS bf16x8*)(vb + 32 * VT_STRIDE + (s) * 32); \
            o0 = __builtin_amdgcn_mfma_f32_32x32x16_bf16(a0_, pk, o0, 0, 0, 0); o1 = __builtin_amdgcn_mfma_f32_32x32x16_bf16(a1_, pk, o1, 0, 0, 0); } while (0)
            PVS(0, pkP0); PVS(1, pkP1); PVS(2, pkP2); PVS(3, pkP3);
#undef PVS
        }
        }
        prev_active = active; prevbuf = 2 * BUF_BYTES;
        if (i + 1 < NT) STORET(0, k1, v1, c1);
        if (MODE == M_SB || MODE == M_FOX) {
            bool vote;
            if (MODE == M_SB) vote = __all(T < -151.0f) != 0;
            else { const float cn = (key0 > 0) ? A.cf[key0 - 1] * LOG2E : 0.f; vote = __all(qb2 + cq2 - cn < m_run - 151.0f) != 0; }
            if (lane == 0) ((LAS unsigned*)(lds + VOTE_OFF))[(i & 1) * 8 + wid] = (active && vote) ? 1u : 0u;
        }
        __syncthreads();
        if (MODE == M_SB || MODE == M_FOX) {
            const LAS unsigned* vv = (const LAS unsigned*)(lds + VOTE_OFF) + (i & 1) * 8;
            const unsigned all8 = (vv[0] & vv[1]) & (vv[2] & vv[3]) & (vv[4] & vv[5]) & (vv[6] & vv[7]);
            if (all8) break;
        }
        }
    }
#undef KEY0
#undef LOADT
#undef STORET
    if (prev_active) {
        const LAS unsigned char* vb = lds + prevbuf + KB_BYTES + r32 * VT_STRIDE + hi * 16;
#define PVS(s, pk) do { const bf16x8 a0_ = *(const LAS bf16x8*)(vb + (s) * 32), a1_ = *(const LAS bf16x8*)(vb + 32 * VT_STRIDE + (s) * 32); \
        o0 = __builtin_amdgcn_mfma_f32_32x32x16_bf16(a0_, pk, o0, 0, 0, 0); o1 = __builtin_amdgcn_mfma_f32_32x32x16_bf16(a1_, pk, o1, 0, 0, 0); } while (0)
        PVS(0, pkP0); PVS(1, pkP1); PVS(2, pkP2); PVS(3, pkP3);
#undef PVS
    }
    float inv = 1.0f;
    if (MODE != M_SB) { const float l = l_run + __shfl_xor(l_run, 32); inv = 1.0f / l; if (MODE == M_MOBA) { if (hi == 0) A.lse[(size_t)row * 32] = m_run + __builtin_amdgcn_logf(l); } }
    bf16_t* op = A.O + (size_t)row * A.ldo + 4 * hi;
#pragma unroll
    for (int g = 0; g < 4; ++g) {
        pg8::store4(op + 8 * g, (f32x4){o0[4 * g] * inv, o0[4 * g + 1] * inv, o0[4 * g + 2] * inv, o0[4 * g + 3] * inv});
        pg8::store4(op + 32 + 8 * g, (f32x4){o1[4 * g] * inv, o1[4 * g + 1] * inv, o1[4 * g + 2] * inv, o1[4 * g + 3] * inv});
    }
}

__device__ __forceinline__ void moba_routed_unit(LAS unsigned char* lds, const bf16_t* Qh, const bf16_t* Kh, const bf16_t* Vh, const int* selh, bf16_t* parth, float* lseh, int j, int b0, int b1) {
    int tid_ = threadIdx.x; asm volatile("" : "+v"(tid_)); const int tid = tid_, lane = tid & 63, wid = __builtin_amdgcn_readfirstlane(tid >> 6), r32 = lane & 31, hi = lane >> 5;
    LAS int* list = (LAS int*)(lds + 71680); LAS int* cnt = (LAS int*)(lds + 71680 + 16384);
    if (tid == 0) *cnt = 0;
    u32x4 kk[4], vv[4];
#pragma unroll
    for (int tl = 0; tl < 4; ++tl) { const size_t ro = (size_t)(256 * j + 64 * tl + lane) * 1024 + wid * 8; kk[tl] = *(const u32x4*)(Kh + ro); vv[tl] = *(const u32x4*)(Vh + ro); }
    __syncthreads();
    typedef int i32x4 __attribute__((ext_vector_type(4)));
    for (int t = 256 * b0 + tid; t < 256 * b1; t += 512) {
        const i32x4 s = *(const i32x4*)(selh + (size_t)t * 4);
        if (s.x == j) { const int p = __hip_atomic_fetch_add(cnt, 1, __ATOMIC_RELAXED, __HIP_MEMORY_SCOPE_WORKGROUP); list[p] = t; }
        if (s.y == j) { const int p = __hip_atomic_fetch_add(cnt, 1, __ATOMIC_RELAXED, __HIP_MEMORY_SCOPE_WORKGROUP); list[p] = t | (1 << 16); }
        if (s.z == j) { const int p = __hip_atomic_fetch_add(cnt, 1, __ATOMIC_RELAXED, __HIP_MEMORY_SCOPE_WORKGROUP); list[p] = t | (2 << 16); }
    }
#pragma unroll
    for (int tl = 0; tl < 4; ++tl) { LAS unsigned char* bb_ = lds + tl * BUF_BYTES; *(LAS u32x4*)(bb_ + wid * 1024 + lane * 16) = kk[tl];
        LAS unsigned short* vt_ = (LAS unsigned short*)(bb_ + KB_BYTES + (8 * wid) * VT_STRIDE + lane * 2); const u32x4 vreg = vv[tl];
        vt_[0 * 72] = (unsigned short)(vreg.x & 0xffffu); vt_[1 * 72] = (unsigned short)(vreg.x >> 16); vt_[2 * 72] = (unsigned short)(vreg.y & 0xffffu); vt_[3 * 72] = (unsigned short)(vreg.y >> 16);
        vt_[4 * 72] = (unsigned short)(vreg.z & 0xffffu); vt_[5 * 72] = (unsigned short)(vreg.z >> 16); vt_[6 * 72] = (unsigned short)(vreg.w & 0xffffu); vt_[7 * 72] = (unsigned short)(vreg.w >> 16); }
    __syncthreads();
    const int n = *cnt;
    const int kperm = (r32 & ~15) | (r32 & 3) | ((r32 & 4) << 1) | ((r32 & 8) >> 1);
    for (int g = wid; g * 32 < n; g += 8) {
        const int mi = g * 32 + r32; const bool valid = mi < n; const int e = list[valid ? mi : 0]; const int t = e & 0xffff, slot = e >> 16;
        bf16x8 qr[4];
#pragma unroll
        for (int d0 = 0; d0 < 4; ++d0) qr[d0] = *(const bf16x8*)(Qh + (size_t)t * 1024 + d0 * 16 + hi * 8);
        f32x16 o0, o1;
#pragma unroll
        for (int r = 0; r < 16; ++r) { o0[r] = 0.f; o1[r] = 0.f; }
        float m_run = -1e30f, l_run = 0.f;
#pragma unroll 1
        for (int tl = 0; tl < 4; ++tl) {
            LAS unsigned char* buf = lds + tl * BUF_BYTES;
            f32x16 p0, p1;
#pragma unroll
            for (int r = 0; r < 16; ++r) { p0[r] = 0.f; p1[r] = 0.f; }
            LAS unsigned char* kb = buf + kperm * 16 + hi * 1024;
            bf16x8 kf[8], va[8];
#pragma unroll
            for (int d0 = 0; d0 < 4; ++d0) { kf[2 * d0] = *(const LAS bf16x8*)(kb + d0 * 2048); kf[2 * d0 + 1] = *(const LAS bf16x8*)(kb + d0 * 2048 + 512); }
            __builtin_amdgcn_sched_barrier(0);
#pragma unroll
            for (int d0 = 0; d0 < 4; ++d0) {
                p0 = __builtin_amdgcn_mfma_f32_32x32x16_bf16(kf[2 * d0], qr[d0], p0, 0, 0, 0);
                p1 = __builtin_amdgcn_mfma_f32_32x32x16_bf16(kf[2 * d0 + 1], qr[d0], p1, 0, 0, 0);
            }
            float mx = -INFINITY;
#pragma unroll
            for (int r = 0; r < 16; ++r) mx = fmaxf(mx, fmaxf(p0[r], p1[r]));
            mx *= C2; mx = fmaxf(mx, __shfl_xor(mx, 32));
            const float m_new = fmaxf(m_run, mx), corr = __builtin_amdgcn_exp2f(m_run - m_new); m_run = m_new;
            float s0 = 0.f, s1 = 0.f;
#pragma unroll
            for (int r = 0; r < 16; ++r) { const float e0 = __builtin_amdgcn_exp2f(fmaf(p0[r], C2, -m_new)), e1 = __builtin_amdgcn_exp2f(fmaf(p1[r], C2, -m_new)); s0 += e0; s1 += e1; p0[r] = e0; p1[r] = e1; }
            l_run = l_run * corr + (s0 + s1);
            if (__any(corr != 1.0f)) {
#pragma unroll
                for (int r = 0; r < 16; ++r) { o0[r] *= corr; o1[r] *= corr; }
            }
            const bf16x8 pk0 = pack8(p0, 0), pk1 = pack8(p0, 8), pk2 = pack8(p1, 0), pk3 = pack8(p1, 8);
            const LAS unsigned char* vb = buf + KB_BYTES + r32 * VT_STRIDE + hi * 16;
#pragma unroll
            for (int s_ = 0; s_ < 4; ++s_) { va[2 * s_] = *(const LAS bf16x8*)(vb + s_ * 32); va[2 * s_ + 1] = *(const LAS bf16x8*)(vb + 32 * VT_STRIDE + s_ * 32); }
            __builtin_amdgcn_sched_barrier(0);
            o0 = __builtin_amdgcn_mfma_f32_32x32x16_bf16(va[0], pk0, o0, 0, 0, 0); o1 = __builtin_amdgcn_mfma_f32_32x32x16_bf16(va[1], pk0, o1, 0, 0, 0);
            o0 = __builtin_amdgcn_mfma_f32_32x32x16_bf16(va[2], pk1, o0, 0, 0, 0); o1 = __builtin_amdgcn_mfma_f32_32x32x16_bf16(va[3], pk1, o1, 0, 0, 0);
            o0 = __builtin_amdgcn_mfma_f32_32x32x16_bf16(va[4], pk2, o0, 0, 0, 0); o1 = __builtin_amdgcn_mfma_f32_32x32x16_bf16(va[5], pk2, o1, 0, 0, 0);
            o0 = __builtin_amdgcn_mfma_f32_32x32x16_bf16(va[6], pk3, o0, 0, 0, 0); o1 = __builtin_amdgcn_mfma_f32_32x32x16_bf16(va[7], pk3, o1, 0, 0, 0);
            asm volatile("" :: "v"(kf[0]), "v"(kf[1]), "v"(kf[2]), "v"(kf[3]), "v"(kf[4]), "v"(kf[5]), "v"(kf[6]), "v"(kf[7]), "v"(va[0]), "v"(va[1]), "v"(va[2]), "v"(va[3]), "v"(va[4]), "v"(va[5]), "v"(va[6]), "v"(va[7]));
        }
        const float l = l_run + __shfl_xor(l_run, 32), inv = 1.0f / l;
        if (valid) {
            bf16_t* op = parth + ((size_t)t * 32 + slot) * 64 + 4 * hi;
#pragma unroll
            for (int g4 = 0; g4 < 4; ++g4) {
                pg8::store4(op + 8 * g4, (f32x4){o0[4 * g4] * inv, o0[4 * g4 + 1] * inv, o0[4 * g4 + 2] * inv, o0[4 * g4 + 3] * inv});
                pg8::store4(op + 32 + 8 * g4, (f32x4){o1[4 * g4] * inv, o1[4 * g4 + 1] * inv, o1[4 * g4 + 2] * inv, o1[4 * g4 + 3] * inv});
            }
            if (hi == 0) lseh[(size_t)t * 32 + slot] = m_run + __builtin_amdgcn_logf(l);
        }
    }
    __syncthreads();
}
}
using pg8::bf16_t; using pg8::f32x4; using pg8::u32x4;
constexpr int S = 16384, D = 1024, DFF = 2816, NUP = 5632, MEM = 256;
constexpr size_t MiB = 1u << 20;
constexpr size_t WS_SSQ = 0;
constexpr size_t WS_KPART = 512 * 1024;
constexpr size_t WS_KMX = 1 * MiB;
constexpr size_t WS_WFT = 1 * MiB + 196608;
constexpr size_t WS_DUMMY = 1 * MiB + 131072;
constexpr size_t WS_CNT = 1 * MiB + 4096;
constexpr size_t WS_BAR = 1 * MiB + 65536;
constexpr size_t WS_LOGF = 2 * MiB, WS_CF = 3 * MiB;
constexpr size_t WS_ROPEC = 4 * MiB, WS_ROPES = 6 * MiB;
constexpr size_t WS_MN = 8 * MiB;
constexpr size_t WS_MKV = 9 * MiB;
constexpr size_t WS_XQ = 10 * MiB, WS_XO = 18 * MiB;
constexpr size_t WS_WIN0 = 26 * MiB, WS_WOUT0 = 32 * MiB, WS_WIN1 = 34 * MiB, WS_WOUT1 = WS_WIN1 + 3328 * 1024 * 2, WS_WXQ = WS_WOUT1 + 2 * MiB, WS_WXKV = WS_WXQ + 1 * MiB, WS_WXO = WS_WXKV + 2 * MiB,
                 WS_WUP = WS_WXO + 1 * MiB, WS_WDN = WS_WUP + 22 * MiB, WS_WEND = WS_WDN + 11 * MiB;
static_assert(WS_WEND <= 80 * MiB, "weights");
constexpr size_t WS_XB = 81 * MiB;
constexpr size_t WS_SEL = 242 * MiB, WS_LSE = 244 * MiB;
constexpr size_t WS_Q = 114 * MiB, WS_K = 146 * MiB, WS_V = 178 * MiB, WS_O = 210 * MiB, WS_ACT = 114 * MiB, WS_END = 246 * MiB;

#ifndef SC_MIX0
#define SC_MIX0 1.0f
#endif
#ifndef SC_MIX1
#define SC_MIX1 1.0f
#endif
#ifndef SC_XA
#define SC_XA 1.0f
#endif
#ifndef SC_FFN
#define SC_FFN 1.0f
#endif
#define RLX_AGENT __ATOMIC_RELAXED, __HIP_MEMORY_SCOPE_AGENT
#define XB_TMO      128
#define XB_XCNT(j)  (256  + 64 * (j))
#define XB_XSUB(j)  (1280 + 64 * (j))
#define XB_XGEN(j)  (2304 + 64 * (j))
#define XB_TOP      3328
#define XB_TOPGEN   3392
#define XCD_BAR_WORDS 3456
#define XB_SPIN_CAP (1u << 18)

__device__ __forceinline__ unsigned xb_ld(unsigned* p)              { return __hip_atomic_load(p, __ATOMIC_RELAXED, __HIP_MEMORY_SCOPE_AGENT); }
__device__ __forceinline__ unsigned xb_add(unsigned* p, unsigned v) { return __hip_atomic_fetch_add(p, v, __ATOMIC_RELAXED, __HIP_MEMORY_SCOPE_AGENT); }
__device__ __forceinline__ unsigned xb_xcc_id() { return (unsigned)__builtin_amdgcn_s_getreg((3 << 11) | 20) & 0xFu; }
#define XB_SPIN(cond, bar) do { unsigned _sp = 0; while (cond) { __builtin_amdgcn_s_sleep(1); \
    if ((++_sp & 255u) == 0u) { if (xb_ld(&(bar)[XB_TMO])) break; if (_sp > XB_SPIN_CAP) { atomicAdd(&(bar)[XB_TMO], 1u); break; } } } } while (0)

struct XcdBarrier {
    unsigned* bar; unsigned x;
    volatile LAS unsigned* st;
};

__device__ __forceinline__ XcdBarrier xcd_barrier_post(unsigned* bar, volatile LAS unsigned* st) {
    XcdBarrier b; b.bar = bar; b.x = xb_xcc_id(); b.st = st;
    if (threadIdx.x == 0) (void)xb_add(&bar[XB_XCNT(b.x)], 1u);
    return b;
}
__device__ __forceinline__ void xcd_barrier_complete(unsigned* bar, unsigned x, unsigned& nloc, unsigned& nx) {
    const unsigned G = gridDim.x * gridDim.y * gridDim.z;
    unsigned sum, cnt, mine, sp = 0u;
    for (;;) {
        sum = 0u; cnt = 0u; mine = 0u;
#pragma unroll
        for (unsigned j = 0; j < 16; ++j) { const unsigned c = xb_ld(&bar[XB_XCNT(j)]); sum += c; cnt += (c > 0u) ? 1u : 0u; mine = (j == x) ? c : mine; }
        if (sum == G) break;
        __builtin_amdgcn_s_sleep(1);
        if ((++sp & 255u) == 0u) { if (xb_ld(&bar[XB_TMO])) break; if (sp > XB_SPIN_CAP) { atomicAdd(&bar[XB_TMO], 1u); break; } }
    }
    nloc = mine > 0u ? mine : 1u; nx = cnt > 0u ? cnt : 1u;
}

__device__ __forceinline__ void xcd_barrier(const XcdBarrier& b) {
    asm volatile("s_waitcnt vmcnt(0)" ::: "memory");
    __syncthreads();
    if (threadIdx.x == 0) {
        unsigned* bar = b.bar;
        __builtin_amdgcn_s_waitcnt(0);
        unsigned nloc = b.st[0], nx = b.st[1];
        if (nloc == 0u) { xcd_barrier_complete(bar, b.x, nloc, nx); b.st[0] = nloc; b.st[1] = nx; }
        const unsigned old = xb_add(&bar[XB_XSUB(b.x)], 1u);
        const unsigned gen = old / nloc;
        if (old + 1u == (gen + 1u) * nloc) {
            __builtin_amdgcn_fence(__ATOMIC_RELEASE, "agent");
            asm volatile("s_waitcnt vmcnt(0)" ::: "memory");
            const unsigned og = xb_add(&bar[XB_TOP], 1u);
            const unsigned tg = og / nx;
            if (og + 1u == (tg + 1u) * nx) xb_add(&bar[XB_TOPGEN], 1u);
            else XB_SPIN(xb_ld(&bar[XB_TOPGEN]) == tg, bar);
            __builtin_amdgcn_fence(__ATOMIC_ACQUIRE, "agent");
            xb_add(&bar[XB_XGEN(b.x)], 1u);
            asm volatile("s_waitcnt vmcnt(0)" ::: "memory");
        } else {
            XB_SPIN(xb_ld(&bar[XB_XGEN(b.x)]) == gen, bar);
            __builtin_amdgcn_fence(__ATOMIC_ACQUIRE, "agent");
            asm volatile("s_waitcnt vmcnt(0)" ::: "memory");
        }
    }
    __syncthreads();
}

#ifndef REP_OUT
#define REP_OUT 1
#endif
#ifndef REP_XQ
#define REP_XQ 1
#endif
#ifndef REP_XO
#define REP_XO 1
#endif
#ifndef REP_DN
#define REP_DN 1
#endif
#ifndef REP_PRO
#define REP_PRO 1
#endif
#ifndef REP_QKV
#define REP_QKV 1
#endif
#ifndef REP_ATT0
#define REP_ATT0 1
#endif
#ifndef REP_FOX
#define REP_FOX 1
#endif
#ifndef REP_UP
#define REP_UP 1
#endif
#ifndef REP_SYNC
#define REP_SYNC 1
#endif
#ifndef REP_XA
#define REP_XA 1
#endif
struct Args { const float* in[20]; float* out; unsigned char* ws; };

__device__ __forceinline__ unsigned f2bf(float f) { unsigned u = __builtin_bit_cast(unsigned, f); return (u + 0x7fffu + ((u >> 16) & 1u)) >> 16; }
__device__ __forceinline__ unsigned pk2(float lo, float hi) { return f2bf(lo) | (f2bf(hi) << 16); }
__device__ __forceinline__ float wave_sum(float v) {
#pragma unroll
    for (int o = 1; o < 64; o <<= 1) v += __shfl_xor(v, o);
    return v;
}
__device__ __forceinline__ int colmap(int mode, int p) {
    if (mode == 1) { if ((p >= 512 && p < 1024) || (p >= 1536 && p < 2048)) { const int w = p & 63; return (p & ~63) + 32 * ((w >> 4) & 1) + 16 * (w >> 5) + (w & 15); } return p; }
    if (mode == 2) return ((p >> 7) & 1) * 2816 + (p >> 8) * 128 + (p & 127);
    return p;
}
__device__ __forceinline__ void conv_weight(const float* W, int ldw, int K, int Nphys, int Nvalid, int mode, const float* g, bf16_t* WT, LAS float* scr, int gw, int NGW, int lane, int& rot) {
    const int nblk = Nphys / 32, items = (K / 64) * nblk;
    const int g0 = (gw - rot % NGW + NGW) % NGW; rot += items;
    for (int it = g0; it < items; it += NGW) {
        const int kb = it / nblk, nb = it % nblk, k0 = 64 * kb, n0 = 32 * nb;
        const int prow = n0 + (lane & 31); const bool ok = prow < Nvalid; const int col = ok ? colmap(mode, prow) : 0;
        float wv_[32];
#pragma unroll
        for (int i = 0; i < 32; ++i) { const int kk = 2 * i + (lane >> 5); wv_[i] = ok ? W[(size_t)(k0 + kk) * ldw + col] : 0.f; }
#pragma unroll
        for (int i = 0; i < 32; ++i) { const int kk = 2 * i + (lane >> 5); float v = wv_[i]; if (g) v *= g[k0 + kk]; scr[kk * 33 + (lane & 31)] = v; }
        asm volatile("s_waitcnt lgkmcnt(0)" ::: "memory");
        const int c = lane & 7;
#pragma unroll
        for (int j = 0; j < 4; ++j) { const int n = (lane >> 3) + 8 * j; const LAS float* s = scr + (8 * c) * 33 + n;
            u32x4 o; o.x = pk2(s[0 * 33], s[1 * 33]); o.y = pk2(s[2 * 33], s[3 * 33]); o.z = pk2(s[4 * 33], s[5 * 33]); o.w = pk2(s[6 * 33], s[7 * 33]);
            *(u32x4*)(WT + (size_t)(n0 + n) * K + k0 + 8 * c) = o; }
        asm volatile("s_waitcnt lgkmcnt(0)" ::: "memory");
    }
}

template <class Epi>
__device__ __forceinline__ void run_gemm(LAS unsigned char* lds, const bf16_t* A, const bf16_t* Bt, int Mtiles, int N, int K, int a_w1, int a_h, int a_t, const Epi& E, int cshift = 0) {
    pg8::Gemm g{A, Bt, Mtiles * 256, N, K, a_w1, a_h, a_t};
    pg8::StaticOrder So; So.init(Mtiles * 256, N, (int)gridDim.x, (int)blockIdx.x - cshift);
    pg8::gemm_phase<Epi, pg8::StaticOrder, true, true>(lds, g, So, E);
}

template <int MODE>
__device__ __forceinline__ void attn_units(LAS unsigned char* lds, unsigned* counter, int idx0, int nunits, int nheads, int head0, bool head_major, const bf16_t* Q, int ldq, const bf16_t* K, const bf16_t* V, int ldkv, bf16_t* O, int ldo,
                                           const float* cf, const unsigned* kmx, const float* kpart, int* sel = nullptr, float* lse = nullptr) {
    LAS int* slot = (LAS int*)(lds + 147456 - 128);
    for (;;) {
        int idx;
        if (counter) {
            if (threadIdx.x == 0) *slot = (int)__hip_atomic_fetch_add(counter, 1u, __ATOMIC_RELAXED, __HIP_MEMORY_SCOPE_AGENT);
            __syncthreads(); idx = *slot - idx0; __syncthreads();
            if (idx >= nunits) break;
            if (idx < 0) continue;
        } else { idx = (int)blockIdx.x; if (idx >= nunits) break; }
        const int h = head_major ? (nheads - 1 - idx / 64) : (idx % nheads), qb = head_major ? (63 - idx % 64) : (63 - idx / nheads), hh = head0 + h;
        att::AttnArgs a; a.Q = Q + hh * 64; a.ldq = ldq; a.K = K + hh * 64; a.V = V + hh * 64; a.ldkv = ldkv; a.O = O + hh * 64; a.ldo = ldo;
        a.cf = cf ? cf + (size_t)hh * S : nullptr; a.kmax2 = kmx ? (__uint_as_float(kmx[2 * hh]) + __uint_as_float(kmx[2 * hh + 1])) * 1.02f : 0.f;
        a.kpart = kpart ? kpart + (size_t)h * 64 * 256 : nullptr;
        a.sel = sel ? sel + (size_t)h * S * 4 : nullptr; a.lse = lse ? lse + h * 4 + 3 : nullptr;
        if (MODE == att::M_MOBA) { a.O = O + (h * 4 + 3) * 64; }
        att::attn_unit<MODE>(lds, a, qb);
        if (!counter) break;
    }
}

typedef const __attribute__((address_space(4))) char* kargp_t;
__device__ __forceinline__ const void* kin(int i) { size_t o = (size_t)i * 8; asm volatile("" : "+s"(o)); return *(const void* const __attribute__((address_space(4)))*)((kargp_t)__builtin_amdgcn_kernarg_segment_ptr() + o); }
__device__ __forceinline__ unsigned char* wsoff(size_t off) { unsigned char* w = (unsigned char*)kin(21); asm volatile("" : "+s"(off)); return w + off; }
#define INF(i) ((const float*)kin(i))
#define OUTP ((float*)kin(20))
#define WSP(T, off) ((T*)wsoff(off))

#define GSYNC() do { XcdBarrier b_; b_.bar = WSP(unsigned, WS_BAR); b_.x = xb_xcc_id(); b_.st = (volatile LAS unsigned*)(lds + 147456 - 64); xcd_barrier(b_); } while (0)
__global__ void __launch_bounds__(512, 2) fwd_kernel(Args args) {
    extern __shared__ __attribute__((aligned(16))) unsigned char lds_raw[];
    LAS unsigned char* lds = (LAS unsigned char*)lds_raw;
    cg::grid_group grid = cg::this_grid();
    (void)args;
    if (threadIdx.x == 0) { volatile LAS unsigned* st_ = (volatile LAS unsigned*)(lds + 147456 - 64); st_[0] = 0u; st_[1] = 0u; }
#pragma unroll 1
    for (int rep_ = 0; rep_ < REP_PRO; ++rep_) {
        int tid_ = threadIdx.x; asm volatile("" : "+v"(tid_)); const int tid = tid_, lane = tid & 63, wave = __builtin_amdgcn_readfirstlane(tid >> 6);
        const int G = (int)gridDim.x, gw = (int)blockIdx.x * 8 + wave, NGW = G * 8, gt = (int)blockIdx.x * 512 + tid, NGT = G * 512;
        LAS float* scr = (LAS float*)(lds + wave * 16384); int rot = 0;
        conv_weight(INF(7), 3072, 1024, 3072, 3072, 1, INF(3), WSP(bf16_t, WS_WIN0), scr, gw, NGW, lane, rot);
        conv_weight(INF(8), 1024, 1024, 1024, 1024, 0, nullptr, WSP(bf16_t, WS_WOUT0), scr, gw, NGW, lane, rot);
        conv_weight(INF(9), 3088, 1024, 3072, 3072, 0, INF(3) + 1024, WSP(bf16_t, WS_WIN1), scr, gw, NGW, lane, rot);
        { const float* wi = INF(9); const float* gm = INF(3) + 1024; bf16_t* wf = WSP(bf16_t, WS_WFT);
          for (int idx = gt; idx < 32 * 1024; idx += NGT) { const int n = idx >> 10, k = idx & 1023; wf[idx] = (bf16_t)f2bf(n < 16 ? gm[k] * wi[(size_t)k * 3088 + 3072 + n] : 0.f); } }
        conv_weight(INF(11), 1024, 1024, 1024, 1024, 0, nullptr, WSP(bf16_t, WS_WOUT1), scr, gw, NGW, lane, rot);
#pragma unroll 1
        for (int l = 0; l < 2; ++l) {
            conv_weight(INF(12) + (size_t)l * 1024 * 256, 256, 1024, 256, 256, 0, INF(4) + l * 1024, WSP(bf16_t, WS_WXQ) + (size_t)l * 256 * 1024, scr, gw, NGW, lane, rot);
            conv_weight(INF(13) + (size_t)l * 1024 * 512, 512, 1024, 512, 512, 0, nullptr, WSP(bf16_t, WS_WXKV) + (size_t)l * 512 * 1024, scr, gw, NGW, lane, rot);
            conv_weight(INF(14) + (size_t)l * 256 * 1024, 1024, 256, 1024, 1024, 0, nullptr, WSP(bf16_t, WS_WXO) + (size_t)l * 1024 * 256, scr, gw, NGW, lane, rot);
            conv_weight(INF(15) + (size_t)l * 1024 * NUP, NUP, 1024, NUP, NUP, 2, INF(6) + l * 1024, WSP(bf16_t, WS_WUP) + (size_t)l * NUP * 1024, scr, gw, NGW, lane, rot);
            conv_weight(INF(18) + (size_t)l * DFF * 1024, 1024, DFF, 1024, 1024, 0, nullptr, WSP(bf16_t, WS_WDN) + (size_t)l * 1024 * DFF, scr, gw, NGW, lane, rot);
        }
        {
            const float* x = INF(0); float* ssq = WSP(float, WS_SSQ); bf16_t* XB = WSP(bf16_t, WS_XB);
            for (int m = gw; m < S; m += NGW) {
                const f32x4* xr = (const f32x4*)(x + (size_t)m * D) + lane; f32x4 v[4]; float s = 0.f;
#pragma unroll
                for (int j = 0; j < 4; ++j) { v[j] = xr[64 * j]; s += (v[j][0] * v[j][0] + v[j][1] * v[j][1]) + (v[j][2] * v[j][2] + v[j][3] * v[j][3]); }
                s = wave_sum(s); if (lane == 0) ssq[m] = s;
                unsigned long long* o8 = (unsigned long long*)(XB + (size_t)m * D) + lane;
#pragma unroll
                for (int j = 0; j < 4; ++j) o8[64 * j] = (unsigned long long)pk2(v[j][0], v[j][1]) | ((unsigned long long)pk2(v[j][2], v[j][3]) << 32);
            }
            for (int idx = gt; idx < 6 * S; idx += NGT) ssq[S + idx] = 0.f;
            for (int idx = gt; idx < 2 * D / 2; idx += NGT) ((unsigned*)(XB - 2 * D))[idx] = 0u;
            for (int idx = gt; idx < 256 * D / 2; idx += NGT) ((unsigned*)(XB + (size_t)S * D))[idx] = 0u;
            if (gt < 32) WSP(unsigned, WS_KMX)[gt] = 0u;
            if (gt < 128) WSP(unsigned, WS_CNT)[gt] = 0u;
            for (int idx = gt; idx < XCD_BAR_WORDS; idx += NGT) WSP(unsigned, WS_BAR)[idx] = 0u;
        }
        {
            const float* mem = INF(1); const float* g_mem = INF(5); bf16_t* MN = WSP(bf16_t, WS_MN);
            for (int m = gw; m < MEM; m += NGW) {
                const f32x4* xr = (const f32x4*)(mem + (size_t)m * D) + lane; f32x4 v[4]; float s = 0.f;
#pragma unroll
                for (int j = 0; j < 4; ++j) { v[j] = xr[64 * j]; s += (v[j][0] * v[j][0] + v[j][1] * v[j][1]) + (v[j][2] * v[j][2] + v[j][3] * v[j][3]); }
                s = wave_sum(s); const float rs = rsqrtf(s * (1.0f / 1024.0f) + 1e-6f);
#pragma unroll
                for (int l = 0; l < 2; ++l) { unsigned long long* o8 = (unsigned long long*)(MN + ((size_t)l * MEM + m) * D) + lane;
#pragma unroll
                    for (int j = 0; j < 4; ++j) { const f32x4 gg = ((const f32x4*)(g_mem + l * 1024) + lane)[64 * j];
                        o8[64 * j] = (unsigned long long)pk2(v[j][0] * rs * gg[0], v[j][1] * rs * gg[1]) | ((unsigned long long)pk2(v[j][2] * rs * gg[2], v[j][3] * rs * gg[3]) << 32); } }
            }
        }
        {
            const int* pos = (const int*)kin(2); float* ropec = WSP(float, WS_ROPEC); float* ropes = WSP(float, WS_ROPES);
            for (int idx = gt; idx < S * 32; idx += NGT) {
                const int t = idx >> 5, i = idx & 31;
                const float invf = (float)exp2(-(double)i * (13.287712379549449 / 32.0));
                const float ang = (float)pos[t] * invf;
                const double a = (double)ang; const double n = rint(a * 0.63661977236758134308); double rr = fma(-n, 1.57079632679489655800e+00, a); rr = fma(-n, 6.12323399573676603587e-17, rr);
                const double r2 = rr * rr;
                const double sn = rr * (1.0 + r2 * (-1.0 / 6 + r2 * (1.0 / 120 + r2 * (-1.0 / 5040 + r2 * (1.0 / 362880 + r2 * (-1.0 / 39916800 + r2 * (1.0 / 6227020800.0)))))));
                const double cs = 1.0 + r2 * (-0.5 + r2 * (1.0 / 24 + r2 * (-1.0 / 720 + r2 * (1.0 / 40320 + r2 * (-1.0 / 3628800 + r2 * (1.0 / 479001600.0 + r2 * (-1.0 / 87178291200.0)))))));
                const int qd = ((int)(long long)n) & 3;
                const double co = (qd == 0) ? cs : (qd == 1) ? -sn : (qd == 2) ? -cs : sn, si = (qd == 0) ? sn : (qd == 1) ? cs : (qd == 2) ? -sn : -cs;
                ropec[idx] = (float)co; ropes[idx] = (float)si;
            }
        }
    }
    grid.sync();
    if (threadIdx.x == 0) (void)xb_add(&WSP(unsigned, WS_BAR)[XB_XCNT(xb_xcc_id())], 1u);
#pragma unroll 1
    for (int layer = 0; layer < 2; ++layer) {
#pragma unroll 1
        for (int rep_ = 0; rep_ < REP_QKV; ++rep_)
        if (layer == 0) {
            { pg8::EpiQKV0 E{WSP(bf16_t, WS_Q), (size_t)(WS_K - WS_Q) / 2, WSP(float, WS_SSQ), WSP(float, WS_ROPEC), WSP(float, WS_ROPES), WSP(float, WS_KPART)};
              run_gemm(lds, WSP(bf16_t, WS_XB), WSP(bf16_t, WS_WIN0), S / 256, 3072, 1024, 64, 128, 256, E); }
        } else {
            {
                int tid_ = threadIdx.x; asm volatile("" : "+v"(tid_)); const int tid = tid_, lane = tid & 63, wv = __builtin_amdgcn_readfirstlane(tid >> 6), r32 = lane & 31, hi = lane >> 5;
                const bf16_t* XBp = WSP(bf16_t, WS_XB); const bf16_t* WF = WSP(bf16_t, WS_WFT); const float* ssq3 = WSP(float, WS_SSQ) + (size_t)3 * S; const float* bfg = INF(10); float* lf = WSP(float, WS_LOGF);
                LAS float* red = (LAS float*)lds;
                for (int rb = (int)blockIdx.x * 64; rb < S; rb += (int)gridDim.x * 64) {
                    att::f32x16 a0, a1;
#pragma unroll
                    for (int r = 0; r < 16; ++r) { a0[r] = 0.f; a1[r] = 0.f; }
                    pg8::bf16x8 af0[8], af1[8], bfr[8];
#pragma unroll
                    for (int s = 0; s < 8; ++s) { const int ko = wv * 128 + 16 * s + 8 * hi;
                        bfr[s] = *(const pg8::bf16x8*)(WF + (size_t)r32 * 1024 + ko); af0[s] = *(const pg8::bf16x8*)(XBp + (size_t)(rb + r32) * 1024 + ko); af1[s] = *(const pg8::bf16x8*)(XBp + (size_t)(rb + 32 + r32) * 1024 + ko); }
#pragma unroll
                    for (int s = 0; s < 8; ++s) { a0 = __builtin_amdgcn_mfma_f32_32x32x16_bf16(af0[s], bfr[s], a0, 0, 0, 0); a1 = __builtin_amdgcn_mfma_f32_32x32x16_bf16(af1[s], bfr[s], a1, 0, 0, 0); }
                    if (r32 < 16) {
#pragma unroll
                        for (int r = 0; r < 16; ++r) { const int i = (r & 3) + 8 * (r >> 2) + 4 * hi; red[(wv * 64 + i) * 16 + r32] = a0[r]; red[(wv * 64 + 32 + i) * 16 + r32] = a1[r]; }
                    }
                    __syncthreads();
                    for (int o = tid; o < 1024; o += 512) { const int tok = o >> 4, h = o & 15; float sum = 0.f;
#pragma unroll
                        for (int w = 0; w < 8; ++w) sum += red[(w * 64 + tok) * 16 + h];
                        const int row = rb + tok; const float x = sum * pg8::rstd_of(ssq3, row) + bfg[h];
                        lf[(size_t)h * S + row] = fminf(x, 0.f) - log1pf(expf(-fabsf(x))); }
                    __syncthreads();
                }
            }
            pg8::EpiBf E{WSP(bf16_t, WS_Q), 1024, WSP(float, WS_SSQ) + (size_t)3 * S, 4, (size_t)(WS_K - WS_Q) / 2, nullptr, nullptr, WSP(unsigned, WS_KMX)};
            run_gemm(lds, WSP(bf16_t, WS_XB), WSP(bf16_t, WS_WIN1), S / 256, 3072, 1024, 64, 128, 256, E);
        }
        GSYNC();
        if (layer == 0) {
            attn_units<att::M_MOBA>(lds, WSP(unsigned, WS_CNT), 0, 512, 8, 8, false, WSP(bf16_t, WS_Q), 1024, WSP(bf16_t, WS_K), WSP(bf16_t, WS_V), 1024, (bf16_t*)OUTP, 2048, nullptr, nullptr, WSP(float, WS_KPART), WSP(int, WS_SEL), WSP(float, WS_LSE));
            attn_units<att::M_SB>(lds, WSP(unsigned, WS_CNT) + 32, 0, 512, 8, 0, false, WSP(bf16_t, WS_Q), 1024, WSP(bf16_t, WS_K), WSP(bf16_t, WS_V), 1024, WSP(bf16_t, WS_O), 1024, nullptr, nullptr, nullptr);
            GSYNC();
            {
                LAS int* slot = (LAS int*)(lds + 147456 - 128);
                for (;;) {
                    if (threadIdx.x == 0) *slot = (int)__hip_atomic_fetch_add(WSP(unsigned, WS_CNT) + 96, 1u, __ATOMIC_RELAXED, __HIP_MEMORY_SCOPE_AGENT);
                    __syncthreads(); const int idx = *slot; __syncthreads();
                    if (idx >= 1248) break;
                    const int h8 = idx & 7; int u = idx >> 3, j = 0;
                    while (u >= ((63 - j + 15) >> 4)) { u -= ((63 - j + 15) >> 4); ++j; }
                    const int b0 = j + 1 + 16 * u, b1 = (b0 + 16 < 64) ? b0 + 16 : 64;
                    att::moba_routed_unit(lds, WSP(bf16_t, WS_Q) + (8 + h8) * 64, WSP(bf16_t, WS_K) + (8 + h8) * 64, WSP(bf16_t, WS_V) + (8 + h8) * 64, WSP(int, WS_SEL) + (size_t)h8 * S * 4,
                                          (bf16_t*)OUTP + h8 * 4 * 64, WSP(float, WS_LSE) + h8 * 4, j, b0, b1);
                }
            }
            GSYNC();
            {
                int tid_ = threadIdx.x; asm volatile("" : "+v"(tid_)); const int tid = tid_, lane = tid & 63, wave = __builtin_amdgcn_readfirstlane(tid >> 6);
                const int gw = (int)blockIdx.x * 8 + wave, NGW = (int)gridDim.x * 8;
                const bf16_t* part = (const bf16_t*)OUTP; const float* lse = WSP(float, WS_LSE); bf16_t* Ob = WSP(bf16_t, WS_O);
                for (int p = gw * 8 + (lane >> 3); p < S * 8; p += NGW * 8) {
                    const int t = p >> 3, h8 = p & 7, ch = lane & 7; const int own = t >> 8, nv = own < 3 ? own : 3;
                    const f32x4 ls = *(const f32x4*)(lse + (size_t)p * 4);
                    float mx = ls[3];
                    if (nv > 0) mx = fmaxf(mx, ls[0]); if (nv > 1) mx = fmaxf(mx, ls[1]); if (nv > 2) mx = fmaxf(mx, ls[2]);
                    const float w0 = nv > 0 ? __builtin_amdgcn_exp2f(ls[0] - mx) : 0.f, w1 = nv > 1 ? __builtin_amdgcn_exp2f(ls[1] - mx) : 0.f, w2 = nv > 2 ? __builtin_amdgcn_exp2f(ls[2] - mx) : 0.f, w3 = __builtin_amdgcn_exp2f(ls[3] - mx);
                    const float wi = 1.0f / ((w0 + w1) + (w2 + w3));
                    float acc8[8];
#pragma unroll
                    for (int e = 0; e < 8; ++e) acc8[e] = 0.f;
#pragma unroll
                    for (int s = 0; s < 4; ++s) {
                        const float w = (s == 0) ? w0 : (s == 1) ? w1 : (s == 2) ? w2 : w3;
                        if (s == 3 || s < nv) {
                            const pg8::bf16x8 v = *(const pg8::bf16x8*)(part + ((size_t)p * 4 + s) * 64 + ch * 8);
#pragma unroll
                            for (int e = 0; e < 8; ++e) acc8[e] += w * att::bf2f(v[e]);
                        }
                    }
                    pg8::store8(Ob + (size_t)t * 1024 + (8 + h8) * 64 + ch * 8, (f32x4){acc8[0] * wi, acc8[1] * wi, acc8[2] * wi, acc8[3] * wi}, (f32x4){acc8[4] * wi, acc8[5] * wi, acc8[6] * wi, acc8[7] * wi});
                }
            }
        } else {
            {
                int tid_ = threadIdx.x; asm volatile("" : "+v"(tid_)); const int tid = tid_, lane = tid & 63, wv = tid >> 6;
                LAS double* sc = (LAS double*)lds;
                for (int wgi = (int)blockIdx.x; wgi < 256; wgi += (int)gridDim.x) {
                    const int h = wgi >> 4, seg = wgi & 15;
                    const float* src = WSP(float, WS_LOGF) + (size_t)h * S;
                    double part = 0.0;
                    for (int i = tid; i < seg * 1024; i += 512) part += (double)src[i];
#pragma unroll
                    for (int o = 32; o >= 1; o >>= 1) part += __shfl_xor(part, o);
                    const int e0 = seg * 1024 + 2 * tid; const double a = (double)src[e0], b = (double)src[e0 + 1];
                    double incl = a + b;
#pragma unroll
                    for (int o = 1; o < 64; o <<= 1) { const double t = __shfl_up(incl, o); if (lane >= o) incl += t; }
                    if (lane == 0) sc[wv] = part;
                    if (lane == 63) sc[8 + wv] = incl;
                    __syncthreads();
                    double before = 0.0;
#pragma unroll
                    for (int k = 0; k < 8; ++k) before += sc[k];
                    for (int k = 0; k < wv; ++k) before += sc[8 + k];
                    const double excl = before + (incl - (a + b));
                    float* dst = WSP(float, WS_CF) + (size_t)h * S + e0;
                    dst[0] = (float)(excl + a); dst[1] = (float)(excl + a + b);
                    __syncthreads();
                }
            }
            GSYNC();
#pragma unroll 1
            for (int rep_ = 0; rep_ < REP_FOX; ++rep_)
            attn_units<att::M_FOX>(lds, WSP(unsigned, WS_CNT) + 64, 0, 1024, 16, 0, true, WSP(bf16_t, WS_Q), 1024, WSP(bf16_t, WS_K), WSP(bf16_t, WS_V), 1024, WSP(bf16_t, WS_O), 1024, WSP(float, WS_CF), WSP(unsigned, WS_KMX), nullptr);
        }
        GSYNC();
#pragma unroll 1
        for (int rep_ = REP_OUT - 1; rep_ >= 0; --rep_)
        { pg8::EpiRes E{(layer == 0 && rep_ == 0) ? INF(0) : (const float*)OUTP, OUTP, WSP(bf16_t, WS_XB), rep_ ? WSP(float, WS_DUMMY) : WSP(float, WS_SSQ) + (size_t)(3 * layer + 1) * S, rep_ ? 0.0f : (layer == 0 ? SC_MIX0 : SC_MIX1)};
          run_gemm(lds, WSP(bf16_t, WS_O), layer == 0 ? WSP(bf16_t, WS_WOUT0) : WSP(bf16_t, WS_WOUT1), S / 256, 1024, 1024, 64, 128, 256, E); }
        GSYNC();
#pragma unroll 1
        for (int rep_ = 0; rep_ < REP_XQ; ++rep_)
        { pg8::EpiBf E{WSP(bf16_t, WS_XQ), 256, WSP(float, WS_SSQ) + (size_t)(3 * layer + 1) * S, 0, 0, nullptr, nullptr, nullptr};
          run_gemm(lds, WSP(bf16_t, WS_XB), WSP(bf16_t, WS_WXQ) + (size_t)layer * 256 * 1024, S / 256, 256, 1024, 64, 128, 256, E); }
        if (layer == 0 && (int)blockIdx.x >= 64 && (int)blockIdx.x < 68) {
            const int l = ((int)blockIdx.x - 64) >> 1;
            pg8::EpiBf E2{WSP(bf16_t, WS_MKV) + (size_t)l * MEM * 512, 512, nullptr, 0, 0, nullptr, nullptr, nullptr};
            run_gemm(lds, WSP(bf16_t, WS_MN) + (size_t)l * MEM * D, WSP(bf16_t, WS_WXKV) + (size_t)l * 512 * 1024, 1, 512, 1024, 64, 128, 256, E2, 64 + 2 * l);
        }
        GSYNC();
#pragma unroll 1
        for (int rep_ = 0; rep_ < REP_XA; ++rep_)
        attn_units<att::M_XA>(lds, nullptr, 0, 256, 4, 0, false, WSP(bf16_t, WS_XQ), 256, WSP(bf16_t, WS_MKV) + (size_t)layer * MEM * 512, WSP(bf16_t, WS_MKV) + (size_t)layer * MEM * 512 + 256, 512, WSP(bf16_t, WS_XO), 256, nullptr, nullptr, nullptr);
        GSYNC();
#pragma unroll 1
        for (int rep_ = REP_XO - 1; rep_ >= 0; --rep_)
        { pg8::EpiRes E{OUTP, OUTP, WSP(bf16_t, WS_XB), rep_ ? WSP(float, WS_DUMMY) : WSP(float, WS_SSQ) + (size_t)(3 * layer + 2) * S, rep_ ? 0.0f : SC_XA};
          run_gemm(lds, WSP(bf16_t, WS_XO), WSP(bf16_t, WS_WXO) + (size_t)layer * 1024 * 256, S / 256, 1024, 256, 64, 128, 256, E); }
        GSYNC();
#pragma unroll 1
        for (int rep_ = 0; rep_ < REP_UP; ++rep_)
        { pg8::EpiUpConv E{WSP(bf16_t, WS_ACT), WSP(float, WS_SSQ) + (size_t)(3 * layer + 2) * S, INF(16) + (size_t)layer * 3 * NUP, INF(17) + (size_t)layer * NUP};
          run_gemm(lds, WSP(bf16_t, WS_XB) - 2 * D, WSP(bf16_t, WS_WUP) + (size_t)layer * NUP * 1024, 66, NUP, 1024, 126, 64, 252, E); }
        GSYNC();
#pragma unroll 1
        for (int rep_ = REP_DN - 1; rep_ >= 0; --rep_)
        { pg8::EpiRes E{OUTP, OUTP, layer == 1 ? (bf16_t*)nullptr : WSP(bf16_t, WS_XB), rep_ ? WSP(float, WS_DUMMY) : WSP(float, WS_SSQ) + (size_t)(3 * layer + 3) * S, rep_ ? 0.0f : SC_FFN};
          run_gemm(lds, WSP(bf16_t, WS_ACT), WSP(bf16_t, WS_WDN) + (size_t)layer * 1024 * DFF, S / 256, 1024, DFF, 64, 128, 256, E); }
        GSYNC();
#pragma unroll 1
        for (int rep_ = 1; rep_ < REP_SYNC; ++rep_) { GSYNC(); GSYNC(); GSYNC(); GSYNC(); GSYNC(); }
    }
    {
        int tid_ = threadIdx.x; asm volatile("" : "+v"(tid_)); const int tid = tid_, lane = tid & 63, wave = __builtin_amdgcn_readfirstlane(tid >> 6);
        const int gw = (int)blockIdx.x * 8 + wave, NGW = (int)gridDim.x * 8;
        const float* ssq_fin = WSP(float, WS_SSQ) + (size_t)6 * S; const float* gf = INF(19); float* out = OUTP;
        for (int m = gw; m < S; m += NGW) {
            const float rs = rsqrtf(ssq_fin[m] * (1.0f / 1024.0f) + 1e-6f);
            f32x4* xr = (f32x4*)(out + (size_t)m * D) + lane;
#pragma unroll
            for (int j = 0; j < 4; ++j) { const f32x4 gg = ((const f32x4*)gf + lane)[64 * j]; xr[64 * j] = xr[64 * j] * rs * gg; }
        }
    }
}

extern "C" void kernel_launch(void* const* d_in, const int* in_sizes, int n_in, void* d_out, int out_size, void* d_ws, size_t ws_size, hipStream_t stream) {
    static int grid = 0;
    constexpr int LDSB = 147456;
    if (grid == 0) {
        if (n_in != 20 || out_size != S * D || ws_size < WS_END) { fprintf(stderr, "kernel_launch: unexpected shapes (n_in %d out %d ws %zu)\n", n_in, out_size, ws_size); grid = -1; return; }
        int dev = 0, cus = 0, per = 0;
        hipGetDevice(&dev); hipDeviceGetAttribute(&cus, hipDeviceAttributeMultiprocessorCount, dev);
        hipFuncSetAttribute((const void*)fwd_kernel, hipFuncAttributeMaxDynamicSharedMemorySize, LDSB);
        hipOccupancyMaxActiveBlocksPerMultiprocessor(&per, (const void*)fwd_kernel, 512, LDSB);
        (void)hipGetLastError();
        grid = cus;
        if (per < 1) fprintf(stderr, "kernel_launch: occupancy query reports %d blocks/CU\n", per);
    }
    if (grid < 0) return;
    Args a{};
    for (int i = 0; i < 20; ++i) a.in[i] = (const float*)d_in[i];
    a.out = (float*)d_out; a.ws = (unsigned char*)d_ws;
    void* kargs[] = {&a};
    hipError_t e = hipLaunchCooperativeKernel((const void*)fwd_kernel, dim3(grid), dim3(512), kargs, LDSB, stream);
    if (e != hipSuccess) fprintf(stderr, "cooperative launch failed: %s (grid %d)\n", hipGetErrorString(e), grid);
}
```

```cpp
#include <hip/hip_runtime.h>
#include <hip/hip_cooperative_groups.h>
#include <cstdio>
#include <cstdint>
namespace cg = cooperative_groups;
namespace pg8 {
#define PG8_LAS __attribute__((address_space(3)))
typedef unsigned short bf16_t;
typedef short bf16x8 __attribute__((ext_vector_type(8)));
typedef float f32x4 __attribute__((ext_vector_type(4)));
typedef unsigned u32x4 __attribute__((ext_vector_type(4)));
constexpr int BM = 256, BK = 64, HALF = 128, HTB = HALF * BK * 2  , STAGE_BYTES = 8 * HTB, NXCD = 8, WGM = 8;

__host__ __device__ __forceinline__ int lds_byte(int r, int c) { const int st = (r >> 4) * 2 + (c >> 5), rr = r & 15, cc = c & 31, ob = rr * 64 + cc * 2; return st * 1024 + (ob ^ (((ob >> 9) & 1) << 5)); }
__host__ __device__ __forceinline__ void stage_rc(int b, int& R, int& C) { const int st = b / 1024, sb = b % 1024, swz = sb ^ (((sb >> 9) & 1) << 5); R = (st >> 1) * 16 + swz / 64; C = (st & 1) * 32 + (swz % 64) / 2; }
__host__ __device__ __forceinline__ int perm32(int rho) { const int n = rho >> 4, i = rho & 15; return 8 * (i >> 2) + 4 * n + (i & 3); }

struct Unit { int pm, pn; };
struct Gemm { const bf16_t* A; const bf16_t* Bt; int M, N, K; int a_w1, a_h, a_t; };

struct StaticOrder {
    int nM, nN, nwg, G, c;
    __host__ __device__ void init(int M, int N, int G_, int c_) { nM = M / BM; nN = N / BM; nwg = nM * nN; G = G_; c = c_; }
    __host__ __device__ bool next(int i, Unit& u) const {
        const long L = (long)i * G + c; if (L >= nwg) return false;
        int wgid = (int)L; { const int q = nwg / NXCD, r = nwg % NXCD, xcd = wgid % NXCD, off = wgid / NXCD; wgid = (xcd < r ? xcd * (q + 1) : r * (q + 1) + (xcd - r) * q) + off; }
        const int nig = WGM * nN, gid = wgid / nig, fm = gid * WGM, gsz = (nM - fm) < WGM ? (nM - fm) : WGM;
        u.pm = fm + ((wgid % nig) % gsz); u.pn = (wgid % nig) / gsz; return true;
    }
    __device__ __forceinline__ void a_ready(const Unit&) const {}
    __device__ __forceinline__ void done(const Unit&) const {}
};

typedef unsigned u32x2 __attribute__((ext_vector_type(2)));
__device__ __forceinline__ unsigned cvt_pk_bf16(float lo, float hi) { unsigned r; asm volatile("v_cvt_pk_bf16_f32 %0, %1, %2" : "=v"(r) : "v"(lo), "v"(hi)); return r; }
__device__ __forceinline__ void store4(bf16_t* p, f32x4 v) { u32x2 w; w.x = cvt_pk_bf16(v[0], v[1]); w.y = cvt_pk_bf16(v[2], v[3]); *(u32x2*)p = w; }
__device__ __forceinline__ void store8(bf16_t* p, f32x4 a, f32x4 b) { u32x4 w; w.x = cvt_pk_bf16(a[0], a[1]); w.y = cvt_pk_bf16(a[2], a[3]); w.z = cvt_pk_bf16(b[0], b[1]); w.w = cvt_pk_bf16(b[2], b[3]); *(u32x4*)p = w; }
__device__ __forceinline__ float rstd_of(const float* ssq, int row) { return rsqrtf(ssq[row] * (1.0f / 1024.0f) + 1e-6f); }
constexpr int SEQ = 16384;

struct EpiQKV0 {
    static constexpr bool PERM = false, AFTER_DRAIN = false;
    bf16_t* Q; size_t tstride; const float* ssq; const float* ropec; const float* ropes; float* kpart;
    __device__ __forceinline__ void operator()(const f32x4 (&acc)[2][2][4][2], const Unit& u, int wr, int wc, int fr, int fq) const {
        const int t = u.pn >> 2, pq = u.pn & 3;
        bf16_t* base = Q + (size_t)t * tstride;
        const bool rope = (t < 2) && (pq >= 2);
#pragma unroll
        for (int ai = 0; ai < 2; ++ai) {
            f32x4 ks00 = (f32x4){0.f, 0.f, 0.f, 0.f}, ks01 = ks00, ks10 = ks00, ks11 = ks00;
#pragma unroll
            for (int m = 0; m < 4; ++m) {
                const int row = u.pm * 256 + ai * 128 + wr * 64 + m * 16 + fr;
                const float rs = rstd_of(ssq, row);
#pragma unroll
                for (int bj = 0; bj < 2; ++bj) {
                    const int hcol = pq * 256 + bj * 128 + (wc >> 1) * 64;
                    const f32x4 v0 = acc[ai][bj][m][0] * rs, v1 = acc[ai][bj][m][1] * rs;
                    bf16_t* rp = base + (size_t)row * 1024 + hcol;
                    if (rope) {
                        const int i0 = 16 * (wc & 1) + 4 * fq;
                        const f32x4 c = *(const f32x4*)(ropec + (size_t)row * 32 + i0), s = *(const f32x4*)(ropes + (size_t)row * 32 + i0);
                        const f32x4 o1 = v0 * c - v1 * s, o2 = v1 * c + v0 * s;
                        store4(rp + i0, o1); store4(rp + 32 + i0, o2);
                        if (bj == 0) { ks00 += o1; ks01 += o2; } else { ks10 += o1; ks11 += o2; }
                    } else {
                        const int d0 = 32 * (wc & 1) + 4 * fq;
                        store4(rp + d0, v0); store4(rp + d0 + 16, v1);
                    }
                }
            }
            if (rope && t == 1) {
#define KSRED(s_, bj_, n_) do { f32x4 s = s_; _Pragma("unroll") for (int o = 1; o < 16; o <<= 1) { s[0] += __shfl_xor(s[0], o); s[1] += __shfl_xor(s[1], o); s[2] += __shfl_xor(s[2], o); s[3] += __shfl_xor(s[3], o); } \
                if (fr == 0) { const int h8 = (pq - 2) * 4 + (bj_) * 2 + (wc >> 1); *(f32x4*)(kpart + (((size_t)h8 * 64 + u.pm) * 4 + ai * 2 + wr) * 64 + 32 * (n_) + 16 * (wc & 1) + 4 * fq) = s; } } while (0)
                KSRED(ks00, 0, 0); KSRED(ks01, 0, 1); KSRED(ks10, 1, 0); KSRED(ks11, 1, 1);
#undef KSRED
            }
        }
    }
};

struct EpiBf {
    static constexpr bool PERM = true, AFTER_DRAIN = false;
    bf16_t* O; int ldc; const float* ssq; int split_tiles; size_t split_stride; float* logf; const float* bfg; unsigned* kmx;
    __device__ __forceinline__ void operator()(const f32x4 (&acc)[2][2][4][2], const Unit& u, int wr, int wc, int fr, int fq) const {
        int pn = u.pn; bf16_t* base = O; int t = 0;
        if (split_tiles) { t = pn / split_tiles; pn -= t * split_tiles; base += (size_t)t * split_stride; }
        if (logf && t == 3) {
            if (wc == 0 && fq < 2) {
#pragma unroll
                for (int ai = 0; ai < 2; ++ai)
#pragma unroll
                    for (int m = 0; m < 4; ++m) { const int row = u.pm * 256 + ai * 128 + wr * 64 + m * 16 + fr; const float rs = rstd_of(ssq, row);
#pragma unroll
                        for (int n = 0; n < 2; ++n)
#pragma unroll
                            for (int j = 0; j < 4; ++j) { const int h = 8 * fq + 4 * n + j; const float x = acc[ai][0][m][n][j] * rs + bfg[h];
                                logf[(size_t)h * SEQ + row] = fminf(x, 0.f) - log1pf(expf(-fabsf(x))); } }
            }
            return;
        }
        const bool domax = (kmx != nullptr) && (t == 1);
        float mx0 = 0.f, mx1 = 0.f;
#pragma unroll
        for (int ai = 0; ai < 2; ++ai)
#pragma unroll
            for (int m = 0; m < 4; ++m) { const int row = u.pm * 256 + ai * 128 + wr * 64 + m * 16 + fr; const float rs = ssq ? rstd_of(ssq, row) : 1.0f;
                bf16_t* rp = base + (size_t)row * ldc + pn * 256 + wc * 32 + 8 * fq;
#pragma unroll
                for (int bj = 0; bj < 2; ++bj) { const f32x4 v0 = acc[ai][bj][m][0] * rs, v1 = acc[ai][bj][m][1] * rs; store8(rp + bj * 128, v0, v1);
                    if (domax) { float q = (v0[0] * v0[0] + v0[1] * v0[1]) + (v0[2] * v0[2] + v0[3] * v0[3]) + (v1[0] * v1[0] + v1[1] * v1[1]) + (v1[2] * v1[2] + v1[3] * v1[3]);
                        q += __shfl_xor(q, 16); q += __shfl_xor(q, 32); if (bj == 0) mx0 = fmaxf(mx0, q); else mx1 = fmaxf(mx1, q); } }
            }
        if (domax) {
#pragma unroll
            for (int o = 1; o < 16; o <<= 1) { mx0 = fmaxf(mx0, __shfl_xor(mx0, o)); mx1 = fmaxf(mx1, __shfl_xor(mx1, o)); }
            if (fr == 0 && fq == 0) { const int h0 = pn * 4 + (wc >> 1);
                atomicMax(kmx + (h0 * 2 + (wc & 1)), __float_as_uint(mx0)); atomicMax(kmx + ((h0 + 2) * 2 + (wc & 1)), __float_as_uint(mx1)); }
        }
    }
};

struct EpiRes {
    static constexpr bool PERM = false, AFTER_DRAIN = false;
    const float* Hin; float* Hout; bf16_t* XB; float* ssq; float sc;
    __device__ __forceinline__ void operator()(const f32x4 (&acc)[2][2][4][2], const Unit& u, int wr, int wc, int fr, int fq) const {
#pragma unroll
        for (int ai = 0; ai < 2; ++ai)
#pragma unroll
            for (int m = 0; m < 4; ++m) { const int row = u.pm * 256 + ai * 128 + wr * 64 + m * 16 + fr; float sq = 0.f;
                const size_t off = (size_t)row * 1024 + u.pn * 256 + wc * 32 + 4 * fq;
#pragma unroll
                for (int bj = 0; bj < 2; ++bj)
#pragma unroll
                    for (int n = 0; n < 2; ++n) { const size_t o = off + bj * 128 + n * 16; const f32x4 h = *(const f32x4*)(Hin + o) + acc[ai][bj][m][n] * sc;
                        *(f32x4*)(Hout + o) = h; if (XB) store4(XB + o, h); sq += (h[0] * h[0] + h[1] * h[1]) + (h[2] * h[2] + h[3] * h[3]); }
                sq += __shfl_xor(sq, 16); sq += __shfl_xor(sq, 32);
                if (fq == 0) __hip_atomic_fetch_add(ssq + row, sq, __ATOMIC_RELAXED, __HIP_MEMORY_SCOPE_AGENT);
            }
    }
};

__device__ __forceinline__ float dpp_ror1(float x) { float r; asm volatile("s_nop 1\n\tv_mov_b32_dpp %0, %1 row_ror:1 row_mask:0xf bank_mask:0xf" : "=v"(r) : "v"(x)); return r; }
__device__ __forceinline__ float dpp_ror2(float x) { float r; asm volatile("s_nop 1\n\tv_mov_b32_dpp %0, %1 row_ror:2 row_mask:0xf bank_mask:0xf" : "=v"(r) : "v"(x)); return r; }
struct EpiUpConv {
    static constexpr bool PERM = true, AFTER_DRAIN = false;
    bf16_t* ACT; const float* ssq; const float* cw; const float* cb;
    __device__ __forceinline__ void operator()(const f32x4 (&acc)[2][2][4][2], const Unit& u, int wr, int wc, int fr, int fq) const {
        const int g0 = 252 * u.pm - 2 + 126 * wr + fr;
        float rs[8];
#pragma unroll
        for (int q = 0; q < 8; ++q) { int r = g0 + 16 * q; r = r < 0 ? 0 : (r > SEQ - 1 ? SEQ - 1 : r); rs[q] = rstd_of(ssq, r); }
#pragma unroll
        for (int n = 0; n < 2; ++n) {
            const int col = 128 * u.pn + 32 * wc + 8 * fq + 4 * n;
            const f32x4 wg0 = *(const f32x4*)(cw + col), wg1 = *(const f32x4*)(cw + 5632 + col), wg2 = *(const f32x4*)(cw + 2 * 5632 + col), bg = *(const f32x4*)(cb + col);
            const f32x4 wv0 = *(const f32x4*)(cw + 2816 + col), wv1 = *(const f32x4*)(cw + 5632 + 2816 + col), wv2 = *(const f32x4*)(cw + 2 * 5632 + 2816 + col), bv = *(const f32x4*)(cb + 2816 + col);
            f32x4 pg = (f32x4){0.f, 0.f, 0.f, 0.f}, pv = (f32x4){0.f, 0.f, 0.f, 0.f};
#pragma unroll
            for (int q = 0; q < 8; ++q) {
                const f32x4 ug = acc[q >> 2][0][q & 3][n] * rs[q], uv = acc[q >> 2][1][q & 3][n] * rs[q];
                f32x4 res;
#pragma unroll
                for (int j = 0; j < 4; ++j) {
                    const float ga1 = dpp_ror1(ug[j]), gb1 = dpp_ror1(pg[j]), ga2 = dpp_ror2(ug[j]), gb2 = dpp_ror2(pg[j]);
                    const float va1 = dpp_ror1(uv[j]), vb1 = dpp_ror1(pv[j]), va2 = dpp_ror2(uv[j]), vb2 = dpp_ror2(pv[j]);
                    const float g1 = fr >= 1 ? ga1 : gb1, g2 = fr >= 2 ? ga2 : gb2, v1 = fr >= 1 ? va1 : vb1, v2 = fr >= 2 ? va2 : vb2;
                    const float cgv = bg[j] + wg0[j] * g2 + wg1[j] * g1 + wg2[j] * ug[j];
                    const float cvv = bv[j] + wv0[j] * v2 + wv1[j] * v1 + wv2[j] * uv[j];
                    res[j] = cgv * __builtin_amdgcn_rcpf(1.0f + __builtin_amdgcn_exp2f(-1.44269504f * cgv)) * cvv;
                }
                pg = ug; pv = uv;
                const int row = g0 + 16 * q;
                if ((q > 0 || fr >= 2) && row < SEQ) store4(ACT + (size_t)row * 2816 + col, res);
            }
        }
    }
};
template <class Epi, class Sched, bool ALIGN_EPI = false, bool SP2 = false>
__device__ __forceinline__ void gemm_phase(PG8_LAS unsigned char* lds, const Gemm g, const Sched& S, const Epi& E) {
    int tid_ = threadIdx.x; asm volatile("" : "+v"(tid_)); const int tid = tid_, wid = __builtin_amdgcn_readfirstlane(tid >> 6), lane = tid & 63, wr = wid >> 2, wc = wid & 3, fr = lane & 15, fq = lane >> 4;
    const int K = g.K, nt = K / BK;
    unsigned voffA[2], voffB[2];
#pragma unroll
    for (int i = 0; i < 2; ++i) { int R, C; stage_rc(tid * 16 + i * 8192, R, C); const int Rb = Epi::PERM ? ((R & ~31) + perm32(R & 31)) : R;
        voffA[i] = (unsigned)(((R >= 64 ? g.a_w1 : 0) + (R & 63)) * K + C) * 2u; voffB[i] = (unsigned)(Rb * K + C) * 2u; }
    const size_t kstep = (size_t)(BK * 2);
    const size_t hstep = (size_t)HALF * K * 2;
    const size_t tstep = 2 * hstep; const size_t hstepA = (size_t)g.a_h * K * 2, tstepA = (size_t)g.a_t * K * 2;
    const unsigned ldsw = (unsigned)wid * 1024u;
    const int aoff = lds_byte(wr * 64 + fr, fq * 8), boff = lds_byte(wc * 32 + fr, fq * 8);
#define PG8_SA(b, h) (((b) * 2 + (h)) * HTB)
#define PG8_SB(b, h) ((4 + (b) * 2 + (h)) * HTB)
#define PG8_STAGE(bufoff, gbase, voff) do { _Pragma("unroll") for (int _i = 0; _i < 2; ++_i) \
        __builtin_amdgcn_global_load_lds((const unsigned*)((const char*)(gbase) + (voff)[_i]), (PG8_LAS unsigned*)(lds + (bufoff) + ldsw + _i * 8192), 16, 0, 0); } while (0)
#define PG8_LDA(dst, b, h) do { _Pragma("unroll") for (int m = 0; m < 4; ++m) _Pragma("unroll") for (int k = 0; k < 2; ++k) dst[m][k] = *(const PG8_LAS bf16x8*)(lds + PG8_SA(b, h) + aoff + m * 2048 + k * 1024); } while (0)
#define PG8_LDB(dst, b, h) do { _Pragma("unroll") for (int n = 0; n < 2; ++n) _Pragma("unroll") for (int k = 0; k < 2; ++k) dst[n][k] = *(const PG8_LAS bf16x8*)(lds + PG8_SB(b, h) + boff + n * 2048 + k * 1024); } while (0)
#define PG8_MMA(ai, bj, At, Bt) do { __builtin_amdgcn_s_setprio(1); _Pragma("unroll") for (int m = 0; m < 4; ++m) _Pragma("unroll") for (int n = 0; n < 2; ++n) _Pragma("unroll") for (int k = 0; k < 2; ++k) \
        acc[ai][bj][m][n] = __builtin_amdgcn_mfma_f32_16x16x32_bf16(Bt[n][k], At[m][k], acc[ai][bj][m][n], 0, 0, 0); __builtin_amdgcn_s_setprio(0); } while (0)
#define PG8_WAIT_V(n) asm volatile("s_waitcnt vmcnt(" #n ")" ::: "memory")
#define PG8_WAIT_L(n) asm volatile("s_waitcnt lgkmcnt(" #n ")" ::: "memory")
#define PG8_BAR __builtin_amdgcn_s_barrier()
#define PG8_SCHED __builtin_amdgcn_sched_barrier(0)
    Unit cur, nxt; int ui = 0;
    if (!S.next(0, cur)) return;
    f32x4 acc[2][2][4][2];
#pragma unroll
    for (int a = 0; a < 2; ++a)
#pragma unroll
        for (int b = 0; b < 2; ++b)
#pragma unroll
            for (int m = 0; m < 4; ++m)
#pragma unroll
                for (int n = 0; n < 2; ++n) acc[a][b][m][n] = (f32x4){0.f, 0.f, 0.f, 0.f};
    bf16x8 At[4][2], B0[2][2], B1[2][2];
    const char* cA = (const char*)g.A + (size_t)cur.pm * tstepA; const char* cB = (const char*)g.Bt + (size_t)cur.pn * tstep;
    S.a_ready(cur);
    if constexpr (SP2) {
        PG8_STAGE(PG8_SB(0, 0), cB, voffB); PG8_STAGE(PG8_SB(0, 1), cB + hstep, voffB); PG8_STAGE(PG8_SA(0, 0), cA, voffA); PG8_STAGE(PG8_SA(0, 1), cA + hstepA, voffA);
        if (wr == 1) PG8_BAR;
        PG8_WAIT_V(2); PG8_BAR;
        PG8_STAGE(PG8_SB(1, 0), cB + kstep, voffB); PG8_STAGE(PG8_SA(1, 0), cA + kstep, voffA); PG8_STAGE(PG8_SB(1, 1), cB + hstep + kstep, voffB);
        PG8_WAIT_V(6); PG8_BAR;
    } else {
        PG8_STAGE(PG8_SB(0, 0), cB, voffB); PG8_STAGE(PG8_SA(0, 0), cA, voffA); PG8_STAGE(PG8_SB(0, 1), cB + hstep, voffB); PG8_STAGE(PG8_SA(0, 1), cA + hstepA, voffA);
        if (wr == 1) PG8_BAR;
        PG8_WAIT_V(4); PG8_BAR;
        PG8_STAGE(PG8_SB(1, 0), cB + kstep, voffB); PG8_STAGE(PG8_SA(1, 0), cA + kstep, voffA); PG8_STAGE(PG8_SB(1, 1), cB + hstep + kstep, voffB);
        PG8_WAIT_V(6); PG8_BAR;
    }
    for (;;) {
        const bool has_next = S.next(ui + 1, nxt);
        const char* nA = has_next ? (const char*)g.A + (size_t)nxt.pm * tstepA : cA; const char* nB = has_next ? (const char*)g.Bt + (size_t)nxt.pn * tstep : cB;
        for (int t = 0; t < nt; t += 2) {
            const bool last = (t == nt - 2);
            const char* a1 = cA + (size_t)(t + 1) * kstep;
            const char* a2 = last ? nA : cA + (size_t)(t + 2) * kstep; const char* b2 = last ? nB : cB + (size_t)(t + 2) * kstep;
            const char* a3 = a2 + kstep; const char* b3 = b2 + kstep;
            if (last && has_next) S.a_ready(nxt);
            if constexpr (SP2) {
            PG8_LDB(B0, 0, 0); PG8_LDB(B1, 0, 1); PG8_SCHED; PG8_LDA(At, 0, 0); PG8_STAGE(PG8_SA(1, 1), a1 + hstepA, voffA);
            PG8_WAIT_V(8); PG8_WAIT_L(0); PG8_BAR; PG8_MMA(0, 0, At, B0); PG8_MMA(0, 1, At, B1); PG8_BAR; PG8_SCHED;
            PG8_LDA(At, 0, 1); PG8_STAGE(PG8_SB(0, 0), b2, voffB); PG8_STAGE(PG8_SB(0, 1), b2 + hstep, voffB); PG8_STAGE(PG8_SA(0, 0), a2, voffA);
            PG8_WAIT_V(8); PG8_WAIT_L(0); PG8_BAR; PG8_MMA(1, 0, At, B0); PG8_MMA(1, 1, At, B1); PG8_BAR; PG8_SCHED;
            PG8_LDB(B0, 1, 0); PG8_LDB(B1, 1, 1); PG8_SCHED; PG8_LDA(At, 1, 0); PG8_STAGE(PG8_SA(0, 1), a2 + hstepA, voffA);
            PG8_WAIT_V(8); PG8_WAIT_L(0); PG8_BAR; PG8_MMA(0, 0, At, B0); PG8_MMA(0, 1, At, B1); PG8_BAR; PG8_SCHED;
            PG8_LDA(At, 1, 1); PG8_STAGE(PG8_SB(1, 0), b3, voffB); PG8_STAGE(PG8_SB(1, 1), b3 + hstep, voffB); PG8_STAGE(PG8_SA(1, 0), a3, voffA);
            PG8_WAIT_V(8); PG8_WAIT_L(0); PG8_BAR; PG8_MMA(1, 0, At, B0); PG8_MMA(1, 1, At, B1); PG8_BAR; PG8_SCHED;
            } else {
            PG8_LDB(B0, 0, 0); PG8_SCHED; PG8_LDA(At, 0, 0); PG8_STAGE(PG8_SA(1, 1), a1 + hstepA, voffA);
            PG8_WAIT_L(8); PG8_BAR; PG8_WAIT_L(0); PG8_MMA(0, 0, At, B0); PG8_BAR; PG8_SCHED;
            PG8_LDB(B1, 0, 1); PG8_STAGE(PG8_SB(0, 0), b2, voffB);
            PG8_BAR; PG8_WAIT_L(0); PG8_MMA(0, 1, At, B1); PG8_BAR;
            PG8_LDA(At, 0, 1); PG8_STAGE(PG8_SA(0, 0), a2, voffA);
            PG8_BAR; PG8_WAIT_L(0); PG8_MMA(1, 0, At, B0); PG8_BAR; PG8_SCHED;
            PG8_STAGE(PG8_SB(0, 1), b2 + hstep, voffB);
            PG8_WAIT_V(6); PG8_BAR; PG8_MMA(1, 1, At, B1); PG8_BAR;
            PG8_LDB(B0, 1, 0); PG8_SCHED; PG8_LDA(At, 1, 0); PG8_STAGE(PG8_SA(0, 1), a2 + hstepA, voffA);
            PG8_WAIT_L(8); PG8_BAR; PG8_WAIT_L(0); PG8_MMA(0, 0, At, B0); PG8_BAR; PG8_SCHED;
            PG8_LDB(B1, 1, 1); PG8_STAGE(PG8_SB(1, 0), b3, voffB);
            PG8_BAR; PG8_WAIT_L(0); PG8_MMA(0, 1, At, B1); PG8_BAR;
            PG8_LDA(At, 1, 1); PG8_STAGE(PG8_SA(1, 0), a3, voffA);
            PG8_BAR; PG8_WAIT_L(0); PG8_MMA(1, 0, At, B0); PG8_BAR; PG8_SCHED;
            PG8_STAGE(PG8_SB(1, 1), b3 + hstep, voffB);
            PG8_WAIT_V(6); PG8_BAR; PG8_MMA(1, 1, At, B1); PG8_BAR;
            }
        }
        if constexpr (ALIGN_EPI) { if (wr == 0) PG8_BAR; }
        if constexpr (!Epi::AFTER_DRAIN) { E(acc, cur, wr, wc, fr, fq); S.done(cur); }
        if (!has_next) break;
#pragma unroll
        for (int a = 0; a < 2; ++a)
#pragma unroll
            for (int b = 0; b < 2; ++b)
#pragma unroll
                for (int m = 0; m < 4; ++m)
#pragma unroll
                    for (int n = 0; n < 2; ++n) acc[a][b][m][n] = (f32x4){0.f, 0.f, 0.f, 0.f};
        cur = nxt; cA = nA; cB = nB; ++ui;
        if constexpr (ALIGN_EPI) { if (wr == 1) PG8_BAR; }
    }
    PG8_WAIT_V(0);
    if constexpr (!ALIGN_EPI) { if (wr == 0) PG8_BAR; }
    PG8_BAR;
    if constexpr (Epi::AFTER_DRAIN) { E.fused(acc, cur, wr, wc, fr, fq, lds, wid, lane); S.done(cur); }
#undef PG8_SA
#undef PG8_SB
#undef PG8_STAGE
#undef PG8_LDA
#undef PG8_LDB
#undef PG8_MMA
#undef PG8_WAIT_V
#undef PG8_WAIT_L
#undef PG8_BAR
#undef PG8_SCHED
}
}
namespace att {
#define LAS __attribute__((address_space(3)))
using pg8::bf16_t; using pg8::bf16x8; using pg8::f32x4; using pg8::u32x4; using pg8::SEQ;
typedef float f32x16 __attribute__((ext_vector_type(16)));
constexpr int KB_BYTES = 8192, VT_STRIDE = 144, VT_BYTES = 64 * VT_STRIDE, BUF_BYTES = KB_BYTES + VT_BYTES + 256;
constexpr int VOTE_OFF = 3 * BUF_BYTES, KM_OFF = 57344;
constexpr float LOG2E = 1.4426950408889634f, C2 = 0.125f * 1.4426950408889634f;
enum { M_SB = 0, M_MOBA = 1, M_FOX = 2, M_XA = 3 };
__device__ __forceinline__ bf16x8 pack8(const f32x16& p, int b) {
    u32x4 w; w.x = pg8::cvt_pk_bf16(p[b + 0], p[b + 1]); w.y = pg8::cvt_pk_bf16(p[b + 2], p[b + 3]); w.z = pg8::cvt_pk_bf16(p[b + 4], p[b + 5]); w.w = pg8::cvt_pk_bf16(p[b + 6], p[b + 7]);
    return __builtin_bit_cast(bf16x8, w);
}
__device__ __forceinline__ float bf2f(short s) { return __uint_as_float(((unsigned)(unsigned short)s) << 16); }

struct AttnArgs { const bf16_t* Q; int ldq; const bf16_t* K; const bf16_t* V; int ldkv; bf16_t* O; int ldo; const float* cf; float kmax2; const float* kpart; int* sel; float* lse; };

template <int MODE>
__device__ __forceinline__ void attn_unit(LAS unsigned char* lds, const AttnArgs& A, int qb) {
    int tid_ = threadIdx.x; asm volatile("" : "+v"(tid_)); const int tid = tid_, lane = tid & 63, wid = __builtin_amdgcn_readfirstlane(tid >> 6), r32 = lane & 31, hi = lane >> 5;
    const int q0 = qb * 256, w0 = q0 + wid * 32, row = w0 + r32;
    bf16x8 qr[4];
#pragma unroll
    for (int d0 = 0; d0 < 4; ++d0) qr[d0] = *(const bf16x8*)(A.Q + (size_t)row * A.ldq + d0 * 16 + hi * 8);
    int i1 = -1, i2 = -1, i3 = -1; unsigned long long wmask = 0ull;
    if (MODE == M_MOBA) {
        const int own = qb;
        LAS float* km = (LAS float*)(lds + KM_OFF);
        {
            float kp_[8][4];
#pragma unroll
            for (int k = 0; k < 8; ++k) { const int idx = tid + 512 * k; const bool ok = idx < own * 64; const float* p = A.kpart + (size_t)((ok ? idx : 0) >> 6) * 256 + (idx & 63);
                kp_[k][0] = p[0]; kp_[k][1] = p[64]; kp_[k][2] = p[128]; kp_[k][3] = p[192]; }
#pragma unroll
            for (int k = 0; k < 8; ++k) { const int idx = tid + 512 * k; if (idx < own * 64) km[idx] = ((kp_[k][0] + kp_[k][1]) + (kp_[k][2] + kp_[k][3])) * (1.0f / 256.0f); }
        }
        __syncthreads();
        float qf[32];
#pragma unroll
        for (int d0 = 0; d0 < 4; ++d0)
#pragma unroll
            for (int e = 0; e < 8; ++e) qf[d0 * 8 + e] = bf2f(qr[d0][e]);
        float v1 = -INFINITY, v2 = -INFINITY, v3 = -INFINITY;
#pragma unroll 4
        for (int j = 0; j < own; ++j) {
            float g = 0.f;
#pragma unroll
            for (int d0 = 0; d0 < 4; ++d0) { const f32x4 a = *(const LAS f32x4*)(km + j * 64 + d0 * 16 + hi * 8), b = *(const LAS f32x4*)(km + j * 64 + d0 * 16 + hi * 8 + 4);
                g += (qf[d0 * 8 + 0] * a[0] + qf[d0 * 8 + 1] * a[1]) + (qf[d0 * 8 + 2] * a[2] + qf[d0 * 8 + 3] * a[3]) + (qf[d0 * 8 + 4] * b[0] + qf[d0 * 8 + 5] * b[1]) + (qf[d0 * 8 + 6] * b[2] + qf[d0 * 8 + 7] * b[3]); }
            const float go = __shfl_xor(g, 32); g = hi ? (go + g) : (g + go);
            if (g > v1) { v3 = v2; i3 = i2; v2 = v1; i2 = i1; v1 = g; i1 = j; } else if (g > v2) { v3 = v2; i3 = i2; v2 = g; i2 = j; } else if (g > v3) { v3 = g; i3 = j; }
        }
        if (hi == 0) { typedef int i32x4 __attribute__((ext_vector_type(4))); *(i32x4*)(A.sel + (size_t)row * 4) = (i32x4){i1, i2, i3, 0}; }
    }
    float qb2 = 0.f, cq2 = 0.f;
    if (MODE == M_FOX) {
        float s = 0.f;
#pragma unroll
        for (int d0 = 0; d0 < 4; ++d0)
#pragma unroll
            for (int e = 0; e < 8; ++e) { const float x = bf2f(qr[d0][e]); s += x * x; }
        s += __shfl_xor(s, 32);
        qb2 = sqrtf(s * A.kmax2) * C2 * 1.01f;
        cq2 = A.cf[row] * LOG2E;
    }
    const int NT = (MODE == M_XA || MODE == M_MOBA) ? 4 : (q0 / 64 + 4);
    f32x16 o0, o1;
#pragma unroll
    for (int r = 0; r < 16; ++r) { o0[r] = 0.f; o1[r] = 0.f; }
    float m_run = -1e30f, l_run = 0.f, T = 0.f;
    u32x4 k1 = (u32x4){0u, 0u, 0u, 0u}, v1 = k1, k2 = k1, v2 = k1, k3 = k1, v3 = k1; float c1 = 0.f, c2 = 0.f, c3 = 0.f;
#define KEY0(i) ((MODE == M_XA) ? 64 * (i) : (MODE == M_MOBA) ? ((i) < 4 ? q0 + 64 * (i) : 256 * (((i) - 4) >> 2) + 64 * (((i) - 4) & 3)) : (q0 + 192 - 64 * (i)))
#define LOADT(i, kreg, vreg, creg) do { const int k0_ = KEY0(i); kreg = *(const u32x4*)(A.K + (size_t)(k0_ + lane) * A.ldkv + wid * 8); vreg = *(const u32x4*)(A.V + (size_t)(k0_ + lane) * A.ldkv + wid * 8); \
        if (MODE == M_FOX) { if (tid < 64) creg = A.cf[k0_ + tid] * LOG2E; } } while (0)
#define STORET(b, kreg, vreg, creg) do { LAS unsigned char* bb_ = lds + (b) * BUF_BYTES; *(LAS u32x4*)(bb_ + wid * 1024 + lane * 16) = kreg; \
        LAS unsigned short* vt_ = (LAS unsigned short*)(bb_ + KB_BYTES + (8 * wid) * VT_STRIDE + lane * 2); \
        vt_[0 * 72] = (unsigned short)(vreg.x & 0xffffu); vt_[1 * 72] = (unsigned short)(vreg.x >> 16); vt_[2 * 72] = (unsigned short)(vreg.y & 0xffffu); vt_[3 * 72] = (unsigned short)(vreg.y >> 16); \
        vt_[4 * 72] = (unsigned short)(vreg.z & 0xffffu); vt_[5 * 72] = (unsigned short)(vreg.z >> 16); vt_[6 * 72] = (unsigned short)(vreg.w & 0xffffu); vt_[7 * 72] = (unsigned short)(vreg.w >> 16); \
        if (MODE == M_FOX) { if (tid < 64) ((LAS float*)(bb_ + KB_BYTES + VT_BYTES))[tid] = creg; } } while (0)
    LOADT(0, k1, v1, c1); if (NT > 1) LOADT(1, k2, v2, c2); if (NT > 2) LOADT(2, k3, v3, c3);
    STORET(0, k1, v1, c1);
    __syncthreads();
    const int kperm = (r32 & ~15) | (r32 & 3) | ((r32 & 4) << 1) | ((r32 & 8) >> 1);
    bool prev_active = false; int prevbuf = 0; bf16x8 pkP0 = (bf16x8){0, 0, 0, 0, 0, 0, 0, 0}, pkP1 = pkP0, pkP2 = pkP0, pkP3 = pkP0;
    for (int i0 = 0; i0 < NT; i0 += 3) {
        { const int i = i0 + 0; if (i >= NT) break;
        const int key0 = KEY0(i);
        if (i + 3 < NT) LOADT(i + 3, k1, v1, c1);
        LAS unsigned char* buf = lds + 0 * BUF_BYTES;
        bool active;
        if (MODE == M_XA) active = true;
        else if (MODE == M_MOBA) active = (i < 4) ? (key0 <= w0 + 31) : (((wmask >> ((i - 4) >> 2)) & 1ull) != 0ull);
        else active = key0 <= w0 + 31;
        if (active) {
            f32x16 p0, p1;
#pragma unroll
            for (int r = 0; r < 16; ++r) { p0[r] = 0.f; p1[r] = 0.f; }
            LAS unsigned char* kb = buf + kperm * 16 + hi * 1024;
#pragma unroll
            for (int d0 = 0; d0 < 4; ++d0) {
                const bf16x8 kf0 = *(const LAS bf16x8*)(kb + d0 * 2048), kf1 = *(const LAS bf16x8*)(kb + d0 * 2048 + 512);
                p0 = __builtin_amdgcn_mfma_f32_32x32x16_bf16(kf0, qr[d0], p0, 0, 0, 0);
                p1 = __builtin_amdgcn_mfma_f32_32x32x16_bf16(kf1, qr[d0], p1, 0, 0, 0);
            }
        if (prev_active) {
            const LAS unsigned char* vb = lds + prevbuf + KB_BYTES + r32 * VT_STRIDE + hi * 16;
#define PVS(s, pk) do { const bf16x8 a0_ = *(const LAS bf16x8*)(vb + (s) * 32), a1_ = *(const LAS bf16x8*)(vb + 32 * VT_STRIDE + (s) * 32); \
            o0 = __builtin_amdgcn_mfma_f32_32x32x16_bf16(a0_, pk, o0, 0, 0, 0); o1 = __builtin_amdgcn_mfma_f32_32x32x16_bf16(a1_, pk, o1, 0, 0, 0); } while (0)
            PVS(0, pkP0); PVS(1, pkP1); PVS(2, pkP2); PVS(3, pkP3);
#undef PVS
        }
            const int kl = key0 + 8 * hi;
            if (MODE == M_SB) {
                const bool nm = key0 + 63 >= w0;
                f32x16 L0, L1; float gt[4];
#pragma unroll
                for (int g = 0; g < 4; ++g) gt[g] = 0.f;
#pragma unroll
                for (int r = 0; r < 16; ++r) {
                    { const float z2 = p0[r] * C2; p0[r] = z2; float l1 = -(fmaxf(z2, 0.f) + __builtin_amdgcn_logf(1.0f + __builtin_amdgcn_exp2f(-fabsf(z2))));
                      if (nm && !(kl + 16 * (r >> 3) + (r & 7) < row)) l1 = 0.f; L0[r] = l1; gt[r >> 3] += l1; }
                    { const float z2 = p1[r] * C2; p1[r] = z2; float l1 = -(fmaxf(z2, 0.f) + __builtin_amdgcn_logf(1.0f + __builtin_amdgcn_exp2f(-fabsf(z2))));
                      if (nm && !(kl + 32 + 16 * (r >> 3) + (r & 7) < row)) l1 = 0.f; L1[r] = l1; gt[2 + (r >> 3)] += l1; }
                }
                float pt[4], after[4]; float run = 0.f;
#pragma unroll
                for (int g = 0; g < 4; ++g) pt[g] = __shfl_xor(gt[g], 32);
#pragma unroll
                for (int g = 3; g >= 0; --g) { after[g] = run + (hi ? 0.f : pt[g]); run += gt[g] + pt[g]; }
#pragma unroll
                for (int g8 = 1; g8 >= 0; --g8) {
                    float s0 = T + after[g8], s1 = T + after[2 + g8];
#pragma unroll
                    for (int e = 7; e >= 0; --e) { const int r = 8 * g8 + e;
                        { const bool valid = !nm || (kl + 16 * g8 + e < row); const float a = valid ? __builtin_amdgcn_exp2f(p0[r] + L0[r] + s0) : 0.f; s0 += L0[r]; p0[r] = a; }
                        { const bool valid = !nm || (kl + 32 + 16 * g8 + e < row); const float a = valid ? __builtin_amdgcn_exp2f(p1[r] + L1[r] + s1) : 0.f; s1 += L1[r]; p1[r] = a; } }
                }
                T += run;
            } else {
                const bool nm = (MODE == M_FOX) ? (key0 + 63 > w0) : ((MODE == M_MOBA) ? (i < 4 && key0 + 63 > w0) : false);
                bool rowsel = true;
                if (MODE == M_MOBA) { if (i >= 4) { const int j = (i - 4) >> 2; rowsel = (i1 == j) | (i2 == j) | (i3 == j); } }
                const LAS float* cl = (const LAS float*)(buf + KB_BYTES + VT_BYTES) + 8 * hi;
                float corr;
                if (nm) {
                    float mx = -INFINITY;
#pragma unroll
                    for (int r = 0; r < 16; ++r) {
                        float t0 = p0[r] * C2, t1 = p1[r] * C2;
                        if (MODE == M_FOX) { t0 += cq2 - cl[16 * (r >> 3) + (r & 7)]; t1 += cq2 - cl[32 + 16 * (r >> 3) + (r & 7)]; }
                        const int k_0 = kl + 16 * (r >> 3) + (r & 7);
                        t0 = (k_0 <= row) ? t0 : -INFINITY; t1 = (k_0 + 32 <= row) ? t1 : -INFINITY;
                        p0[r] = t0; p1[r] = t1; mx = fmaxf(mx, fmaxf(t0, t1));
                    }
                    mx = fmaxf(mx, __shfl_xor(mx, 32));
                    float m_new;
                    if (MODE == M_FOX) { m_run = fmaxf(m_run, mx); m_new = fminf(qb2, 48.0f); corr = 1.0f; }
                    else { m_new = fmaxf(m_run, mx); corr = __builtin_amdgcn_exp2f(m_run - m_new); m_run = m_new; }
                    float sum = 0.f;
#pragma unroll
                    for (int r = 0; r < 16; ++r) { const float e0 = __builtin_amdgcn_exp2f(p0[r] - m_new), e1 = __builtin_amdgcn_exp2f(p1[r] - m_new); sum += e0 + e1; p0[r] = e0; p1[r] = e1; }
                    l_run = l_run * corr + sum;
                } else {
                    if (MODE == M_FOX) {
                        typedef float f32x2 __attribute__((ext_vector_type(2)));
                        const float base = cq2 - fminf(qb2, 48.0f); const f32x2 basev = (f32x2){base, base}, c2v = (f32x2){C2, C2};
                        f32x2 sa = (f32x2){0.f, 0.f}, sb = (f32x2){0.f, 0.f};
#pragma unroll
                        for (int r = 0; r < 16; r += 2) {
                            const f32x2 ca = *(const LAS f32x2*)(cl + 16 * (r >> 3) + (r & 7)), cb = *(const LAS f32x2*)(cl + 32 + 16 * (r >> 3) + (r & 7));
                            const f32x2 ta = (f32x2){p0[r], p0[r + 1]} * c2v + (basev - ca), tb = (f32x2){p1[r], p1[r + 1]} * c2v + (basev - cb);
                            const f32x2 ea = (f32x2){__builtin_amdgcn_exp2f(ta.x), __builtin_amdgcn_exp2f(ta.y)}, eb = (f32x2){__builtin_amdgcn_exp2f(tb.x), __builtin_amdgcn_exp2f(tb.y)};
                            sa += ea; sb += eb; p0[r] = ea.x; p0[r + 1] = ea.y; p1[r] = eb.x; p1[r + 1] = eb.y;
                        }
                        corr = 1.0f; l_run += (sa.x + sa.y) + (sb.x + sb.y);
                    } else {
                    float mx = -INFINITY;
#pragma unroll
                    for (int r = 0; r < 16; ++r) mx = fmaxf(mx, fmaxf(p0[r], p1[r]));
                    mx *= C2;
                    if (MODE == M_MOBA) mx = rowsel ? mx : -INFINITY;
                    mx = fmaxf(mx, __shfl_xor(mx, 32));
                    const float m_new = fmaxf(m_run, mx); corr = __builtin_amdgcn_exp2f(m_run - m_new); m_run = m_new;
                    const float off = (MODE == M_MOBA && !rowsel) ? -INFINITY : -m_new;
                    float s0 = 0.f, s1 = 0.f;
#pragma unroll
                    for (int r = 0; r < 16; ++r) { const float e0 = __builtin_amdgcn_exp2f(fmaf(p0[r], C2, off)), e1 = __builtin_amdgcn_exp2f(fmaf(p1[r], C2, off)); s0 += e0; s1 += e1; p0[r] = e0; p1[r] = e1; }
                    l_run = l_run * corr + (s0 + s1);
                    }
                }
                if (__any(corr != 1.0f)) {
#pragma unroll
                    for (int r = 0; r < 16; ++r) { o0[r] *= corr; o1[r] *= corr; }
                }
            }
            pkP0 = pack8(p0, 0); pkP1 = pack8(p0, 8); pkP2 = pack8(p1, 0); pkP3 = pack8(p1, 8);
        } else {
        if (prev_active) {
            const LAS unsigned char* vb = lds + prevbuf + KB_BYTES + r32 * VT_STRIDE + hi * 16;
#define PVS(s, pk) do { const bf16x8 a0_ = *(const LAS bf16x8*)(vb + (s) * 32), a1_ = *(const LAS bf16x8*)(vb + 32 * VT_STRIDE + (s) * 32); \
            o0 = __builtin_amdgcn_mfma_f32_32x32x16_bf16(a0_, pk, o0, 0, 0, 0); o1 = __builtin_amdgcn_mfma_f32_32x32x16_bf16(a1_, pk, o1, 0, 0, 0); } while (0)
            PVS(0, pkP0); PVS(1, pkP1); PVS(2, pkP2); PVS(3, pkP3);
#undef PVS
        }
        }
        prev_active = active; prevbuf = 0 * BUF_BYTES;
        if (i + 1 < NT) STORET(1, k2, v2, c2);
        if (MODE == M_SB || MODE == M_FOX) {
            bool vote;
            if (MODE == M_SB) vote = __all(T < -151.0f) != 0;
            else { const float cn = (key0 > 0) ? A.cf[key0 - 1] * LOG2E : 0.f; vote = __all(qb2 + cq2 - cn < m_run - 151.0f) != 0; }
            if (lane == 0) ((LAS unsigned*)(lds + VOTE_OFF))[(i & 1) * 8 + wid] = (active && vote) ? 1u : 0u;
        }
        __syncthreads();
        if (MODE == M_SB || MODE == M_FOX) {
            const LAS unsigned* vv = (const LAS unsigned*)(lds + VOTE_OFF) + (i & 1) * 8;
            const unsigned all8 = (vv[0] & vv[1]) & (vv[2] & vv[3]) & (vv[4] & vv[5]) & (vv[6] & vv[7]);
            if (all8) break;
        }
        }
        { const int i = i0 + 1; if (i >= NT) break;
        const int key0 = KEY0(i);
        if (i + 3 < NT) LOADT(i + 3, k2, v2, c2);
        LAS unsigned char* buf = lds + 1 * BUF_BYTES;
        bool active;
        if (MODE == M_XA) active = true;
        else if (MODE == M_MOBA) active = (i < 4) ? (key0 <= w0 + 31) : (((wmask >> ((i - 4) >> 2)) & 1ull) != 0ull);
        else active = key0 <= w0 + 31;
        if (active) {
            f32x16 p0, p1;
#pragma unroll
            for (int r = 0; r < 16; ++r) { p0[r] = 0.f; p1[r] = 0.f; }
            LAS unsigned char* kb = buf + kperm * 16 + hi * 1024;
#pragma unroll
            for (int d0 = 0; d0 < 4; ++d0) {
                const bf16x8 kf0 = *(const LAS bf16x8*)(kb + d0 * 2048), kf1 = *(const LAS bf16x8*)(kb + d0 * 2048 + 512);
                p0 = __builtin_amdgcn_mfma_f32_32x32x16_bf16(kf0, qr[d0], p0, 0, 0, 0);
                p1 = __builtin_amdgcn_mfma_f32_32x32x16_bf16(kf1, qr[d0], p1, 0, 0, 0);
            }
        if (prev_active) {
            const LAS unsigned char* vb = lds + prevbuf + KB_BYTES + r32 * VT_STRIDE + hi * 16;
#define PVS(s, pk) do { const bf16x8 a0_ = *(const LAS bf16x8*)(vb + (s) * 32), a1_ = *(const LAS bf16x8*)(vb + 32 * VT_STRIDE + (s) * 32); \
            o0 = __builtin_amdgcn_mfma_f32_32x32x16_bf16(a0_, pk, o0, 0, 0, 0); o1 = __builtin_amdgcn_mfma_f32_32x32x16_bf16(a1_, pk, o1, 0, 0, 0); } while (0)
            PVS(0, pkP0); PVS(1, pkP1); PVS(2, pkP2); PVS(3, pkP3);
#undef PVS
        }
            const int kl = key0 + 8 * hi;
            if (MODE == M_SB) {
                const bool nm = key0 + 63 >= w0;
                f32x16 L0, L1; float gt[4];
#pragma unroll
                for (int g = 0; g < 4; ++g) gt[g] = 0.f;
#pragma unroll
                for (int r = 0; r < 16; ++r) {
                    { const float z2 = p0[r] * C2; p0[r] = z2; float l1 = -(fmaxf(z2, 0.f) + __builtin_amdgcn_logf(1.0f + __builtin_amdgcn_exp2f(-fabsf(z2))));
                      if (nm && !(kl + 16 * (r >> 3) + (r & 7) < row)) l1 = 0.f; L0[r] = l1; gt[r >> 3] += l1; }
                    { const float z2 = p1[r] * C2; p1[r] = z2; float l1 = -(fmaxf(z2, 0.f) + __builtin_amdgcn_logf(1.0f + __builtin_amdgcn_exp2f(-fabsf(z2))));
                      if (nm && !(kl + 32 + 16 * (r >> 3) + (r & 7) < row)) l1 = 0.f; L1[r] = l1; gt[2 + (r >> 3)] += l1; }
                }
                float pt[4], after[4]; float run = 0.f;
#pragma unroll
                for (int g = 0; g < 4; ++g) pt[g] = __shfl_xor(gt[g], 32);
#pragma unroll
                for (int g = 3; g >= 0; --g) { after[g] = run + (hi ? 0.f : pt[g]); run += gt[g] + pt[g]; }
#pragma unroll
                for (int g8 = 1; g8 >= 0; --g8) {
                    float s0 = T + after[g8], s1 = T + after[2 + g8];
#pragma unroll
                    for (int e = 7; e >= 0; --e) { const int r = 8 * g8 + e;
                        { const bool valid = !nm || (kl + 16 * g8 + e < row); const float a = valid ? __builtin_amdgcn_exp2f(p0[r] + L0[r] + s0) : 0.f; s0 += L0[r]; p0[r] = a; }
                        { const bool valid = !nm || (kl + 32 + 16 * g8 + e < row); const float a = valid ? __builtin_amdgcn_exp2f(p1[r] + L1[r] + s1) : 0.f; s1 += L1[r]; p1[r] = a; } }
                }
                T += run;
            } else {
                const bool nm = (MODE == M_FOX) ? (key0 + 63 > w0) : ((MODE == M_MOBA) ? (i < 4 && key0 + 63 > w0) : false);
                bool rowsel = true;
                if (MODE == M_MOBA) { if (i >= 4) { const int j = (i - 4) >> 2; rowsel = (i1 == j) | (i2 == j) | (i3 == j); } }
                const LAS float* cl = (const LAS float*)(buf + KB_BYTES + VT_BYTES) + 8 * hi;
                float corr;
                if (nm) {
                    float mx = -INFINITY;
#pragma unroll
                    for (int r = 0; r < 16; ++r) {
                        float t0 = p0[r] * C2, t1 = p1[r] * C2;
                        if (MODE == M_FOX) { t0 += cq2 - cl[16 * (r >> 3) + (r & 7)]; t1 += cq2 - cl[32 + 16 * (r >> 3) + (r & 7)]; }
                        const int k_0 = kl + 16 * (r >> 3) + (r & 7);
                        t0 = (k_0 <= row) ? t0 : -INFINITY; t1 = (k_0 + 32 <= row) ? t1 : -INFINITY;
                        p0[r] = t0; p1[r] = t1; mx = fmaxf(mx, fmaxf(t0, t1));
                    }
                    mx = fmaxf(mx, __shfl_xor(mx, 32));
                    float m_new;
                    if (MODE == M_FOX) { m_run = fmaxf(m_run, mx); m_new = fminf(qb2, 48.0f); corr = 1.0f; }
                    else { m_new = fmaxf(m_run, mx); corr = __builtin_amdgcn_exp2f(m_run - m_new); m_run = m_new; }
                    float sum = 0.f;
#pragma unroll
                    for (int r = 0; r < 16; ++r) { const float e0 = __builtin_amdgcn_exp2f(p0[r] - m_new), e1 = __builtin_amdgcn_exp2f(p1[r] - m_new); sum += e0 + e1; p0[r] = e0; p1[r] = e1; }
                    l_run = l_run * corr + sum;
                } else {
                    if (MODE == M_FOX) {
                        typedef float f32x2 __attribute__((ext_vector_type(2)));
                        const float base = cq2 - fminf(qb2, 48.0f); const f32x2 basev = (f32x2){base, base}, c2v = (f32x2){C2, C2};
                        f32x2 sa = (f32x2){0.f, 0.f}, sb = (f32x2){0.f, 0.f};
#pragma unroll
                        for (int r = 0; r < 16; r += 2) {
                            const f32x2 ca = *(const LAS f32x2*)(cl + 16 * (r >> 3) + (r & 7)), cb = *(const LAS f32x2*)(cl + 32 + 16 * (r >> 3) + (r & 7));
                            const f32x2 ta = (f32x2){p0[r], p0[r + 1]} * c2v + (basev - ca), tb = (f32x2){p1[r], p1[r + 1]} * c2v + (basev - cb);
                            const f32x2 ea = (f32x2){__builtin_amdgcn_exp2f(ta.x), __builtin_amdgcn_exp2f(ta.y)}, eb = (f32x2){__builtin_amdgcn_exp2f(tb.x), __builtin_amdgcn_exp2f(tb.y)};
                            sa += ea; sb += eb; p0[r] = ea.x; p0[r + 1] = ea.y; p1[r] = eb.x; p1[r + 1] = eb.y;
                        }
                        corr = 1.0f; l_run += (sa.x + sa.y) + (sb.x + sb.y);
                    } else {
                    float mx = -INFINITY;
#pragma unroll
                    for (int r = 0; r < 16; ++r) mx = fmaxf(mx, fmaxf(p0[r], p1[r]));
                    mx *= C2;
                    if (MODE == M_MOBA) mx = rowsel ? mx : -INFINITY;
                    mx = fmaxf(mx, __shfl_xor(mx, 32));
                    const float m_new = fmaxf(m_run, mx); corr = __builtin_amdgcn_exp2f(m_run - m_new); m_run = m_new;
                    const float off = (MODE == M_MOBA && !rowsel) ? -INFINITY : -m_new;
                    float s0 = 0.f, s1 = 0.f;
#pragma unroll
                    for (int r = 0; r < 16; ++r) { const float e0 = __builtin_amdgcn_exp2f(fmaf(p0[r], C2, off)), e1 = __builtin_amdgcn_exp2f(fmaf(p1[r], C2, off)); s0 += e0; s1 += e1; p0[r] = e0; p1[r] = e1; }
                    l_run = l_run * corr + (s0 + s1);
                    }
                }
                if (__any(corr != 1.0f)) {
#pragma unroll
                    for (int r = 0; r < 16; ++r) { o0[r] *= corr; o1[r] *= corr; }
                }
            }
            pkP0 = pack8(p0, 0); pkP1 = pack8(p0, 8); pkP2 = pack8(p1, 0); pkP3 = pack8(p1, 8);
        } else {
        if (prev_active) {
            const LAS unsigned char* vb = lds + prevbuf + KB_BYTES + r32 * VT_STRIDE + hi * 16;
#define PVS(s, pk) do { const bf16x8 a0_ = *(const LAS bf16x8*)(vb + (s) * 32), a1_ = *(const LAS bf16x8*)(vb + 32 * VT_STRIDE + (s) * 32); \
            o0 = __builtin_amdgcn_mfma_f32_32x32x16_bf16(a0_, pk, o0, 0, 0, 0); o1 = __builtin_amdgcn_mfma_f32_32x32x16_bf16(a1_, pk, o1, 0, 0, 0); } while (0)
            PVS(0, pkP0); PVS(1, pkP1); PVS(2, pkP2); PVS(3, pkP3);
#undef PVS
        }
        }
        prev_active = active; prevbuf = 1 * BUF_BYTES;
        if (i + 1 < NT) STORET(2, k3, v3, c3);
        if (MODE == M_SB || MODE == M_FOX) {
            bool vote;
            if (MODE == M_SB) vote = __all(T < -151.0f) != 0;
            else { const float cn = (key0 > 0) ? A.cf[key0 - 1] * LOG2E : 0.f; vote = __all(qb2 + cq2 - cn < m_run - 151.0f) != 0; }
            if (lane == 0) ((LAS unsigned*)(lds + VOTE_OFF))[(i & 1) * 8 + wid] = (active && vote) ? 1u : 0u;
        }
        __syncthreads();
        if (MODE == M_SB || MODE == M_FOX) {
            const LAS unsigned* vv = (const LAS unsigned*)(lds + VOTE_OFF) + (i & 1) * 8;
            const unsigned all8 = (vv[0] & vv[1]) & (vv[2] & vv[3]) & (vv[4] & vv[5]) & (vv[6] & vv[7]);
            if (all8) break;
        }
        }
        { const int i = i0 + 2; if (i >= NT) break;
        const int key0 = KEY0(i);
        if (i + 3 < NT) LOADT(i + 3, k3, v3, c3);
        LAS unsigned char* buf = lds + 2 * BUF_BYTES;
        bool active;
        if (MODE == M_XA) active = true;
        else if (MODE == M_MOBA) active = (i < 4) ? (key0 <= w0 + 31) : (((wmask >> ((i - 4) >> 2)) & 1ull) != 0ull);
        else active = key0 <= w0 + 31;
        if (active) {
            f32x16 p0, p1;
#pragma unroll
            for (int r = 0; r < 16; ++r) { p0[r] = 0.f; p1[r] = 0.f; }
            LAS unsigned char* kb = buf + kperm * 16 + hi * 1024;
#pragma unroll
            for (int d0 = 0; d0 < 4; ++d0) {
                const bf16x8 kf0 = *(const LAS bf16x8*)(kb + d0 * 2048), kf1 = *(const LAS bf16x8*)(kb + d0 * 2048 + 512);
                p0 = __builtin_amdgcn_mfma_f32_32x32x16_bf16(kf0, qr[d0], p0, 0, 0, 0);
                p1 = __builtin_amdgcn_mfma_f32_32x32x16_bf16(kf1, qr[d0], p1, 0, 0, 0);
            }
        if (prev_active) {
            const LAS unsigned char* vb = lds + prevbuf + KB_BYTES + r32 * VT_STRIDE + hi * 16;
#define PVS(s, pk) do { const bf16x8 a0_ = *(const LAS bf16x8*)(vb + (s) * 32), a1_ = *(const LAS bf16x8*)(vb + 32 * VT_STRIDE + (s) * 32); \
            o0 = __builtin_amdgcn_mfma_f32_32x32x16_bf16(a0_, pk, o0, 0, 0, 0); o1 = __builtin_amdgcn_mfma_f32_32x32x16_bf16(a1_, pk, o1, 0, 0, 0); } while (0)
            PVS(0, pkP0); PVS(1, pkP1); PVS(2, pkP2); PVS(3, pkP3);
#undef PVS
        }
            const int kl = key0 + 8 * hi;
            if (MODE == M_SB) {
                const bool nm = key0 + 63 >= w0;
                f32x16 L0, L1; float gt[4];
#pragma unroll
                for (int g = 0; g < 4; ++g) gt[g] = 0.f;
#pragma unroll
                for (int r = 0; r < 16; ++r) {
                    { const float z2 = p0[r] * C2; p0[r] = z2; float l1 = -(fmaxf(z2, 0.f) + __builtin_amdgcn_logf(1.0f + __builtin_amdgcn_exp2f(-fabsf(z2))));
                      if (nm && !(kl + 16 * (r >> 3) + (r & 7) < row)) l1 = 0.f; L0[r] = l1; gt[r >> 3] += l1; }
                    { const float z2 = p1[r] * C2; p1[r] = z2; float l1 = -(fmaxf(z2, 0.f) + __builtin_amdgcn_logf(1.0f + __builtin_amdgcn_exp2f(-fabsf(z2))));
                      if (nm && !(kl + 32 + 16 * (r >> 3) + (r & 7) < row)) l1 = 0.f; L1[r] = l1; gt[2 + (r >> 3)] += l1; }
                }
                float pt[4], after[4]; float run = 0.f;
#pragma unroll
                for (int g = 0; g < 4; ++g) pt[g] = __shfl_xor(gt[g], 32);
#pragma unroll
                for (int g = 3; g >= 0; --g) { after[g] = run + (hi ? 0.f : pt[g]); run += gt[g] + pt[g]; }
#pragma unroll
                for (int g8 = 1; g8 >= 0; --g8) {
                    float s0 = T + after[g8], s1 = T + after[2 + g8];
#pragma unroll
                    for (int e = 7; e >= 0; --e) { const int r = 8 * g8 + e;
                        { const bool valid = !nm || (kl + 16 * g8 + e < row); const float a = valid ? __builtin_amdgcn_exp2f(p0[r] + L0[r] + s0) : 0.f; s0 += L0[r]; p0[r] = a; }
                        { const bool valid = !nm || (kl + 32 + 16 * g8 + e < row); const float a = valid ? __builtin_amdgcn_exp2f(p1[r] + L1[r] + s1) : 0.f; s1 += L1[r]; p1[r] = a; } }
                }
                T += run;
            } else {
                const bool nm = (MODE == M_FOX) ? (key0 + 63 > w0) : ((MODE == M_MOBA) ? (i < 4 && key0 + 63 > w0) : false);
                bool rowsel = true;
                if (MODE == M_MOBA) { if (i >= 4) { const int j = (i - 4) >> 2; rowsel = (i1 == j) | (i2 == j) | (i3 == j); } }
                const LAS float* cl = (const LAS float*)(buf + KB_BYTES + VT_BYTES) + 8 * hi;
                float corr;
                if (nm) {
                    float mx = -INFINITY;
#pragma unroll
                    for (int r = 0; r < 16; ++r) {
                        float t0 = p0[r] * C2, t1 = p1[r] * C2;
                        if (MODE == M_FOX) { t0 += cq2 - cl[16 * (r >> 3) + (r & 7)]; t1 += cq2 - cl[32 + 16 * (r >> 3) + (r & 7)]; }
                        const int k_0 = kl + 16 * (r >> 3) + (r & 7);
                        t0 = (k_0 <= row) ? t0 : -INFINITY; t1 = (k_0 + 32 <= row) ? t1 : -INFINITY;
                        p0[r] = t0; p1[r] = t1; mx = fmaxf(mx, fmaxf(t0, t1));
                    }
                    mx = fmaxf(mx, __shfl_xor(mx, 32));
                    float m_new;
                    if (MODE == M_FOX) { m_run = fmaxf(m_run, mx); m_new = fminf(qb2, 48.0f); corr = 1.0f; }
                    else { m_new = fmaxf(m_run, mx); corr = __builtin_amdgcn_exp2f(m_run - m_new); m_run = m_new; }
                    float sum = 0.f;
#pragma unroll
                    for (int r = 0; r < 16; ++r) { const float e0 = __builtin_amdgcn_exp2f(p0[r] - m_new), e1 = __builtin_amdgcn_exp2f(p1[r] - m_new); sum += e0 + e1; p0[r] = e0; p1[r] = e1; }
                    l_run = l_run * corr + sum;
                } else {
                    if (MODE == M_FOX) {
                        typedef float f32x2 __attribute__((ext_vector_type(2)));
                        const float base = cq2 - fminf(qb2, 48.0f); const f32x2 basev = (f32x2){base, base}, c2v = (f32x2){C2, C2};
                        f32x2 sa = (f32x2){0.f, 0.f}, sb = (f32x2){0.f, 0.f};
#pragma unroll
                        for (int r = 0; r < 16; r += 2) {
                            const f32x2 ca = *(const LAS f32x2*)(cl + 16 * (r >> 3) + (r & 7)), cb = *(const LAS f32x2*)(cl + 32 + 16 * (r >> 3) + (r & 7));
                            const f32x2 ta = (f32x2){p0[r], p0[r + 1]} * c2v + (basev - ca), tb = (f32x2){p1[r], p1[r + 1]} * c2v + (basev - cb);
                            const f32x2 ea = (f32x2){__builtin_amdgcn_exp2f(ta.x), __builtin_amdgcn_exp2f(ta.y)}, eb = (f32x2){__builtin_amdgcn_exp2f(tb.x), __builtin_amdgcn_exp2f(tb.y)};
                            sa += ea; sb += eb; p0[r] = ea.x; p0[r + 1] = ea.y; p1[r] = eb.x; p1[r + 1] = eb.y;
                        }
                        corr = 1.0f; l_run += (sa.x + sa.y) + (sb.x + sb.y);
                    } else {
                    float mx = -INFINITY;
#pragma unroll
                    for (int r = 0; r < 16; ++r) mx = fmaxf(mx, fmaxf(p0[r], p1[r]));
                    mx *= C2;
                    if (MODE == M_MOBA) mx = rowsel ? mx : -INFINITY;
                    mx = fmaxf(mx, __shfl_xor(mx, 32));
                    const float m_new = fmaxf(m_run, mx); corr = __builtin_amdgcn_exp2f(m_run - m_new); m_run = m_new;
                    const float off = (MODE == M_MOBA && !rowsel) ? -INFINITY : -m_new;
                    float s0 = 0.f, s1 = 0.f;
#pragma unroll
                    for (int r = 0; r < 16; ++r) { const float e0 = __builtin_amdgcn_exp2f(fmaf(p0[r], C2, off)), e1 = __builtin_amdgcn_exp2f(fmaf(p1[r], C2, off)); s0 += e0; s1 += e1; p0[r] = e0; p1[r] = e1; }
                    l_run = l_run * corr + (s0 + s1);
                    }
                }
                if (__any(corr != 1.0f)) {
#pragma unroll
                    for (int r = 0; r < 16; ++r) { o0[r] *= corr; o1[r] *= corr; }
                }
            }
            pkP0 = pack8(p0, 0); pkP1 = pack8(p0, 8); pkP2 = pack8(p1, 0); pkP3 = pack8(p1, 8);
        } else {
        if (prev_active) {
            const LAS unsigned char* vb = lds + prevbuf + KB_BYTES + r32 * VT_STRIDE + hi * 16;
#define PVS(s, pk) do { const bf16x8 a0_ = *(const LAS bf16x8*)(vb + (s) * 32), a1_ = *(const LAS bf16x8*)(vb + 32 * VT_STRIDE + (s) * 32); \
            o0 = __builtin_amdgcn_mfma_f32_32x32x16_bf16(a0_, pk, o0, 0, 0, 0); o1 = __builtin_amdgcn_mfma_f32_32x32x16_bf16(a1_, pk, o1, 0, 0, 0); } while (0)
            PVS(0, pkP0); PVS(1, pkP1); PVS(2, pkP2); PVS(3, pkP3);
#undef PVS
        }
        }
        prev_active = active; prevbuf = 2 * BUF_BYTES;
        if (i + 1 < NT) STORET(0, k1, v1, c1);
        if (MODE == M_SB || MODE == M_FOX) {
            bool vote;
            if (MODE == M_SB) vote = __all(T < -151.0f) != 0;
            else { const float cn = (key0 > 0) ? A.cf[key0 - 1] * LOG2E : 0.f; vote = __all(qb2 + cq2 - cn < m_run - 151.0f) != 0; }
            if (lane == 0) ((LAS unsigned*)(lds + VOTE_OFF))[(i & 1) * 8 + wid] = (active && vote) ? 1u : 0u;
        }
        __syncthreads();
        if (MODE == M_SB || MODE == M_FOX) {
            const LAS unsigned* vv = (const LAS unsigned*)(lds + VOTE_OFF) + (i & 1) * 8;
            const unsigned all8 = (vv[0] & vv[1]) & (vv[2] & vv[3]) & (vv[4] & vv[5]) & (vv[6] & vv[7]);
            if (all8) break;
        }
        }
    }
#undef KEY0
#undef LOADT
#undef STORET
    if (prev_active) {
        const LAS unsigned char* vb = lds + prevbuf + KB_BYTES + r32 * VT_STRIDE + hi * 16;
#define PVS(s, pk) do { const bf16x8 a0_ = *(const LAS bf16x8*)(vb + (s) * 32), a1_ = *(const LAS bf16x8*)(vb + 32 * VT_STRIDE + (s) * 32); \
        o0 = __builtin_amdgcn_mfma_f32_32x32x16_bf16(a0_, pk, o0, 0, 0, 0); o1 = __builtin_amdgcn_mfma_f32_32x32x16_bf16(a1_, pk, o1, 0, 0, 0); } while (0)
        PVS(0, pkP0); PVS(1, pkP1); PVS(2, pkP2); PVS(3, pkP3);
#undef PVS
    }
    float inv = 1.0f;
    if (MODE != M_SB) { const float l = l_run + __shfl_xor(l_run, 32); inv = 1.0f / l; if (MODE == M_MOBA) { if (hi == 0) A.lse[(size_t)row * 32] = m_run + __builtin_amdgcn_logf(l); } }
    bf16_t* op = A.O + (size_t)row * A.ldo + 4 * hi;
#pragma unroll
    for (int g = 0; g < 4; ++g) {
        pg8::store4(op + 8 * g, (f32x4){o0[4 * g] * inv, o0[4 * g + 1] * inv, o0[4 * g + 2] * inv, o0[4 * g + 3] * inv});
        pg8::store4(op + 32 + 8 * g, (f32x4){o1[4 * g] * inv, o1[4 * g + 1] * inv, o1[4 * g + 2] * inv, o1[4 * g + 3] * inv});
    }
}

__device__ __forceinline__ void moba_routed_unit(LAS unsigned char* lds, const bf16_t* Qh, const bf16_t* Kh, const bf16_t* Vh, const int* selh, bf16_t* parth, float* lseh, int j, int b0, int b1) {
    int tid_ = threadIdx.x; asm volatile("" : "+v"(tid_)); const int tid = tid_, lane = tid & 63, wid = __builtin_amdgcn_readfirstlane(tid >> 6), r32 = lane & 31, hi = lane >> 5;
    LAS int* list = (LAS int*)(lds + 71680); LAS int* cnt = (LAS int*)(lds + 71680 + 16384);
    if (tid == 0) *cnt = 0;
    u32x4 kk[4], vv[4];
#pragma unroll
    for (int tl = 0; tl < 4; ++tl) { const size_t ro = (size_t)(256 * j + 64 * tl + lane) * 1024 + wid * 8; kk[tl] = *(const u32x4*)(Kh + ro); vv[tl] = *(const u32x4*)(Vh + ro); }
    __syncthreads();
    typedef int i32x4 __attribute__((ext_vector_type(4)));
    for (int t = 256 * b0 + tid; t < 256 * b1; t += 512) {
        const i32x4 s = *(const i32x4*)(selh + (size_t)t * 4);
        if (s.x == j) { const int p = __hip_atomic_fetch_add(cnt, 1, __ATOMIC_RELAXED, __HIP_MEMORY_SCOPE_WORKGROUP); list[p] = t; }
        if (s.y == j) { const int p = __hip_atomic_fetch_add(cnt, 1, __ATOMIC_RELAXED, __HIP_MEMORY_SCOPE_WORKGROUP); list[p] = t | (1 << 16); }
        if (s.z == j) { const int p = __hip_atomic_fetch_add(cnt, 1, __ATOMIC_RELAXED, __HIP_MEMORY_SCOPE_WORKGROUP); list[p] = t | (2 << 16); }
    }
#pragma unroll
    for (int tl = 0; tl < 4; ++tl) { LAS unsigned char* bb_ = lds + tl * BUF_BYTES; *(LAS u32x4*)(bb_ + wid * 1024 + lane * 16) = kk[tl];
        LAS unsigned short* vt_ = (LAS unsigned short*)(bb_ + KB_BYTES + (8 * wid) * VT_STRIDE + lane * 2); const u32x4 vreg = vv[tl];
        vt_[0 * 72] = (unsigned short)(vreg.x & 0xffffu); vt_[1 * 72] = (unsigned short)(vreg.x >> 16); vt_[2 * 72] = (unsigned short)(vreg.y & 0xffffu); vt_[3 * 72] = (unsigned short)(vreg.y >> 16);
        vt_[4 * 72] = (unsigned short)(vreg.z & 0xffffu); vt_[5 * 72] = (unsigned short)(vreg.z >> 16); vt_[6 * 72] = (unsigned short)(vreg.w & 0xffffu); vt_[7 * 72] = (unsigned short)(vreg.w >> 16); }
    __syncthreads();
    const int n = *cnt;
    const int kperm = (r32 & ~15) | (r32 & 3) | ((r32 & 4) << 1) | ((r32 & 8) >> 1);
    for (int g = wid; g * 32 < n; g += 8) {
        const int mi = g * 32 + r32; const bool valid = mi < n; const int e = list[valid ? mi : 0]; const int t = e & 0xffff, slot = e >> 16;
        bf16x8 qr[4];
#pragma unroll
        for (int d0 = 0; d0 < 4; ++d0) qr[d0] = *(const bf16x8*)(Qh + (size_t)t * 1024 + d0 * 16 + hi * 8);
        f32x16 o0, o1;
#pragma unroll
        for (int r = 0; r < 16; ++r) { o0[r] = 0.f; o1[r] = 0.f; }
        float m_run = -1e30f, l_run = 0.f;
#pragma unroll 1
        for (int tl = 0; tl < 4; ++tl) {
            LAS unsigned char* buf = lds + tl * BUF_BYTES;
            f32x16 p0, p1;
#pragma unroll
            for (int r = 0; r < 16; ++r) { p0[r] = 0.f; p1[r] = 0.f; }
            LAS unsigned char* kb = buf + kperm * 16 + hi * 1024;
#pragma unroll
            for (int d0 = 0; d0 < 4; ++d0) {
                const bf16x8 kf0 = *(const LAS bf16x8*)(kb + d0 * 2048), kf1 = *(const LAS bf16x8*)(kb + d0 * 2048 + 512);
                p0 = __builtin_amdgcn_mfma_f32_32x32x16_bf16(kf0, qr[d0], p0, 0, 0, 0);
                p1 = __builtin_amdgcn_mfma_f32_32x32x16_bf16(kf1, qr[d0], p1, 0, 0, 0);
            }
            float mx = -INFINITY;
#pragma unroll
            for (int r = 0; r < 16; ++r) mx = fmaxf(mx, fmaxf(p0[r], p1[r]));
            mx *= C2; mx = fmaxf(mx, __shfl_xor(mx, 32));
            const float m_new = fmaxf(m_run, mx), corr = __builtin_amdgcn_exp2f(m_run - m_new); m_run = m_new;
            float s0 = 0.f, s1 = 0.f;
#pragma unroll
            for (int r = 0; r < 16; ++r) { const float e0 = __builtin_amdgcn_exp2f(fmaf(p0[r], C2, -m_new)), e1 = __builtin_amdgcn_exp2f(fmaf(p1[r], C2, -m_new)); s0 += e0; s1 += e1; p0[r] = e0; p1[r] = e1; }
            l_run = l_run * corr + (s0 + s1);
            if (__any(corr != 1.0f)) {
#pragma unroll
                for (int r = 0; r < 16; ++r) { o0[r] *= corr; o1[r] *= corr; }
            }
            const bf16x8 pk0 = pack8(p0, 0), pk1 = pack8(p0, 8), pk2 = pack8(p1, 0), pk3 = pack8(p1, 8);
            const LAS unsigned char* vb = buf + KB_BYTES + r32 * VT_STRIDE + hi * 16;
#define PVS(s, pk) do { const bf16x8 a0_ = *(const LAS bf16x8*)(vb + (s) * 32), a1_ = *(const LAS bf16x8*)(vb + 32 * VT_STRIDE + (s) * 32); \
            o0 = __builtin_amdgcn_mfma_f32_32x32x16_bf16(a0_, pk, o0, 0, 0, 0); o1 = __builtin_amdgcn_mfma_f32_32x32x16_bf16(a1_, pk, o1, 0, 0, 0); } while (0)
            PVS(0, pk0); PVS(1, pk1); PVS(2, pk2); PVS(3, pk3);
#undef PVS
        }
        const float l = l_run + __shfl_xor(l_run, 32), inv = 1.0f / l;
        if (valid) {
            bf16_t* op = parth + ((size_t)t * 32 + slot) * 64 + 4 * hi;
#pragma unroll
            for (int g4 = 0; g4 < 4; ++g4) {
                pg8::store4(op + 8 * g4, (f32x4){o0[4 * g4] * inv, o0[4 * g4 + 1] * inv, o0[4 * g4 + 2] * inv, o0[4 * g4 + 3] * inv});
                pg8::store4(op + 32 + 8 * g4, (f32x4){o1[4 * g4] * inv, o1[4 * g4 + 1] * inv, o1[4 * g4 + 2] * inv, o1[4 * g4 + 3] * inv});
            }
            if (hi == 0) lseh[(size_t)t * 32 + slot] = m_run + __builtin_amdgcn_logf(l);
        }
    }
    __syncthreads();
}
}
using pg8::bf16_t; using pg8::f32x4; using pg8::u32x4;
constexpr int S = 16384, D = 1024, DFF = 2816, NUP = 5632, MEM = 256;
constexpr size_t MiB = 1u << 20;
constexpr size_t WS_SSQ = 0;
constexpr size_t WS_KPART = 512 * 1024;
constexpr size_t WS_KMX = 1 * MiB;
constexpr size_t WS_WFT = 1 * MiB + 196608;
constexpr size_t WS_DUMMY = 1 * MiB + 131072;
constexpr size_t WS_CNT = 1 * MiB + 4096;
constexpr size_t WS_BAR = 1 * MiB + 65536;
constexpr size_t WS_LOGF = 2 * MiB, WS_CF = 3 * MiB;
constexpr size_t WS_ROPEC = 4 * MiB, WS_ROPES = 6 * MiB;
constexpr size_t WS_MN = 8 * MiB;
constexpr size_t WS_MKV = 9 * MiB;
constexpr size_t WS_XQ = 10 * MiB, WS_XO = 18 * MiB;
constexpr size_t WS_WIN0 = 26 * MiB, WS_WOUT0 = 32 * MiB, WS_WIN1 = 34 * MiB, WS_WOUT1 = WS_WIN1 + 3328 * 1024 * 2, WS_WXQ = WS_WOUT1 + 2 * MiB, WS_WXKV = WS_WXQ + 1 * MiB, WS_WXO = WS_WXKV + 2 * MiB,
                 WS_WUP = WS_WXO + 1 * MiB, WS_WDN = WS_WUP + 22 * MiB, WS_WEND = WS_WDN + 11 * MiB;
static_assert(WS_WEND <= 80 * MiB, "weights");
constexpr size_t WS_XB = 81 * MiB;
constexpr size_t WS_SEL = 242 * MiB, WS_LSE = 244 * MiB;
constexpr size_t WS_Q = 114 * MiB, WS_K = 146 * MiB, WS_V = 178 * MiB, WS_O = 210 * MiB, WS_ACT = 114 * MiB, WS_END = 246 * MiB;

#ifndef SC_MIX0
#define SC_MIX0 1.0f
#endif
#ifndef SC_MIX1
#define SC_MIX1 1.0f
#endif
#ifndef SC_XA
#define SC_XA 1.0f
#endif
#ifndef SC_FFN
#define SC_FFN 1.0f
#endif
#define RLX_AGENT __ATOMIC_RELAXED, __HIP_MEMORY_SCOPE_AGENT
#define XB_TMO      128
#define XB_XCNT(j)  (256  + 64 * (j))
#define XB_XSUB(j)  (1280 + 64 * (j))
#define XB_XGEN(j)  (2304 + 64 * (j))
#define XB_TOP      3328
#define XB_TOPGEN   3392
#define XCD_BAR_WORDS 3456
#define XB_SPIN_CAP (1u << 18)

__device__ __forceinline__ unsigned xb_ld(unsigned* p)              { return __hip_atomic_load(p, __ATOMIC_RELAXED, __HIP_MEMORY_SCOPE_AGENT); }
__device__ __forceinline__ unsigned xb_add(unsigned* p, unsigned v) { return __hip_atomic_fetch_add(p, v, __ATOMIC_RELAXED, __HIP_MEMORY_SCOPE_AGENT); }
__device__ __forceinline__ unsigned xb_xcc_id() { return (unsigned)__builtin_amdgcn_s_getreg((3 << 11) | 20) & 0xFu; }
#define XB_SPIN(cond, bar) do { unsigned _sp = 0; while (cond) { __builtin_amdgcn_s_sleep(1); \
    if ((++_sp & 255u) == 0u) { if (xb_ld(&(bar)[XB_TMO])) break; if (_sp > XB_SPIN_CAP) { atomicAdd(&(bar)[XB_TMO], 1u); break; } } } } while (0)

struct XcdBarrier {
    unsigned* bar; unsigned x;
    volatile LAS unsigned* st;
};

__device__ __forceinline__ XcdBarrier xcd_barrier_post(unsigned* bar, volatile LAS unsigned* st) {
    XcdBarrier b; b.bar = bar; b.x = xb_xcc_id(); b.st = st;
    if (threadIdx.x == 0) (void)xb_add(&bar[XB_XCNT(b.x)], 1u);
    return b;
}
__device__ __forceinline__ void xcd_barrier_complete(unsigned* bar, unsigned x, unsigned& nloc, unsigned& nx) {
    const unsigned G = gridDim.x * gridDim.y * gridDim.z;
    unsigned sum, cnt, mine, sp = 0u;
    for (;;) {
        sum = 0u; cnt = 0u; mine = 0u;
#pragma unroll
        for (unsigned j = 0; j < 16; ++j) { const unsigned c = xb_ld(&bar[XB_XCNT(j)]); sum += c; cnt += (c > 0u) ? 1u : 0u; mine = (j == x) ? c : mine; }
        if (sum == G) break;
        __builtin_amdgcn_s_sleep(1);
        if ((++sp & 255u) == 0u) { if (xb_ld(&bar[XB_TMO])) break; if (sp > XB_SPIN_CAP) { atomicAdd(&bar[XB_TMO], 1u); break; } }
    }
    nloc = mine > 0u ? mine : 1u; nx = cnt > 0u ? cnt : 1u;
}

__device__ __forceinline__ void xcd_barrier(const XcdBarrier& b) {
    asm volatile("s_waitcnt vmcnt(0)" ::: "memory");
    __syncthreads();
    if (threadIdx.x == 0) {
        unsigned* bar = b.bar;
        __builtin_amdgcn_s_waitcnt(0);
        unsigned nloc = b.st[0], nx = b.st[1];
        if (nloc == 0u) { xcd_barrier_complete(bar, b.x, nloc, nx); b.st[0] = nloc; b.st[1] = nx; }
        const unsigned old = xb_add(&bar[XB_XSUB(b.x)], 1u);
        const unsigned gen = old / nloc;
        if (old + 1u == (gen + 1u) * nloc) {
            __builtin_amdgcn_fence(__ATOMIC_RELEASE, "agent");
            asm volatile("s_waitcnt vmcnt(0)" ::: "memory");
            const unsigned og = xb_add(&bar[XB_TOP], 1u);
            const unsigned tg = og / nx;
            if (og + 1u == (tg + 1u) * nx) xb_add(&bar[XB_TOPGEN], 1u);
            else XB_SPIN(xb_ld(&bar[XB_TOPGEN]) == tg, bar);
            __builtin_amdgcn_fence(__ATOMIC_ACQUIRE, "agent");
            xb_add(&bar[XB_XGEN(b.x)], 1u);
            asm volatile("s_waitcnt vmcnt(0)" ::: "memory");
        } else {
            XB_SPIN(xb_ld(&bar[XB_XGEN(b.x)]) == gen, bar);
            __builtin_amdgcn_fence(__ATOMIC_ACQUIRE, "agent");
            asm volatile("s_waitcnt vmcnt(0)" ::: "memory");
        }
    }
    __syncthreads();
}

#ifndef REP_OUT
#define REP_OUT 1
#endif
#ifndef REP_XQ
#define REP_XQ 1
#endif
#ifndef REP_XO
#define REP_XO 1
#endif
#ifndef REP_DN
#define REP_DN 1
#endif
#ifndef REP_PRO
#define REP_PRO 1
#endif
#ifndef REP_QKV
#define REP_QKV 1
#endif
#ifndef REP_ATT0
#define REP_ATT0 1
#endif
#ifndef REP_FOX
#define REP_FOX 1
#endif
#ifndef REP_UP
#define REP_UP 1
#endif
#ifndef REP_SYNC
#define REP_SYNC 1
#endif
#ifndef REP_XA
#define REP_XA 1
#endif
struct Args { const float* in[20]; float* out; unsigned char* ws; };

__device__ __forceinline__ unsigned f2bf(float f) { unsigned u = __builtin_bit_cast(unsigned, f); return (u + 0x7fffu + ((u >> 16) & 1u)) >> 16; }
__device__ __forceinline__ unsigned pk2(float lo, float hi) { return f2bf(lo) | (f2bf(hi) << 16); }
__device__ __forceinline__ float wave_sum(float v) {
#pragma unroll
    for (int o = 1; o < 64; o <<= 1) v += __shfl_xor(v, o);
    return v;
}
__device__ __forceinline__ int colmap(int mode, int p) {
    if (mode == 1) { if ((p >= 512 && p < 1024) || (p >= 1536 && p < 2048)) { const int w = p & 63; return (p & ~63) + 32 * ((w >> 4) & 1) + 16 * (w >> 5) + (w & 15); } return p; }
    if (mode == 2) return ((p >> 7) & 1) * 2816 + (p >> 8) * 128 + (p & 127);
    return p;
}
__device__ __forceinline__ void conv_weight(const float* W, int ldw, int K, int Nphys, int Nvalid, int mode, const float* g, bf16_t* WT, LAS float* scr, int gw, int NGW, int lane, int& rot) {
    const int nblk = Nphys / 32, items = (K / 64) * nblk;
    const int g0 = (gw - rot % NGW + NGW) % NGW; rot += items;
    for (int it = g0; it < items; it += NGW) {
        const int kb = it / nblk, nb = it % nblk, k0 = 64 * kb, n0 = 32 * nb;
        const int prow = n0 + (lane & 31); const bool ok = prow < Nvalid; const int col = ok ? colmap(mode, prow) : 0;
        float wv_[32];
#pragma unroll
        for (int i = 0; i < 32; ++i) { const int kk = 2 * i + (lane >> 5); wv_[i] = ok ? W[(size_t)(k0 + kk) * ldw + col] : 0.f; }
#pragma unroll
        for (int i = 0; i < 32; ++i) { const int kk = 2 * i + (lane >> 5); float v = wv_[i]; if (g) v *= g[k0 + kk]; scr[kk * 33 + (lane & 31)] = v; }
        asm volatile("s_waitcnt lgkmcnt(0)" ::: "memory");
        const int c = lane & 7;
#pragma unroll
        for (int j = 0; j < 4; ++j) { const int n = (lane >> 3) + 8 * j; const LAS float* s = scr + (8 * c) * 33 + n;
            u32x4 o; o.x = pk2(s[0 * 33], s[1 * 33]); o.y = pk2(s[2 * 33], s[3 * 33]); o.z = pk2(s[4 * 33], s[5 * 33]); o.w = pk2(s[6 * 33], s[7 * 33]);
            *(u32x4*)(WT + (size_t)(n0 + n) * K + k0 + 8 * c) = o; }
        asm volatile("s_waitcnt lgkmcnt(0)" ::: "memory");
    }
}

template <class Epi>
__device__ __forceinline__ void run_gemm(LAS unsigned char* lds, const bf16_t* A, const bf16_t* Bt, int Mtiles, int N, int K, int a_w1, int a_h, int a_t, const Epi& E, int cshift = 0) {
    pg8::Gemm g{A, Bt, Mtiles * 256, N, K, a_w1, a_h, a_t};
    pg8::StaticOrder So; So.init(Mtiles * 256, N, (int)gridDim.x, (int)blockIdx.x - cshift);
    pg8::gemm_phase<Epi, pg8::StaticOrder, true, true>(lds, g, So, E);
}

template <int MODE>
__device__ __forceinline__ void attn_units(LAS unsigned char* lds, unsigned* counter, int idx0, int nunits, int nheads, int head0, bool head_major, const bf16_t* Q, int ldq, const bf16_t* K, const bf16_t* V, int ldkv, bf16_t* O, int ldo,
                                           const float* cf, const unsigned* kmx, const float* kpart, int* sel = nullptr, float* lse = nullptr) {
    LAS int* slot = (LAS int*)(lds + 147456 - 128);
    for (;;) {
        int idx;
        if (counter) {
            if (threadIdx.x == 0) *slot = (int)__hip_atomic_fetch_add(counter, 1u, __ATOMIC_RELAXED, __HIP_MEMORY_SCOPE_AGENT);
            __syncthreads(); idx = *slot - idx0; __syncthreads();
            if (idx >= nunits) break;
            if (idx < 0) continue;
        } else { idx = (int)blockIdx.x; if (idx >= nunits) break; }
        const int h = head_major ? (nheads - 1 - idx / 64) : (idx % nheads), qb = head_major ? (63 - idx % 64) : (63 - idx / nheads), hh = head0 + h;
        att::AttnArgs a; a.Q = Q + hh * 64; a.ldq = ldq; a.K = K + hh * 64; a.V = V + hh * 64; a.ldkv = ldkv; a.O = O + hh * 64; a.ldo = ldo;
        a.cf = cf ? cf + (size_t)hh * S : nullptr; a.kmax2 = kmx ? (__uint_as_float(kmx[2 * hh]) + __uint_as_float(kmx[2 * hh + 1])) * 1.02f : 0.f;
        a.kpart = kpart ? kpart + (size_t)h * 64 * 256 : nullptr;
        a.sel = sel ? sel + (size_t)h * S * 4 : nullptr; a.lse = lse ? lse + h * 4 + 3 : nullptr;
        if (MODE == att::M_MOBA) { a.O = O + (h * 4 + 3) * 64; }
        att::attn_unit<MODE>(lds, a, qb);
        if (!counter) break;
    }
}

typedef const __attribute__((address_space(4))) char* kargp_t;
__device__ __forceinline__ const void* kin(int i) { size_t o = (size_t)i * 8; asm volatile("" : "+s"(o)); return *(const void* const __attribute__((address_space(4)))*)((kargp_t)__builtin_amdgcn_kernarg_segment_ptr() + o); }
__device__ __forceinline__ unsigned char* wsoff(size_t off) { unsigned char* w = (unsigned char*)kin(21); asm volatile("" : "+s"(off)); return w + off; }
#define INF(i) ((const float*)kin(i))
#define OUTP ((float*)kin(20))
#define WSP(T, off) ((T*)wsoff(off))

#define GSYNC() do { XcdBarrier b_; b_.bar = WSP(unsigned, WS_BAR); b_.x = xb_xcc_id(); b_.st = (volatile LAS unsigned*)(lds + 147456 - 64); xcd_barrier(b_); } while (0)
__global__ void __launch_bounds__(512, 2) fwd_kernel(Args args) {
    extern __shared__ __attribute__((aligned(16))) unsigned char lds_raw[];
    LAS unsigned char* lds = (LAS unsigned char*)lds_raw;
    cg::grid_group grid = cg::this_grid();
    (void)args;
    if (threadIdx.x == 0) { volatile LAS unsigned* st_ = (volatile LAS unsigned*)(lds + 147456 - 64); st_[0] = 0u; st_[1] = 0u; }
#pragma unroll 1
    for (int rep_ = 0; rep_ < REP_PRO; ++rep_) {
        int tid_ = threadIdx.x; asm volatile("" : "+v"(tid_)); const int tid = tid_, lane = tid & 63, wave = __builtin_amdgcn_readfirstlane(tid >> 6);
        const int G = (int)gridDim.x, gw = (int)blockIdx.x * 8 + wave, NGW = G * 8, gt = (int)blockIdx.x * 512 + tid, NGT = G * 512;
        LAS float* scr = (LAS float*)(lds + wave * 16384); int rot = 0;
        conv_weight(INF(7), 3072, 1024, 3072, 3072, 1, INF(3), WSP(bf16_t, WS_WIN0), scr, gw, NGW, lane, rot);
        conv_weight(INF(8), 1024, 1024, 1024, 1024, 0, nullptr, WSP(bf16_t, WS_WOUT0), scr, gw, NGW, lane, rot);
        conv_weight(INF(12), 256, 1024, 256, 256, 0, INF(4), WSP(bf16_t, WS_WXQ), scr, gw, NGW, lane, rot);
#pragma unroll 1
        for (int l = 0; l < 2; ++l) conv_weight(INF(13) + (size_t)l * 1024 * 512, 512, 1024, 512, 512, 0, nullptr, WSP(bf16_t, WS_WXKV) + (size_t)l * 512 * 1024, scr, gw, NGW, lane, rot);
        conv_weight(INF(14), 1024, 256, 1024, 1024, 0, nullptr, WSP(bf16_t, WS_WXO), scr, gw, NGW, lane, rot);
        conv_weight(INF(15), NUP, 1024, NUP, NUP, 2, INF(6), WSP(bf16_t, WS_WUP), scr, gw, NGW, lane, rot);
        conv_weight(INF(18), 1024, DFF, 1024, 1024, 0, nullptr, WSP(bf16_t, WS_WDN), scr, gw, NGW, lane, rot);
        {
            const float* x = INF(0); float* ssq = WSP(float, WS_SSQ); bf16_t* XB = WSP(bf16_t, WS_XB);
            for (int m = gw; m < S; m += NGW) {
                const f32x4* xr = (const f32x4*)(x + (size_t)m * D) + lane; f32x4 v[4]; float s = 0.f;
#pragma unroll
                for (int j = 0; j < 4; ++j) { v[j] = xr[64 * j]; s += (v[j][0] * v[j][0] + v[j][1] * v[j][1]) + (v[j][2] * v[j][2] + v[j][3] * v[j][3]); }
                s = wave_sum(s); if (lane == 0) ssq[m] = s;
                unsigned long long* o8 = (unsigned long long*)(XB + (size_t)m * D) + lane;
#pragma unroll
                for (int j = 0; j < 4; ++j) o8[64 * j] = (unsigned long long)pk2(v[j][0], v[j][1]) | ((unsigned long long)pk2(v[j][2], v[j][3]) << 32);
            }
            for (int idx = gt; idx < 6 * S; idx += NGT) ssq[S + idx] = 0.f;
            for (int idx = gt; idx < 2 * D / 2; idx += NGT) ((unsigned*)(XB - 2 * D))[idx] = 0u;
            for (int idx = gt; idx < 256 * D / 2; idx += NGT) ((unsigned*)(XB + (size_t)S * D))[idx] = 0u;
            if (gt < 32) WSP(unsigned, WS_KMX)[gt] = 0u;
            if (gt < 128) WSP(unsigned, WS_CNT)[gt] = 0u;
            for (int idx = gt; idx < XCD_BAR_WORDS; idx += NGT) WSP(unsigned, WS_BAR)[idx] = 0u;
        }
        {
            const float* mem = INF(1); const float* g_mem = INF(5); bf16_t* MN = WSP(bf16_t, WS_MN);
            for (int m = gw; m < MEM; m += NGW) {
                const f32x4* xr = (const f32x4*)(mem + (size_t)m * D) + lane; f32x4 v[4]; float s = 0.f;
#pragma unroll
                for (int j = 0; j < 4; ++j) { v[j] = xr[64 * j]; s += (v[j][0] * v[j][0] + v[j][1] * v[j][1]) + (v[j][2] * v[j][2] + v[j][3] * v[j][3]); }
                s = wave_sum(s); const float rs = rsqrtf(s * (1.0f / 1024.0f) + 1e-6f);
#pragma unroll
                for (int l = 0; l < 2; ++l) { unsigned long long* o8 = (unsigned long long*)(MN + ((size_t)l * MEM + m) * D) + lane;
#pragma unroll
                    for (int j = 0; j < 4; ++j) { const f32x4 gg = ((const f32x4*)(g_mem + l * 1024) + lane)[64 * j];
                        o8[64 * j] = (unsigned long long)pk2(v[j][0] * rs * gg[0], v[j][1] * rs * gg[1]) | ((unsigned long long)pk2(v[j][2] * rs * gg[2], v[j][3] * rs * gg[3]) << 32); } }
            }
        }
        {
            const int* pos = (const int*)kin(2); float* ropec = WSP(float, WS_ROPEC); float* ropes = WSP(float, WS_ROPES);
            for (int idx = gt; idx < S * 32; idx += NGT) {
                const int t = idx >> 5, i = idx & 31;
                const float invf = (float)exp2(-(double)i * (13.287712379549449 / 32.0));
                const float ang = (float)pos[t] * invf;
                const double a = (double)ang; const double n = rint(a * 0.63661977236758134308); double rr = fma(-n, 1.57079632679489655800e+00, a); rr = fma(-n, 6.12323399573676603587e-17, rr);
                const double r2 = rr * rr;
                const double sn = rr * (1.0 + r2 * (-1.0 / 6 + r2 * (1.0 / 120 + r2 * (-1.0 / 5040 + r2 * (1.0 / 362880 + r2 * (-1.0 / 39916800 + r2 * (1.0 / 6227020800.0)))))));
                const double cs = 1.0 + r2 * (-0.5 + r2 * (1.0 / 24 + r2 * (-1.0 / 720 + r2 * (1.0 / 40320 + r2 * (-1.0 / 3628800 + r2 * (1.0 / 479001600.0 + r2 * (-1.0 / 87178291200.0)))))));
                const int qd = ((int)(long long)n) & 3;
                const double co = (qd == 0) ? cs : (qd == 1) ? -sn : (qd == 2) ? -cs : sn, si = (qd == 0) ? sn : (qd == 1) ? cs : (qd == 2) ? -sn : -cs;
                ropec[idx] = (float)co; ropes[idx] = (float)si;
            }
        }
    }
    grid.sync();
    if (threadIdx.x == 0) (void)xb_add(&WSP(unsigned, WS_BAR)[XB_XCNT(xb_xcc_id())], 1u);
#pragma unroll 1
    for (int layer = 0; layer < 2; ++layer) {
#pragma unroll 1
        for (int rep_ = 0; rep_ < REP_QKV; ++rep_)
        if (layer == 0) {
            { pg8::EpiQKV0 E{WSP(bf16_t, WS_Q), (size_t)(WS_K - WS_Q) / 2, WSP(float, WS_SSQ), WSP(float, WS_ROPEC), WSP(float, WS_ROPES), WSP(float, WS_KPART)};
              run_gemm(lds, WSP(bf16_t, WS_XB), WSP(bf16_t, WS_WIN0), S / 256, 3072, 1024, 64, 128, 256, E); }
        } else {
            {
                int tid_ = threadIdx.x; asm volatile("" : "+v"(tid_)); const int tid = tid_, lane = tid & 63, wv = __builtin_amdgcn_readfirstlane(tid >> 6), r32 = lane & 31, hi = lane >> 5;
                const bf16_t* XBp = WSP(bf16_t, WS_XB); const bf16_t* WF = WSP(bf16_t, WS_WFT); const float* ssq3 = WSP(float, WS_SSQ) + (size_t)3 * S; const float* bfg = INF(10); float* lf = WSP(float, WS_LOGF);
                LAS float* red = (LAS float*)lds;
                for (int rb = (int)blockIdx.x * 64; rb < S; rb += (int)gridDim.x * 64) {
                    att::f32x16 a0, a1;
#pragma unroll
                    for (int r = 0; r < 16; ++r) { a0[r] = 0.f; a1[r] = 0.f; }
                    pg8::bf16x8 af0[8], af1[8], bfr[8];
#pragma unroll
                    for (int s = 0; s < 8; ++s) { const int ko = wv * 128 + 16 * s + 8 * hi;
                        bfr[s] = *(const pg8::bf16x8*)(WF + (size_t)r32 * 1024 + ko); af0[s] = *(const pg8::bf16x8*)(XBp + (size_t)(rb + r32) * 1024 + ko); af1[s] = *(const pg8::bf16x8*)(XBp + (size_t)(rb + 32 + r32) * 1024 + ko); }
#pragma unroll
                    for (int s = 0; s < 8; ++s) { a0 = __builtin_amdgcn_mfma_f32_32x32x16_bf16(af0[s], bfr[s], a0, 0, 0, 0); a1 = __builtin_amdgcn_mfma_f32_32x32x16_bf16(af1[s], bfr[s], a1, 0, 0, 0); }
                    if (r32 < 16) {
#pragma unroll
                        for (int r = 0; r < 16; ++r) { const int i = (r & 3) + 8 * (r >> 2) + 4 * hi; red[(wv * 64 + i) * 16 + r32] = a0[r]; red[(wv * 64 + 32 + i) * 16 + r32] = a1[r]; }
                    }
                    __syncthreads();
                    for (int o = tid; o < 1024; o += 512) { const int tok = o >> 4, h = o & 15; float sum = 0.f;
#pragma unroll
                        for (int w = 0; w < 8; ++w) sum += red[(w * 64 + tok) * 16 + h];
                        const int row = rb + tok; const float x = sum * pg8::rstd_of(ssq3, row) + bfg[h];
                        lf[(size_t)h * S + row] = fminf(x, 0.f) - log1pf(expf(-fabsf(x))); }
                    __syncthreads();
                }
            }
            pg8::EpiBf E{WSP(bf16_t, WS_Q), 1024, WSP(float, WS_SSQ) + (size_t)3 * S, 4, (size_t)(WS_K - WS_Q) / 2, nullptr, nullptr, WSP(unsigned, WS_KMX)};
            run_gemm(lds, WSP(bf16_t, WS_XB), WSP(bf16_t, WS_WIN1), S / 256, 3072, 1024, 64, 128, 256, E);
        }
        GSYNC();
        if (layer == 0) {
            attn_units<att::M_MOBA>(lds, WSP(unsigned, WS_CNT), 0, 512, 8, 8, false, WSP(bf16_t, WS_Q), 1024, WSP(bf16_t, WS_K), WSP(bf16_t, WS_V), 1024, (bf16_t*)OUTP, 2048, nullptr, nullptr, WSP(float, WS_KPART), WSP(int, WS_SEL), WSP(float, WS_LSE));
            attn_units<att::M_SB>(lds, WSP(unsigned, WS_CNT) + 32, 0, 512, 8, 0, false, WSP(bf16_t, WS_Q), 1024, WSP(bf16_t, WS_K), WSP(bf16_t, WS_V), 1024, WSP(bf16_t, WS_O), 1024, nullptr, nullptr, nullptr);
            GSYNC();
            {
                LAS int* slot = (LAS int*)(lds + 147456 - 128);
                for (;;) {
                    if (threadIdx.x == 0) *slot = (int)__hip_atomic_fetch_add(WSP(unsigned, WS_CNT) + 96, 1u, __ATOMIC_RELAXED, __HIP_MEMORY_SCOPE_AGENT);
                    __syncthreads(); const int idx = *slot; __syncthreads();
                    if (idx >= 1248) break;
                    const int h8 = idx & 7; int u = idx >> 3, j = 0;
                    while (u >= ((63 - j + 15) >> 4)) { u -= ((63 - j + 15) >> 4); ++j; }
                    const int b0 = j + 1 + 16 * u, b1 = (b0 + 16 < 64) ? b0 + 16 : 64;
                    att::moba_routed_unit(lds, WSP(bf16_t, WS_Q) + (8 + h8) * 64, WSP(bf16_t, WS_K) + (8 + h8) * 64, WSP(bf16_t, WS_V) + (8 + h8) * 64, WSP(int, WS_SEL) + (size_t)h8 * S * 4,
                                          (bf16_t*)OUTP + h8 * 4 * 64, WSP(float, WS_LSE) + h8 * 4, j, b0, b1);
                }
            }
            GSYNC();
            {
                int tid_ = threadIdx.x; asm volatile("" : "+v"(tid_)); const int tid = tid_, lane = tid & 63, wave = __builtin_amdgcn_readfirstlane(tid >> 6);
                const int gw = (int)blockIdx.x * 8 + wave, NGW = (int)gridDim.x * 8;
                const bf16_t* part = (const bf16_t*)OUTP; const float* lse = WSP(float, WS_LSE); bf16_t* Ob = WSP(bf16_t, WS_O);
                for (int p = gw * 8 + (lane >> 3); p < S * 8; p += NGW * 8) {
                    const int t = p >> 3, h8 = p & 7, ch = lane & 7; const int own = t >> 8, nv = own < 3 ? own : 3;
                    const f32x4 ls = *(const f32x4*)(lse + (size_t)p * 4);
                    float mx = ls[3];
                    if (nv > 0) mx = fmaxf(mx, ls[0]); if (nv > 1) mx = fmaxf(mx, ls[1]); if (nv > 2) mx = fmaxf(mx, ls[2]);
                    const float w0 = nv > 0 ? __builtin_amdgcn_exp2f(ls[0] - mx) : 0.f, w1 = nv > 1 ? __builtin_amdgcn_exp2f(ls[1] - mx) : 0.f, w2 = nv > 2 ? __builtin_amdgcn_exp2f(ls[2] - mx) : 0.f, w3 = __builtin_amdgcn_exp2f(ls[3] - mx);
                    const float wi = 1.0f / ((w0 + w1) + (w2 + w3));
                    float acc8[8];
#pragma unroll
                    for (int e = 0; e < 8; ++e) acc8[e] = 0.f;
#pragma unroll
                    for (int s = 0; s < 4; ++s) {
                        const float w = (s == 0) ? w0 : (s == 1) ? w1 : (s == 2) ? w2 : w3;
                        if (s == 3 || s < nv) {
                            const pg8::bf16x8 v = *(const pg8::bf16x8*)(part + ((size_t)p * 4 + s) * 64 + ch * 8);
#pragma unroll
                            for (int e = 0; e < 8; ++e) acc8[e] += w * att::bf2f(v[e]);
                        }
                    }
                    pg8::store8(Ob + (size_t)t * 1024 + (8 + h8) * 64 + ch * 8, (f32x4){acc8[0] * wi, acc8[1] * wi, acc8[2] * wi, acc8[3] * wi}, (f32x4){acc8[4] * wi, acc8[5] * wi, acc8[6] * wi, acc8[7] * wi});
                }
            }
        } else {
            {
                int tid_ = threadIdx.x; asm volatile("" : "+v"(tid_)); const int tid = tid_, lane = tid & 63, wv = tid >> 6;
                LAS double* sc = (LAS double*)lds;
                for (int wgi = (int)blockIdx.x; wgi < 256; wgi += (int)gridDim.x) {
                    const int h = wgi >> 4, seg = wgi & 15;
                    const float* src = WSP(float, WS_LOGF) + (size_t)h * S;
                    double part = 0.0;
                    for (int i = tid; i < seg * 1024; i += 512) part += (double)src[i];
#pragma unroll
                    for (int o = 32; o >= 1; o >>= 1) part += __shfl_xor(part, o);
                    const int e0 = seg * 1024 + 2 * tid; const double a = (double)src[e0], b = (double)src[e0 + 1];
                    double incl = a + b;
#pragma unroll
                    for (int o = 1; o < 64; o <<= 1) { const double t = __shfl_up(incl, o); if (lane >= o) incl += t; }
                    if (lane == 0) sc[wv] = part;
                    if (lane == 63) sc[8 + wv] = incl;
                    __syncthreads();
                    double before = 0.0;
#pragma unroll
                    for (int k = 0; k < 8; ++k) before += sc[k];
                    for (int k = 0; k < wv; ++k) before += sc[8 + k];
                    const double excl = before + (incl - (a + b));
                    float* dst = WSP(float, WS_CF) + (size_t)h * S + e0;
                    dst[0] = (float)(excl + a); dst[1] = (float)(excl + a + b);
                    __syncthreads();
                }
            }
            GSYNC();
#pragma unroll 1
            for (int rep_ = 0; rep_ < REP_FOX; ++rep_)
            attn_units<att::M_FOX>(lds, WSP(unsigned, WS_CNT) + 64, 0, 1024, 16, 0, true, WSP(bf16_t, WS_Q), 1024, WSP(bf16_t, WS_K), WSP(bf16_t, WS_V), 1024, WSP(bf16_t, WS_O), 1024, WSP(float, WS_CF), WSP(unsigned, WS_KMX), nullptr);
        }
        GSYNC();
#pragma unroll 1
        for (int rep_ = REP_OUT - 1; rep_ >= 0; --rep_)
        { pg8::EpiRes E{(layer == 0 && rep_ == 0) ? INF(0) : (const float*)OUTP, OUTP, WSP(bf16_t, WS_XB), rep_ ? WSP(float, WS_DUMMY) : WSP(float, WS_SSQ) + (size_t)(3 * layer + 1) * S, rep_ ? 0.0f : (layer == 0 ? SC_MIX0 : SC_MIX1)};
          run_gemm(lds, WSP(bf16_t, WS_O), layer == 0 ? WSP(bf16_t, WS_WOUT0) : WSP(bf16_t, WS_WOUT1), S / 256, 1024, 1024, 64, 128, 256, E); }
        GSYNC();
#pragma unroll 1
        for (int rep_ = 0; rep_ < REP_XQ; ++rep_)
        { pg8::EpiBf E{WSP(bf16_t, WS_XQ), 256, WSP(float, WS_SSQ) + (size_t)(3 * layer + 1) * S, 0, 0, nullptr, nullptr, nullptr};
          run_gemm(lds, WSP(bf16_t, WS_XB), WSP(bf16_t, WS_WXQ) + (size_t)layer * 256 * 1024, S / 256, 256, 1024, 64, 128, 256, E); }
        if (layer == 0 && (int)blockIdx.x >= 68) {
            int tid_ = threadIdx.x; asm volatile("" : "+v"(tid_)); const int tid = tid_, lane = tid & 63, wave = __builtin_amdgcn_readfirstlane(tid >> 6);
            const int gw = ((int)blockIdx.x - 68) * 8 + wave, NGW = ((int)gridDim.x - 68) * 8, gt = ((int)blockIdx.x - 68) * 512 + tid, NGT = ((int)gridDim.x - 68) * 512;
            LAS float* scr = (LAS float*)(lds + wave * 16384); int rot = 0;
            conv_weight(INF(9), 3088, 1024, 3072, 3072, 0, INF(3) + 1024, WSP(bf16_t, WS_WIN1), scr, gw, NGW, lane, rot);
            { const float* wi = INF(9); const float* gm = INF(3) + 1024; bf16_t* wf = WSP(bf16_t, WS_WFT);
              for (int idx = gt; idx < 32 * 1024; idx += NGT) { const int n = idx >> 10, k = idx & 1023; wf[idx] = (bf16_t)f2bf(n < 16 ? gm[k] * wi[(size_t)k * 3088 + 3072 + n] : 0.f); } }
            conv_weight(INF(11), 1024, 1024, 1024, 1024, 0, nullptr, WSP(bf16_t, WS_WOUT1), scr, gw, NGW, lane, rot);
            conv_weight(INF(12) + (size_t)1024 * 256, 256, 1024, 256, 256, 0, INF(4) + 1024, WSP(bf16_t, WS_WXQ) + (size_t)256 * 1024, scr, gw, NGW, lane, rot);
            conv_weight(INF(14) + (size_t)256 * 1024, 1024, 256, 1024, 1024, 0, nullptr, WSP(bf16_t, WS_WXO) + (size_t)1024 * 256, scr, gw, NGW, lane, rot);
            conv_weight(INF(15) + (size_t)1024 * NUP, NUP, 1024, NUP, NUP, 2, INF(6) + 1024, WSP(bf16_t, WS_WUP) + (size_t)NUP * 1024, scr, gw, NGW, lane, rot);
            conv_weight(INF(18) + (size_t)DFF * 1024, 1024, DFF, 1024, 1024, 0, nullptr, WSP(bf16_t, WS_WDN) + (size_t)1024 * DFF, scr, gw, NGW, lane, rot);
        }
        if (layer == 0 && (int)blockIdx.x >= 64 && (int)blockIdx.x < 68) {
            const int l = ((int)blockIdx.x - 64) >> 1;
            pg8::EpiBf E2{WSP(bf16_t, WS_MKV) + (size_t)l * MEM * 512, 512, nullptr, 0, 0, nullptr, nullptr, nullptr};
            run_gemm(lds, WSP(bf16_t, WS_MN) + (size_t)l * MEM * D, WSP(bf16_t, WS_WXKV) + (size_t)l * 512 * 1024, 1, 512, 1024, 64, 128, 256, E2, 64 + 2 * l);
        }
        GSYNC();
#pragma unroll 1
        for (int rep_ = 0; rep_ < REP_XA; ++rep_)
        attn_units<att::M_XA>(lds, nullptr, 0, 256, 4, 0, false, WSP(bf16_t, WS_XQ), 256, WSP(bf16_t, WS_MKV) + (size_t)layer * MEM * 512, WSP(bf16_t, WS_MKV) + (size_t)layer * MEM * 512 + 256, 512, WSP(bf16_t, WS_XO), 256, nullptr, nullptr, nullptr);
        GSYNC();
#pragma unroll 1
        for (int rep_ = REP_XO - 1; rep_ >= 0; --rep_)
        { pg8::EpiRes E{OUTP, OUTP, WSP(bf16_t, WS_XB), rep_ ? WSP(float, WS_DUMMY) : WSP(float, WS_SSQ) + (size_t)(3 * layer + 2) * S, rep_ ? 0.0f : SC_XA};
          run_gemm(lds, WSP(bf16_t, WS_XO), WSP(bf16_t, WS_WXO) + (size_t)layer * 1024 * 256, S / 256, 1024, 256, 64, 128, 256, E); }
        GSYNC();
#pragma unroll 1
        for (int rep_ = 0; rep_ < REP_UP; ++rep_)
        { pg8::EpiUpConv E{WSP(bf16_t, WS_ACT), WSP(float, WS_SSQ) + (size_t)(3 * layer + 2) * S, INF(16) + (size_t)layer * 3 * NUP, INF(17) + (size_t)layer * NUP};
          run_gemm(lds, WSP(bf16_t, WS_XB) - 2 * D, WSP(bf16_t, WS_WUP) + (size_t)layer * NUP * 1024, 66, NUP, 1024, 126, 64, 252, E); }
        GSYNC();
#pragma unroll 1
        for (int rep_ = REP_DN - 1; rep_ >= 0; --rep_)
        { pg8::EpiRes E{OUTP, OUTP, layer == 1 ? (bf16_t*)nullptr : WSP(bf16_t, WS_XB), rep_ ? WSP(float, WS_DUMMY) : WSP(float, WS_SSQ) + (size_t)(3 * layer + 3) * S, rep_ ? 0.0f : SC_FFN};
          run_gemm(lds, WSP(bf16_t, WS_ACT), WSP(bf16_t, WS_WDN) + (size_t)layer * 1024 * DFF, S / 256, 1024, DFF, 64, 128, 256, E); }
        GSYNC();
#pragma unroll 1
        for (int rep_ = 1; rep_ < REP_SYNC; ++rep_) { GSYNC(); GSYNC(); GSYNC(); GSYNC(); GSYNC(); }
    }
    {
        int tid_ = threadIdx.x; asm volatile("" : "+v"(tid_)); const int tid = tid_, lane = tid & 63, wave = __builtin_amdgcn_readfirstlane(tid >> 6);
        const int gw = (int)blockIdx.x * 8 + wave, NGW = (int)gridDim.x * 8;
        const float* ssq_fin = WSP(float, WS_SSQ) + (size_t)6 * S; const float* gf = INF(19); float* out = OUTP;
        for (int m = gw; m < S; m += NGW) {
            const float rs = rsqrtf(ssq_fin[m] * (1.0f / 1024.0f) + 1e-6f);
            f32x4* xr = (f32x4*)(out + (size_t)m * D) + lane;
#pragma unroll
            for (int j = 0; j < 4; ++j) { const f32x4 gg = ((const f32x4*)gf + lane)[64 * j]; xr[64 * j] = xr[64 * j] * rs * gg; }
        }
    }
}

extern "C" void kernel_launch(void* const* d_in, const int* in_sizes, int n_in, void* d_out, int out_size, void* d_ws, size_t ws_size, hipStream_t stream) {
    static int grid = 0;
    constexpr int LDSB = 147456;
    if (grid == 0) {
        if (n_in != 20 || out_size != S * D || ws_size < WS_END) { fprintf(stderr, "kernel_launch: unexpected shapes (n_in %d out %d ws %zu)\n", n_in, out_size, ws_size); grid = -1; return; }
        int dev = 0, cus = 0, per = 0;
        hipGetDevice(&dev); hipDeviceGetAttribute(&cus, hipDeviceAttributeMultiprocessorCount, dev);
        hipFuncSetAttribute((const void*)fwd_kernel, hipFuncAttributeMaxDynamicSharedMemorySize, LDSB);
        hipOccupancyMaxActiveBlocksPerMultiprocessor(&per, (const void*)fwd_kernel, 512, LDSB);
        (void)hipGetLastError();
        grid = cus;
        if (per < 1) fprintf(stderr, "kernel_launch: occupancy query reports %d blocks/CU\n", per);
    }
    if (grid < 0) return;
    Args a{};
    for (int i = 0; i < 20; ++i) a.in[i] = (const float*)d_in[i];
    a.out = (float*)d_out; a.ws = (unsigned char*)d_ws;
    void* kargs[] = {&a};
    hipError_t e = hipLaunchCooperativeKernel((const void*)fwd_kernel, dim3(grid), dim3(512), kargs, LDSB, stream);
    if (e != hipSuccess) fprintf(stderr, "cooperative launch failed: %s (grid %d)\n", hipGetErrorString(e), grid);
}
```

```cpp
#include <hip/hip_runtime.h>
#include <hip/hip_cooperative_groups.h>
#include <cstdio>
#include <cstdint>
namespace cg = cooperative_groups;
namespace pg8 {
#define PG8_LAS __attribute__((address_space(3)))
typedef unsigned short bf16_t;
typedef short bf16x8 __attribute__((ext_vector_type(8)));
typedef float f32x4 __attribute__((ext_vector_type(4)));
typedef unsigned u32x4 __attribute__((ext_vector_type(4)));
constexpr int BM = 256, BK = 64, HALF = 128, HTB = HALF * BK * 2  , STAGE_BYTES = 8 * HTB, NXCD = 8, WGM = 8;

__host__ __device__ __forceinline__ int lds_byte(int r, int c) { const int st = (r >> 4) * 2 + (c >> 5), rr = r & 15, cc = c & 31, ob = rr * 64 + cc * 2; return st * 1024 + (ob ^ (((ob >> 9) & 1) << 5)); }
__host__ __device__ __forceinline__ void stage_rc(int b, int& R, int& C) { const int st = b / 1024, sb = b % 1024, swz = sb ^ (((sb >> 9) & 1) << 5); R = (st >> 1) * 16 + swz / 64; C = (st & 1) * 32 + (swz % 64) / 2; }
__host__ __device__ __forceinline__ int perm32(int rho) { const int n = rho >> 4, i = rho & 15; return 8 * (i >> 2) + 4 * n + (i & 3); }

struct Unit { int pm, pn; };
struct Gemm { const bf16_t* A; const bf16_t* Bt; int M, N, K; int a_w1, a_h, a_t; };

struct StaticOrder {
    int nM, nN, nwg, G, c;
    __host__ __device__ void init(int M, int N, int G_, int c_) { nM = M / BM; nN = N / BM; nwg = nM * nN; G = G_; c = c_; }
    __host__ __device__ bool next(int i, Unit& u) const {
        const long L = (long)i * G + c; if (L >= nwg) return false;
        int wgid = (int)L; { const int q = nwg / NXCD, r = nwg % NXCD, xcd = wgid % NXCD, off = wgid / NXCD; wgid = (xcd < r ? xcd * (q + 1) : r * (q + 1) + (xcd - r) * q) + off; }
        const int nig = WGM * nN, gid = wgid / nig, fm = gid * WGM, gsz = (nM - fm) < WGM ? (nM - fm) : WGM;
        u.pm = fm + ((wgid % nig) % gsz); u.pn = (wgid % nig) / gsz; return true;
    }
    __device__ __forceinline__ void a_ready(const Unit&) const {}
    __device__ __forceinline__ void done(const Unit&) const {}
};

typedef unsigned u32x2 __attribute__((ext_vector_type(2)));
__device__ __forceinline__ unsigned cvt_pk_bf16(float lo, float hi) { unsigned r; asm volatile("v_cvt_pk_bf16_f32 %0, %1, %2" : "=v"(r) : "v"(lo), "v"(hi)); return r; }
__device__ __forceinline__ void store4(bf16_t* p, f32x4 v) { u32x2 w; w.x = cvt_pk_bf16(v[0], v[1]); w.y = cvt_pk_bf16(v[2], v[3]); *(u32x2*)p = w; }
__device__ __forceinline__ void store8(bf16_t* p, f32x4 a, f32x4 b) { u32x4 w; w.x = cvt_pk_bf16(a[0], a[1]); w.y = cvt_pk_bf16(a[2], a[3]); w.z = cvt_pk_bf16(b[0], b[1]); w.w = cvt_pk_bf16(b[2], b[3]); *(u32x4*)p = w; }
__device__ __forceinline__ float rstd_of(const float* ssq, int row) { return rsqrtf(ssq[row] * (1.0f / 1024.0f) + 1e-6f); }
constexpr int SEQ = 16384;

struct EpiQKV0 {
    static constexpr bool PERM = false, AFTER_DRAIN = false;
    bf16_t* Q; size_t tstride; const float* ssq; const float* ropec; const float* ropes; float* kpart;
    __device__ __forceinline__ void operator()(const f32x4 (&acc)[2][2][4][2], const Unit& u, int wr, int wc, int fr, int fq) const {
        const int t = u.pn >> 2, pq = u.pn & 3;
        bf16_t* base = Q + (size_t)t * tstride;
        const bool rope = (t < 2) && (pq >= 2);
#pragma unroll
        for (int ai = 0; ai < 2; ++ai) {
            f32x4 ks00 = (f32x4){0.f, 0.f, 0.f, 0.f}, ks01 = ks00, ks10 = ks00, ks11 = ks00;
#pragma unroll
            for (int m = 0; m < 4; ++m) {
                const int row = u.pm * 256 + ai * 128 + wr * 64 + m * 16 + fr;
                const float rs = rstd_of(ssq, row);
#pragma unroll
                for (int bj = 0; bj < 2; ++bj) {
                    const int hcol = pq * 256 + bj * 128 + (wc >> 1) * 64;
                    const f32x4 v0 = acc[ai][bj][m][0] * rs, v1 = acc[ai][bj][m][1] * rs;
                    bf16_t* rp = base + (size_t)row * 1024 + hcol;
                    if (rope) {
                        const int i0 = 16 * (wc & 1) + 4 * fq;
                        const f32x4 c = *(const f32x4*)(ropec + (size_t)row * 32 + i0), s = *(const f32x4*)(ropes + (size_t)row * 32 + i0);
                        const f32x4 o1 = v0 * c - v1 * s, o2 = v1 * c + v0 * s;
                        store4(rp + i0, o1); store4(rp + 32 + i0, o2);
                        if (bj == 0) { ks00 += o1; ks01 += o2; } else { ks10 += o1; ks11 += o2; }
                    } else {
                        const int d0 = 32 * (wc & 1) + 4 * fq;
                        store4(rp + d0, v0); store4(rp + d0 + 16, v1);
                    }
                }
            }
            if (rope && t == 1) {
#define KSRED(s_, bj_, n_) do { f32x4 s = s_; _Pragma("unroll") for (int o = 1; o < 16; o <<= 1) { s[0] += __shfl_xor(s[0], o); s[1] += __shfl_xor(s[1], o); s[2] += __shfl_xor(s[2], o); s[3] += __shfl_xor(s[3], o); } \
                if (fr == 0) { const int h8 = (pq - 2) * 4 + (bj_) * 2 + (wc >> 1); *(f32x4*)(kpart + (((size_t)h8 * 64 + u.pm) * 4 + ai * 2 + wr) * 64 + 32 * (n_) + 16 * (wc & 1) + 4 * fq) = s; } } while (0)
                KSRED(ks00, 0, 0); KSRED(ks01, 0, 1); KSRED(ks10, 1, 0); KSRED(ks11, 1, 1);
#undef KSRED
            }
        }
    }
};

struct EpiBf {
    static constexpr bool PERM = true, AFTER_DRAIN = false;
    bf16_t* O; int ldc; const float* ssq; int split_tiles; size_t split_stride; float* logf; const float* bfg; unsigned* kmx;
    __device__ __forceinline__ void operator()(const f32x4 (&acc)[2][2][4][2], const Unit& u, int wr, int wc, int fr, int fq) const {
        int pn = u.pn; bf16_t* base = O; int t = 0;
        if (split_tiles) { t = pn / split_tiles; pn -= t * split_tiles; base += (size_t)t * split_stride; }
        if (logf && t == 3) {
            if (wc == 0 && fq < 2) {
#pragma unroll
                for (int ai = 0; ai < 2; ++ai)
#pragma unroll
                    for (int m = 0; m < 4; ++m) { const int row = u.pm * 256 + ai * 128 + wr * 64 + m * 16 + fr; const float rs = rstd_of(ssq, row);
#pragma unroll
                        for (int n = 0; n < 2; ++n)
#pragma unroll
                            for (int j = 0; j < 4; ++j) { const int h = 8 * fq + 4 * n + j; const float x = acc[ai][0][m][n][j] * rs + bfg[h];
                                logf[(size_t)h * SEQ + row] = fminf(x, 0.f) - log1pf(expf(-fabsf(x))); } }
            }
            return;
        }
        const bool domax = (kmx != nullptr) && (t == 1);
        float mx0 = 0.f, mx1 = 0.f;
#pragma unroll
        for (int ai = 0; ai < 2; ++ai)
#pragma unroll
            for (int m = 0; m < 4; ++m) { const int row = u.pm * 256 + ai * 128 + wr * 64 + m * 16 + fr; const float rs = ssq ? rstd_of(ssq, row) : 1.0f;
                bf16_t* rp = base + (size_t)row * ldc + pn * 256 + wc * 32 + 8 * fq;
#pragma unroll
                for (int bj = 0; bj < 2; ++bj) { const f32x4 v0 = acc[ai][bj][m][0] * rs, v1 = acc[ai][bj][m][1] * rs; store8(rp + bj * 128, v0, v1);
                    if (domax) { float q = (v0[0] * v0[0] + v0[1] * v0[1]) + (v0[2] * v0[2] + v0[3] * v0[3]) + (v1[0] * v1[0] + v1[1] * v1[1]) + (v1[2] * v1[2] + v1[3] * v1[3]);
                        q += __shfl_xor(q, 16); q += __shfl_xor(q, 32); if (bj == 0) mx0 = fmaxf(mx0, q); else mx1 = fmaxf(mx1, q); } }
            }
        if (domax) {
#pragma unroll
            for (int o = 1; o < 16; o <<= 1) { mx0 = fmaxf(mx0, __shfl_xor(mx0, o)); mx1 = fmaxf(mx1, __shfl_xor(mx1, o)); }
            if (fr == 0 && fq == 0) { const int h0 = pn * 4 + (wc >> 1);
                atomicMax(kmx + (h0 * 2 + (wc & 1)), __float_as_uint(mx0)); atomicMax(kmx + ((h0 + 2) * 2 + (wc & 1)), __float_as_uint(mx1)); }
        }
    }
};

struct EpiRes {
    static constexpr bool PERM = false, AFTER_DRAIN = false;
    const float* Hin; float* Hout; bf16_t* XB; float* ssq; float sc;
    __device__ __forceinline__ void operator()(const f32x4 (&acc)[2][2][4][2], const Unit& u, int wr, int wc, int fr, int fq) const {
#pragma unroll
        for (int ai = 0; ai < 2; ++ai)
#pragma unroll
            for (int m = 0; m < 4; ++m) { const int row = u.pm * 256 + ai * 128 + wr * 64 + m * 16 + fr; float sq = 0.f;
                const size_t off = (size_t)row * 1024 + u.pn * 256 + wc * 32 + 4 * fq;
#pragma unroll
                for (int bj = 0; bj < 2; ++bj)
#pragma unroll
                    for (int n = 0; n < 2; ++n) { const size_t o = off + bj * 128 + n * 16; const f32x4 h = *(const f32x4*)(Hin + o) + acc[ai][bj][m][n] * sc;
                        *(f32x4*)(Hout + o) = h; if (XB) store4(XB + o, h); sq += (h[0] * h[0] + h[1] * h[1]) + (h[2] * h[2] + h[3] * h[3]); }
                sq += __shfl_xor(sq, 16); sq += __shfl_xor(sq, 32);
                if (fq == 0) __hip_atomic_fetch_add(ssq + row, sq, __ATOMIC_RELAXED, __HIP_MEMORY_SCOPE_AGENT);
            }
    }
};

__device__ __forceinline__ float dpp_ror1(float x) { float r; asm volatile("s_nop 1\n\tv_mov_b32_dpp %0, %1 row_ror:1 row_mask:0xf bank_mask:0xf" : "=v"(r) : "v"(x)); return r; }
__device__ __forceinline__ float dpp_ror2(float x) { float r; asm volatile("s_nop 1\n\tv_mov_b32_dpp %0, %1 row_ror:2 row_mask:0xf bank_mask:0xf" : "=v"(r) : "v"(x)); return r; }
struct EpiUpConv {
    static constexpr bool PERM = true, AFTER_DRAIN = false;
    bf16_t* ACT; const float* ssq; const float* cw; const float* cb;
    __device__ __forceinline__ void operator()(const f32x4 (&acc)[2][2][4][2], const Unit& u, int wr, int wc, int fr, int fq) const {
        const int g0 = 252 * u.pm - 2 + 126 * wr + fr;
        float rs[8];
#pragma unroll
        for (int q = 0; q < 8; ++q) { int r = g0 + 16 * q; r = r < 0 ? 0 : (r > SEQ - 1 ? SEQ - 1 : r); rs[q] = rstd_of(ssq, r); }
#pragma unroll
        for (int n = 0; n < 2; ++n) {
            const int col = 128 * u.pn + 32 * wc + 8 * fq + 4 * n;
            const f32x4 wg0 = *(const f32x4*)(cw + col), wg1 = *(const f32x4*)(cw + 5632 + col), wg2 = *(const f32x4*)(cw + 2 * 5632 + col), bg = *(const f32x4*)(cb + col);
            const f32x4 wv0 = *(const f32x4*)(cw + 2816 + col), wv1 = *(const f32x4*)(cw + 5632 + 2816 + col), wv2 = *(const f32x4*)(cw + 2 * 5632 + 2816 + col), bv = *(const f32x4*)(cb + 2816 + col);
            f32x4 pg = (f32x4){0.f, 0.f, 0.f, 0.f}, pv = (f32x4){0.f, 0.f, 0.f, 0.f};
#pragma unroll
            for (int q = 0; q < 8; ++q) {
                const f32x4 ug = acc[q >> 2][0][q & 3][n] * rs[q], uv = acc[q >> 2][1][q & 3][n] * rs[q];
                f32x4 res;
#pragma unroll
                for (int j = 0; j < 4; ++j) {
                    const float ga1 = dpp_ror1(ug[j]), gb1 = dpp_ror1(pg[j]), ga2 = dpp_ror2(ug[j]), gb2 = dpp_ror2(pg[j]);
                    const float va1 = dpp_ror1(uv[j]), vb1 = dpp_ror1(pv[j]), va2 = dpp_ror2(uv[j]), vb2 = dpp_ror2(pv[j]);
                    const float g1 = fr >= 1 ? ga1 : gb1, g2 = fr >= 2 ? ga2 : gb2, v1 = fr >= 1 ? va1 : vb1, v2 = fr >= 2 ? va2 : vb2;
                    const float cgv = bg[j] + wg0[j] * g2 + wg1[j] * g1 + wg2[j] * ug[j];
                    const float cvv = bv[j] + wv0[j] * v2 + wv1[j] * v1 + wv2[j] * uv[j];
                    res[j] = cgv * __builtin_amdgcn_rcpf(1.0f + __builtin_amdgcn_exp2f(-1.44269504f * cgv)) * cvv;
                }
                pg = ug; pv = uv;
                const int row = g0 + 16 * q;
                if ((q > 0 || fr >= 2) && row < SEQ) store4(ACT + (size_t)row * 2816 + col, res);
            }
        }
    }
};
template <class Epi, class Sched, bool ALIGN_EPI = false, bool SP2 = false>
__device__ __forceinline__ void gemm_phase(PG8_LAS unsigned char* lds, const Gemm g, const Sched& S, const Epi& E) {
    int tid_ = threadIdx.x; asm volatile("" : "+v"(tid_)); const int tid = tid_, wid = __builtin_amdgcn_readfirstlane(tid >> 6), lane = tid & 63, wr = wid >> 2, wc = wid & 3, fr = lane & 15, fq = lane >> 4;
    const int K = g.K, nt = K / BK;
    unsigned voffA[2], voffB[2];
#pragma unroll
    for (int i = 0; i < 2; ++i) { int R, C; stage_rc(tid * 16 + i * 8192, R, C); const int Rb = Epi::PERM ? ((R & ~31) + perm32(R & 31)) : R;
        voffA[i] = (unsigned)(((R >= 64 ? g.a_w1 : 0) + (R & 63)) * K + C) * 2u; voffB[i] = (unsigned)(Rb * K + C) * 2u; }
    const size_t kstep = (size_t)(BK * 2);
    const size_t hstep = (size_t)HALF * K * 2;
    const size_t tstep = 2 * hstep; const size_t hstepA = (size_t)g.a_h * K * 2, tstepA = (size_t)g.a_t * K * 2;
    const unsigned ldsw = (unsigned)wid * 1024u;
    const int aoff = lds_byte(wr * 64 + fr, fq * 8), boff = lds_byte(wc * 32 + fr, fq * 8);
#define PG8_SA(b, h) (((b) * 2 + (h)) * HTB)
#define PG8_SB(b, h) ((4 + (b) * 2 + (h)) * HTB)
#define PG8_STAGE(bufoff, gbase, voff) do { _Pragma("unroll") for (int _i = 0; _i < 2; ++_i) \
        __builtin_amdgcn_global_load_lds((const unsigned*)((const char*)(gbase) + (voff)[_i]), (PG8_LAS unsigned*)(lds + (bufoff) + ldsw + _i * 8192), 16, 0, 0); } while (0)
#define PG8_LDA(dst, b, h) do { _Pragma("unroll") for (int m = 0; m < 4; ++m) _Pragma("unroll") for (int k = 0; k < 2; ++k) dst[m][k] = *(const PG8_LAS bf16x8*)(lds + PG8_SA(b, h) + aoff + m * 2048 + k * 1024); } while (0)
#define PG8_LDB(dst, b, h) do { _Pragma("unroll") for (int n = 0; n < 2; ++n) _Pragma("unroll") for (int k = 0; k < 2; ++k) dst[n][k] = *(const PG8_LAS bf16x8*)(lds + PG8_SB(b, h) + boff + n * 2048 + k * 1024); } while (0)
#define PG8_MMA(ai, bj, At, Bt) do { __builtin_amdgcn_s_setprio(1); _Pragma("unroll") for (int m = 0; m < 4; ++m) _Pragma("unroll") for (int n = 0; n < 2; ++n) _Pragma("unroll") for (int k = 0; k < 2; ++k) \
        acc[ai][bj][m][n] = __builtin_amdgcn_mfma_f32_16x16x32_bf16(Bt[n][k], At[m][k], acc[ai][bj][m][n], 0, 0, 0); __builtin_amdgcn_s_setprio(0); } while (0)
#define PG8_WAIT_V(n) asm volatile("s_waitcnt vmcnt(" #n ")" ::: "memory")
#define PG8_WAIT_L(n) asm volatile("s_waitcnt lgkmcnt(" #n ")" ::: "memory")
#define PG8_BAR __builtin_amdgcn_s_barrier()
#define PG8_SCHED __builtin_amdgcn_sched_barrier(0)
    Unit cur, nxt; int ui = 0;
    if (!S.next(0, cur)) return;
    f32x4 acc[2][2][4][2];
#pragma unroll
    for (int a = 0; a < 2; ++a)
#pragma unroll
        for (int b = 0; b < 2; ++b)
#pragma unroll
            for (int m = 0; m < 4; ++m)
#pragma unroll
                for (int n = 0; n < 2; ++n) acc[a][b][m][n] = (f32x4){0.f, 0.f, 0.f, 0.f};
    bf16x8 At[4][2], B0[2][2], B1[2][2];
    const char* cA = (const char*)g.A + (size_t)cur.pm * tstepA; const char* cB = (const char*)g.Bt + (size_t)cur.pn * tstep;
    S.a_ready(cur);
    if constexpr (SP2) {
        PG8_STAGE(PG8_SB(0, 0), cB, voffB); PG8_STAGE(PG8_SB(0, 1), cB + hstep, voffB); PG8_STAGE(PG8_SA(0, 0), cA, voffA); PG8_STAGE(PG8_SA(0, 1), cA + hstepA, voffA);
        if (wr == 1) PG8_BAR;
        PG8_WAIT_V(2); PG8_BAR;
        PG8_STAGE(PG8_SB(1, 0), cB + kstep, voffB); PG8_STAGE(PG8_SA(1, 0), cA + kstep, voffA); PG8_STAGE(PG8_SB(1, 1), cB + hstep + kstep, voffB);
        PG8_WAIT_V(6); PG8_BAR;
    } else {
        PG8_STAGE(PG8_SB(0, 0), cB, voffB); PG8_STAGE(PG8_SA(0, 0), cA, voffA); PG8_STAGE(PG8_SB(0, 1), cB + hstep, voffB); PG8_STAGE(PG8_SA(0, 1), cA + hstepA, voffA);
        if (wr == 1) PG8_BAR;
        PG8_WAIT_V(4); PG8_BAR;
        PG8_STAGE(PG8_SB(1, 0), cB + kstep, voffB); PG8_STAGE(PG8_SA(1, 0), cA + kstep, voffA); PG8_STAGE(PG8_SB(1, 1), cB + hstep + kstep, voffB);
        PG8_WAIT_V(6); PG8_BAR;
    }
    for (;;) {
        const bool has_next = S.next(ui + 1, nxt);
        const char* nA = has_next ? (const char*)g.A + (size_t)nxt.pm * tstepA : cA; const char* nB = has_next ? (const char*)g.Bt + (size_t)nxt.pn * tstep : cB;
        for (int t = 0; t < nt; t += 2) {
            const bool last = (t == nt - 2);
            const char* a1 = cA + (size_t)(t + 1) * kstep;
            const char* a2 = last ? nA : cA + (size_t)(t + 2) * kstep; const char* b2 = last ? nB : cB + (size_t)(t + 2) * kstep;
            const char* a3 = a2 + kstep; const char* b3 = b2 + kstep;
            if (last && has_next) S.a_ready(nxt);
            if constexpr (SP2) {
            PG8_LDB(B0, 0, 0); PG8_LDB(B1, 0, 1); PG8_SCHED; PG8_LDA(At, 0, 0); PG8_STAGE(PG8_SA(1, 1), a1 + hstepA, voffA);
            PG8_WAIT_V(8); PG8_WAIT_L(0); PG8_BAR; PG8_MMA(0, 0, At, B0); PG8_MMA(0, 1, At, B1); PG8_BAR; PG8_SCHED;
            PG8_LDA(At, 0, 1); PG8_STAGE(PG8_SB(0, 0), b2, voffB); PG8_STAGE(PG8_SB(0, 1), b2 + hstep, voffB); PG8_STAGE(PG8_SA(0, 0), a2, voffA);
            PG8_WAIT_V(8); PG8_WAIT_L(0); PG8_BAR; PG8_MMA(1, 0, At, B0); PG8_MMA(1, 1, At, B1); PG8_BAR; PG8_SCHED;
            PG8_LDB(B0, 1, 0); PG8_LDB(B1, 1, 1); PG8_SCHED; PG8_LDA(At, 1, 0); PG8_STAGE(PG8_SA(0, 1), a2 + hstepA, voffA);
            PG8_WAIT_V(8); PG8_WAIT_L(0); PG8_BAR; PG8_MMA(0, 0, At, B0); PG8_MMA(0, 1, At, B1); PG8_BAR; PG8_SCHED;
            PG8_LDA(At, 1, 1); PG8_STAGE(PG8_SB(1, 0), b3, voffB); PG8_STAGE(PG8_SB(1, 1), b3 + hstep, voffB); PG8_STAGE(PG8_SA(1, 0), a3, voffA);
            PG8_WAIT_V(8); PG8_WAIT_L(0); PG8_BAR; PG8_MMA(1, 0, At, B0); PG8_MMA(1, 1, At, B1); PG8_BAR; PG8_SCHED;
            } else {
            PG8_LDB(B0, 0, 0); PG8_SCHED; PG8_LDA(At, 0, 0); PG8_STAGE(PG8_SA(1, 1), a1 + hstepA, voffA);
            PG8_WAIT_L(8); PG8_BAR; PG8_WAIT_L(0); PG8_MMA(0, 0, At, B0); PG8_BAR; PG8_SCHED;
            PG8_LDB(B1, 0, 1); PG8_STAGE(PG8_SB(0, 0), b2, voffB);
            PG8_BAR; PG8_WAIT_L(0); PG8_MMA(0, 1, At, B1); PG8_BAR;
            PG8_LDA(At, 0, 1); PG8_STAGE(PG8_SA(0, 0), a2, voffA);
            PG8_BAR; PG8_WAIT_L(0); PG8_MMA(1, 0, At, B0); PG8_BAR; PG8_SCHED;
            PG8_STAGE(PG8_SB(0, 1), b2 + hstep, voffB);
            PG8_WAIT_V(6); PG8_BAR; PG8_MMA(1, 1, At, B1); PG8_BAR;
            PG8_LDB(B0, 1, 0); PG8_SCHED; PG8_LDA(At, 1, 0); PG8_STAGE(PG8_SA(0, 1), a2 + hstepA, voffA);
            PG8_WAIT_L(8); PG8_BAR; PG8_WAIT_L(0); PG8_MMA(0, 0, At, B0); PG8_BAR; PG8_SCHED;
            PG8_LDB(B1, 1, 1); PG8_STAGE(PG8_SB(1, 0), b3, voffB);
            PG8_BAR; PG8_WAIT_L(0); PG8_MMA(0, 1, At, B1); PG8_BAR;
            PG8_LDA(At, 1, 1); PG8_STAGE(PG8_SA(1, 0), a3, voffA);
            PG8_BAR; PG8_WAIT_L(0); PG8_MMA(1, 0, At, B0); PG8_BAR; PG8_SCHED;
            PG8_STAGE(PG8_SB(1, 1), b3 + hstep, voffB);
            PG8_WAIT_V(6); PG8_BAR; PG8_MMA(1, 1, At, B1); PG8_BAR;
            }
        }
        if constexpr (ALIGN_EPI) { if (wr == 0) PG8_BAR; }
        if constexpr (!Epi::AFTER_DRAIN) { E(acc, cur, wr, wc, fr, fq); S.done(cur); }
        if (!has_next) break;
#pragma unroll
        for (int a = 0; a < 2; ++a)
#pragma unroll
            for (int b = 0; b < 2; ++b)
#pragma unroll
                for (int m = 0; m < 4; ++m)
#pragma unroll
                    for (int n = 0; n < 2; ++n) acc[a][b][m][n] = (f32x4){0.f, 0.f, 0.f, 0.f};
        cur = nxt; cA = nA; cB = nB; ++ui;
        if constexpr (ALIGN_EPI) { if (wr == 1) PG8_BAR; }
    }
    PG8_WAIT_V(0);
    if constexpr (!ALIGN_EPI) { if (wr == 0) PG8_BAR; }
    PG8_BAR;
    if constexpr (Epi::AFTER_DRAIN) { E.fused(acc, cur, wr, wc, fr, fq, lds, wid, lane); S.done(cur); }
#undef PG8_SA
#undef PG8_SB
#undef PG8_STAGE
#undef PG8_LDA
#undef PG8_LDB
#undef PG8_MMA
#undef PG8_WAIT_V
#undef PG8_WAIT_L
#undef PG8_BAR
#undef PG8_SCHED
}
}
namespace att {
#define LAS __attribute__((address_space(3)))
using pg8::bf16_t; using pg8::bf16x8; using pg8::f32x4; using pg8::u32x4; using pg8::SEQ;
typedef float f32x16 __attribute__((ext_vector_type(16)));
constexpr int KB_BYTES = 8192, VT_STRIDE = 144, VT_BYTES = 64 * VT_STRIDE, BUF_BYTES = KB_BYTES + VT_BYTES + 256;
constexpr int VOTE_OFF = 3 * BUF_BYTES, KM_OFF = 57344;
constexpr float LOG2E = 1.4426950408889634f, C2 = 0.125f * 1.4426950408889634f;
enum { M_SB = 0, M_MOBA = 1, M_FOX = 2, M_XA = 3 };
__device__ __forceinline__ bf16x8 pack8(const f32x16& p, int b) {
    u32x4 w; w.x = pg8::cvt_pk_bf16(p[b + 0], p[b + 1]); w.y = pg8::cvt_pk_bf16(p[b + 2], p[b + 3]); w.z = pg8::cvt_pk_bf16(p[b + 4], p[b + 5]); w.w = pg8::cvt_pk_bf16(p[b + 6], p[b + 7]);
    return __builtin_bit_cast(bf16x8, w);
}
__device__ __forceinline__ float bf2f(short s) { return __uint_as_float(((unsigned)(unsigned short)s) << 16); }

struct AttnArgs { const bf16_t* Q; int ldq; const bf16_t* K; const bf16_t* V; int ldkv; bf16_t* O; int ldo; const float* cf; float kmax2; const float* kpart; int* sel; float* lse; };

template <int MODE>
__device__ __forceinline__ void attn_unit(LAS unsigned char* lds, const AttnArgs& A, int qb) {
    int tid_ = threadIdx.x; asm volatile("" : "+v"(tid_)); const int tid = tid_, lane = tid & 63, wid = __builtin_amdgcn_readfirstlane(tid >> 6), r32 = lane & 31, hi = lane >> 5;
    const int q0 = qb * 256, w0 = q0 + wid * 32, row = w0 + r32;
    bf16x8 qr[4];
#pragma unroll
    for (int d0 = 0; d0 < 4; ++d0) qr[d0] = *(const bf16x8*)(A.Q + (size_t)row * A.ldq + d0 * 16 + hi * 8);
    int i1 = -1, i2 = -1, i3 = -1; unsigned long long wmask = 0ull;
    if (MODE == M_MOBA) {
        const int own = qb;
        LAS float* km = (LAS float*)(lds + KM_OFF);
        {
            float kp_[8][4];
#pragma unroll
            for (int k = 0; k < 8; ++k) { const int idx = tid + 512 * k; const bool ok = idx < own * 64; const float* p = A.kpart + (size_t)((ok ? idx : 0) >> 6) * 256 + (idx & 63);
                kp_[k][0] = p[0]; kp_[k][1] = p[64]; kp_[k][2] = p[128]; kp_[k][3] = p[192]; }
#pragma unroll
            for (int k = 0; k < 8; ++k) { const int idx = tid + 512 * k; if (idx < own * 64) km[idx] = ((kp_[k][0] + kp_[k][1]) + (kp_[k][2] + kp_[k][3])) * (1.0f / 256.0f); }
        }
        __syncthreads();
        float qf[32];
#pragma unroll
        for (int d0 = 0; d0 < 4; ++d0)
#pragma unroll
            for (int e = 0; e < 8; ++e) qf[d0 * 8 + e] = bf2f(qr[d0][e]);
        float v1 = -INFINITY, v2 = -INFINITY, v3 = -INFINITY;
#pragma unroll 4
        for (int j = 0; j < own; ++j) {
            float g = 0.f;
#pragma unroll
            for (int d0 = 0; d0 < 4; ++d0) { const f32x4 a = *(const LAS f32x4*)(km + j * 64 + d0 * 16 + hi * 8), b = *(const LAS f32x4*)(km + j * 64 + d0 * 16 + hi * 8 + 4);
                g += (qf[d0 * 8 + 0] * a[0] + qf[d0 * 8 + 1] * a[1]) + (qf[d0 * 8 + 2] * a[2] + qf[d0 * 8 + 3] * a[3]) + (qf[d0 * 8 + 4] * b[0] + qf[d0 * 8 + 5] * b[1]) + (qf[d0 * 8 + 6] * b[2] + qf[d0 * 8 + 7] * b[3]); }
            const float go = __shfl_xor(g, 32); g = hi ? (go + g) : (g + go);
            if (g > v1) { v3 = v2; i3 = i2; v2 = v1; i2 = i1; v1 = g; i1 = j; } else if (g > v2) { v3 = v2; i3 = i2; v2 = g; i2 = j; } else if (g > v3) { v3 = g; i3 = j; }
        }
        if (hi == 0) { typedef int i32x4 __attribute__((ext_vector_type(4))); *(i32x4*)(A.sel + (size_t)row * 4) = (i32x4){i1, i2, i3, 0}; }
    }
    float qb2 = 0.f, cq2 = 0.f;
    if (MODE == M_FOX) {
        float s = 0.f;
#pragma unroll
        for (int d0 = 0; d0 < 4; ++d0)
#pragma unroll
            for (int e = 0; e < 8; ++e) { const float x = bf2f(qr[d0][e]); s += x * x; }
        s += __shfl_xor(s, 32);
        qb2 = sqrtf(s * A.kmax2) * C2 * 1.01f;
        cq2 = A.cf[row] * LOG2E;
    }
    const int NT = (MODE == M_XA || MODE == M_MOBA) ? 4 : (q0 / 64 + 4);
    f32x16 o0, o1;
#pragma unroll
    for (int r = 0; r < 16; ++r) { o0[r] = 0.f; o1[r] = 0.f; }
    float m_run = -1e30f, l_run = 0.f, T = 0.f;
    u32x4 k1 = (u32x4){0u, 0u, 0u, 0u}, v1 = k1, k2 = k1, v2 = k1, k3 = k1, v3 = k1; float c1 = 0.f, c2 = 0.f, c3 = 0.f;
#define KEY0(i) ((MODE == M_XA) ? 64 * (i) : (MODE == M_MOBA) ? ((i) < 4 ? q0 + 64 * (i) : 256 * (((i) - 4) >> 2) + 64 * (((i) - 4) & 3)) : (q0 + 192 - 64 * (i)))
#define LOADT(i, kreg, vreg, creg) do { const int k0_ = KEY0(i); kreg = *(const u32x4*)(A.K + (size_t)(k0_ + lane) * A.ldkv + wid * 8); vreg = *(const u32x4*)(A.V + (size_t)(k0_ + lane) * A.ldkv + wid * 8); \
        if (MODE == M_FOX) { if (tid < 64) creg = A.cf[k0_ + tid] * LOG2E; } } while (0)
#define STORET(b, kreg, vreg, creg) do { LAS unsigned char* bb_ = lds + (b) * BUF_BYTES; *(LAS u32x4*)(bb_ + wid * 1024 + lane * 16) = kreg; \
        LAS unsigned short* vt_ = (LAS unsigned short*)(bb_ + KB_BYTES + (8 * wid) * VT_STRIDE + lane * 2); \
        vt_[0 * 72] = (unsigned short)(vreg.x & 0xffffu); vt_[1 * 72] = (unsigned short)(vreg.x >> 16); vt_[2 * 72] = (unsigned short)(vreg.y & 0xffffu); vt_[3 * 72] = (unsigned short)(vreg.y >> 16); \
        vt_[4 * 72] = (unsigned short)(vreg.z & 0xffffu); vt_[5 * 72] = (unsigned short)(vreg.z >> 16); vt_[6 * 72] = (unsigned short)(vreg.w & 0xffffu); vt_[7 * 72] = (unsigned short)(vreg.w >> 16); \
        if (MODE == M_FOX) { if (tid < 64) ((LAS float*)(bb_ + KB_BYTES + VT_BYTES))[tid] = creg; } } while (0)
    LOADT(0, k1, v1, c1); if (NT > 1) LOADT(1, k2, v2, c2); if (NT > 2) LOADT(2, k3, v3, c3);
    STORET(0, k1, v1, c1);
    __syncthreads();
    const int kperm = (r32 & ~15) | (r32 & 3) | ((r32 & 4) << 1) | ((r32 & 8) >> 1);
    bool prev_active = false; int prevbuf = 0; bf16x8 pkP0 = (bf16x8){0, 0, 0, 0, 0, 0, 0, 0}, pkP1 = pkP0, pkP2 = pkP0, pkP3 = pkP0;
    for (int i0 = 0; i0 < NT; i0 += 3) {
        { const int i = i0 + 0; if (i >= NT) break;
        const int key0 = KEY0(i);
        if (i + 3 < NT) LOADT(i + 3, k1, v1, c1);
        LAS unsigned char* buf = lds + 0 * BUF_BYTES;
        bool active;
        if (MODE == M_XA) active = true;
        else if (MODE == M_MOBA) active = (i < 4) ? (key0 <= w0 + 31) : (((wmask >> ((i - 4) >> 2)) & 1ull) != 0ull);
        else active = key0 <= w0 + 31;
        if (active) {
            f32x16 p0, p1;
#pragma unroll
            for (int r = 0; r < 16; ++r) { p0[r] = 0.f; p1[r] = 0.f; }
            LAS unsigned char* kb = buf + kperm * 16 + hi * 1024;
#pragma unroll
            for (int d0 = 0; d0 < 4; ++d0) {
                const bf16x8 kf0 = *(const LAS bf16x8*)(kb + d0 * 2048), kf1 = *(const LAS bf16x8*)(kb + d0 * 2048 + 512);
                p0 = __builtin_amdgcn_mfma_f32_32x32x16_bf16(kf0, qr[d0], p0, 0, 0, 0);
                p1 = __builtin_amdgcn_mfma_f32_32x32x16_bf16(kf1, qr[d0], p1, 0, 0, 0);
            }
        if (prev_active) {
            const LAS unsigned char* vb = lds + prevbuf + KB_BYTES + r32 * VT_STRIDE + hi * 16;
#define PVS(s, pk) do { const bf16x8 a0_ = *(const LAS bf16x8*)(vb + (s) * 32), a1_ = *(const LAS bf16x8*)(vb + 32 * VT_STRIDE + (s) * 32); \
            o0 = __builtin_amdgcn_mfma_f32_32x32x16_bf16(a0_, pk, o0, 0, 0, 0); o1 = __builtin_amdgcn_mfma_f32_32x32x16_bf16(a1_, pk, o1, 0, 0, 0); } while (0)
            PVS(0, pkP0); PVS(1, pkP1); PVS(2, pkP2); PVS(3, pkP3);
#undef PVS
        }
            const int kl = key0 + 8 * hi;
            if (MODE == M_SB) {
                const bool nm = key0 + 63 >= w0;
                f32x16 L0, L1; float gt[4];
#pragma unroll
                for (int g = 0; g < 4; ++g) gt[g] = 0.f;
#pragma unroll
                for (int r = 0; r < 16; ++r) {
                    { const float z2 = p0[r] * C2; p0[r] = z2; float l1 = -(fmaxf(z2, 0.f) + __builtin_amdgcn_logf(1.0f + __builtin_amdgcn_exp2f(-fabsf(z2))));
                      if (nm && !(kl + 16 * (r >> 3) + (r & 7) < row)) l1 = 0.f; L0[r] = l1; gt[r >> 3] += l1; }
                    { const float z2 = p1[r] * C2; p1[r] = z2; float l1 = -(fmaxf(z2, 0.f) + __builtin_amdgcn_logf(1.0f + __builtin_amdgcn_exp2f(-fabsf(z2))));
                      if (nm && !(kl + 32 + 16 * (r >> 3) + (r & 7) < row)) l1 = 0.f; L1[r] = l1; gt[2 + (r >> 3)] += l1; }
                }
                float pt[4], after[4]; float run = 0.f;
#pragma unroll
                for (int g = 0; g < 4; ++g) pt[g] = __shfl_xor(gt[g], 32);
#pragma unroll
                for (int g = 3; g >= 0; --g) { after[g] = run + (hi ? 0.f : pt[g]); run += gt[g] + pt[g]; }
#pragma unroll
                for (int g8 = 1; g8 >= 0; --g8) {
                    float s0 = T + after[g8], s1 = T + after[2 + g8];
#pragma unroll
                    for (int e = 7; e >= 0; --e) { const int r = 8 * g8 + e;
                        { const bool valid = !nm || (kl + 16 * g8 + e < row); const float a = valid ? __builtin_amdgcn_exp2f(p0[r] + L0[r] + s0) : 0.f; s0 += L0[r]; p0[r] = a; }
                        { const bool valid = !nm || (kl + 32 + 16 * g8 + e < row); const float a = valid ? __builtin_amdgcn_exp2f(p1[r] + L1[r] + s1) : 0.f; s1 += L1[r]; p1[r] = a; } }
                }
                T += run;
            } else {
                const bool nm = (MODE == M_FOX) ? (key0 + 63 > w0) : ((MODE == M_MOBA) ? (i < 4 && key0 + 63 > w0) : false);
                bool rowsel = true;
                if (MODE == M_MOBA) { if (i >= 4) { const int j = (i - 4) >> 2; rowsel = (i1 == j) | (i2 == j) | (i3 == j); } }
                const LAS float* cl = (const LAS float*)(buf + KB_BYTES + VT_BYTES) + 8 * hi;
                float corr;
                if (nm) {
                    float mx = -INFINITY;
#pragma unroll
                    for (int r = 0; r < 16; ++r) {
                        float t0 = p0[r] * C2, t1 = p1[r] * C2;
                        if (MODE == M_FOX) { t0 += cq2 - cl[16 * (r >> 3) + (r & 7)]; t1 += cq2 - cl[32 + 16 * (r >> 3) + (r & 7)]; }
                        const int k_0 = kl + 16 * (r >> 3) + (r & 7);
                        t0 = (k_0 <= row) ? t0 : -INFINITY; t1 = (k_0 + 32 <= row) ? t1 : -INFINITY;
                        p0[r] = t0; p1[r] = t1; mx = fmaxf(mx, fmaxf(t0, t1));
                    }
                    mx = fmaxf(mx, __shfl_xor(mx, 32));
                    float m_new;
                    if (MODE == M_FOX) { m_run = fmaxf(m_run, mx); m_new = fminf(qb2, 48.0f); corr = 1.0f; }
                    else { m_new = fmaxf(m_run, mx); corr = __builtin_amdgcn_exp2f(m_run - m_new); m_run = m_new; }
                    float sum = 0.f;
#pragma unroll
                    for (int r = 0; r < 16; ++r) { const float e0 = __builtin_amdgcn_exp2f(p0[r] - m_new), e1 = __builtin_amdgcn_exp2f(p1[r] - m_new); sum += e0 + e1; p0[r] = e0; p1[r] = e1; }
                    l_run = l_run * corr + sum;
                } else {
                    if (MODE == M_FOX) {
                        typedef float f32x2 __attribute__((ext_vector_type(2)));
                        const float base = cq2 - fminf(qb2, 48.0f); const f32x2 basev = (f32x2){base, base}, c2v = (f32x2){C2, C2};
                        f32x2 sa = (f32x2){0.f, 0.f}, sb = (f32x2){0.f, 0.f};
#pragma unroll
                        for (int r = 0; r < 16; r += 2) {
                            const f32x2 ca = *(const LAS f32x2*)(cl + 16 * (r >> 3) + (r & 7)), cb = *(const LAS f32x2*)(cl + 32 + 16 * (r >> 3) + (r & 7));
                            const f32x2 ta = (f32x2){p0[r], p0[r + 1]} * c2v + (basev - ca), tb = (f32x2){p1[r], p1[r + 1]} * c2v + (basev - cb);
                            const f32x2 ea = (f32x2){__builtin_amdgcn_exp2f(ta.x), __builtin_amdgcn_exp2f(ta.y)}, eb = (f32x2){__builtin_amdgcn_exp2f(tb.x), __builtin_amdgcn_exp2f(tb.y)};
                            sa += ea; sb += eb; p0[r] = ea.x; p0[r + 1] = ea.y; p1[r] = eb.x; p1[r + 1] = eb.y;
                        }
                        corr = 1.0f; l_run += (sa.x + sa.y) + (sb.x + sb.y);
                    } else {
                    float mx = -INFINITY;
#pragma unroll
                    for (int r = 0; r < 16; ++r) mx = fmaxf(mx, fmaxf(p0[r], p1[r]));
                    mx *= C2;
                    if (MODE == M_MOBA) mx = rowsel ? mx : -INFINITY;
                    mx = fmaxf(mx, __shfl_xor(mx, 32));
                    const float m_new = fmaxf(m_run, mx); corr = __builtin_amdgcn_exp2f(m_run - m_new); m_run = m_new;
                    const float off = (MODE == M_MOBA && !rowsel) ? -INFINITY : -m_new;
                    float s0 = 0.f, s1 = 0.f;
#pragma unroll
                    for (int r = 0; r < 16; ++r) { const float e0 = __builtin_amdgcn_exp2f(fmaf(p0[r], C2, off)), e1 = __builtin_amdgcn_exp2f(fmaf(p1[r], C2, off)); s0 += e0; s1 += e1; p0[r] = e0; p1[r] = e1; }
                    l_run = l_run * corr + (s0 + s1);
                    }
                }
                if (__any(corr != 1.0f)) {
#pragma unroll
                    for (int r = 0; r < 16; ++r) { o0[r] *= corr; o1[r] *= corr; }
                }
            }
            pkP0 = pack8(p0, 0); pkP1 = pack8(p0, 8); pkP2 = pack8(p1, 0); pkP3 = pack8(p1, 8);
        } else {
        if (prev_active) {
            const LAS unsigned char* vb = lds + prevbuf + KB_BYTES + r32 * VT_STRIDE + hi * 16;
#define PVS(s, pk) do { const bf16x8 a0_ = *(const LAS bf16x8*)(vb + (s) * 32), a1_ = *(const LAS bf16x8*)(vb + 32 * VT_STRIDE + (s) * 32); \
            o0 = __builtin_amdgcn_mfma_f32_32x32x16_bf16(a0_, pk, o0, 0, 0, 0); o1 = __builtin_amdgcn_mfma_f32_32x32x16_bf16(a1_, pk, o1, 0, 0, 0); } while (0)
            PVS(0, pkP0); PVS(1, pkP1); PVS(2, pkP2); PVS(3, pkP3);
#undef PVS
        }
        }
        prev_active = active; prevbuf = 0 * BUF_BYTES;
        if (i + 1 < NT) STORET(1, k2, v2, c2);
        if (MODE == M_SB || MODE == M_FOX) {
            bool vote;
            if (MODE == M_SB) vote = __all(T < -151.0f) != 0;
            else { const float cn = (key0 > 0) ? A.cf[key0 - 1] * LOG2E : 0.f; vote = __all(qb2 + cq2 - cn < m_run - 151.0f) != 0; }
            if (lane == 0) ((LAS unsigned*)(lds + VOTE_OFF))[(i & 1) * 8 + wid] = (active && vote) ? 1u : 0u;
        }
        __syncthreads();
        if (MODE == M_SB || MODE == M_FOX) {
            const LAS unsigned* vv = (const LAS unsigned*)(lds + VOTE_OFF) + (i & 1) * 8;
            const unsigned all8 = (vv[0] & vv[1]) & (vv[2] & vv[3]) & (vv[4] & vv[5]) & (vv[6] & vv[7]);
            if (all8) break;
        }
        }
        { const int i = i0 + 1; if (i >= NT) break;
        const int key0 = KEY0(i);
        if (i + 3 < NT) LOADT(i + 3, k2, v2, c2);
        LAS unsigned char* buf = lds + 1 * BUF_BYTES;
        bool active;
        if (MODE == M_XA) active = true;
        else if (MODE == M_MOBA) active = (i < 4) ? (key0 <= w0 + 31) : (((wmask >> ((i - 4) >> 2)) & 1ull) != 0ull);
        else active = key0 <= w0 + 31;
        if (active) {
            f32x16 p0, p1;
#pragma unroll
            for (int r = 0; r < 16; ++r) { p0[r] = 0.f; p1[r] = 0.f; }
            LAS unsigned char* kb = buf + kperm * 16 + hi * 1024;
#pragma unroll
            for (int d0 = 0; d0 < 4; ++d0) {
                const bf16x8 kf0 = *(const LAS bf16x8*)(kb + d0 * 2048), kf1 = *(const LAS bf16x8*)(kb + d0 * 2048 + 512);
                p0 = __builtin_amdgcn_mfma_f32_32x32x16_bf16(kf0, qr[d0], p0, 0, 0, 0);
                p1 = __builtin_amdgcn_mfma_f32_32x32x16_bf16(kf1, qr[d0], p1, 0, 0, 0);
            }
        if (prev_active) {
            const LAS unsigned char* vb = lds + prevbuf + KB_BYTES + r32 * VT_STRIDE + hi * 16;
#define PVS(s, pk) do { const bf16x8 a0_ = *(const LAS bf16x8*)(vb + (s) * 32), a1_ = *(const LAS bf16x8*)(vb + 32 * VT_STRIDE + (s) * 32); \
            o0 = __builtin_amdgcn_mfma_f32_32x32x16_bf16(a0_, pk, o0, 0, 0, 0); o1 = __builtin_amdgcn_mfma_f32_32x32x16_bf16(a1_, pk, o1, 0, 0, 0); } while (0)
            PVS(0, pkP0); PVS(1, pkP1); PVS(2, pkP2); PVS(3, pkP3);
#undef PVS
        }
            const int kl = key0 + 8 * hi;
            if (MODE == M_SB) {
                const bool nm = key0 + 63 >= w0;
                f32x16 L0, L1; float gt[4];
#pragma unroll
                for (int g = 0; g < 4; ++g) gt[g] = 0.f;
#pragma unroll
                for (int r = 0; r < 16; ++r) {
                    { const float z2 = p0[r] * C2; p0[r] = z2; float l1 = -(fmaxf(z2, 0.f) + __builtin_amdgcn_logf(1.0f + __builtin_amdgcn_exp2f(-fabsf(z2))));
                      if (nm && !(kl + 16 * (r >> 3) + (r & 7) < row)) l1 = 0.f; L0[r] = l1; gt[r >> 3] += l1; }
                    { const float z2 = p1[r] * C2; p1[r] = z2; float l1 = -(fmaxf(z2, 0.f) + __builtin_amdgcn_logf(1.0f + __builtin_amdgcn_exp2f(-fabsf(z2))));
                      if (nm && !(kl + 32 + 16 * (r >> 3) + (r & 7) < row)) l1 = 0.f; L1[r] = l1; gt[2 + (r >> 3)] += l1; }
                }
                float pt[4], after[4]; float run = 0.f;
#pragma unroll
                for (int g = 0; g < 4; ++g) pt[g] = __shfl_xor(gt[g], 32);
#pragma unroll
                for (int g = 3; g >= 0; --g) { after[g] = run + (hi ? 0.f : pt[g]); run += gt[g] + pt[g]; }
#pragma unroll
                for (int g8 = 1; g8 >= 0; --g8) {
                    float s0 = T + after[g8], s1 = T + after[2 + g8];
#pragma unroll
                    for (int e = 7; e >= 0; --e) { const int r = 8 * g8 + e;
                        { const bool valid = !nm || (kl + 16 * g8 + e < row); const float a = valid ? __builtin_amdgcn_exp2f(p0[r] + L0[r] + s0) : 0.f; s0 += L0[r]; p0[r] = a; }
                        { const bool valid = !nm || (kl + 32 + 16 * g8 + e < row); const float a = valid ? __builtin_amdgcn_exp2f(p1[r] + L1[r] + s1) : 0.f; s1 += L1[r]; p1[r] = a; } }
                }
                T += run;
            } else {
                const bool nm = (MODE == M_FOX) ? (key0 + 63 > w0) : ((MODE == M_MOBA) ? (i < 4 && key0 + 63 > w0) : false);
                bool rowsel = true;
                if (MODE == M_MOBA) { if (i >= 4) { const int j = (i - 4) >> 2; rowsel = (i1 == j) | (i2 == j) | (i3 == j); } }
                const LAS float* cl = (const LAS float*)(buf + KB_BYTES + VT_BYTES) + 8 * hi;
                float corr;
                if (nm) {
                    float mx = -INFINITY;
#pragma unroll
                    for (int r = 0; r < 16; ++r) {
                        float t0 = p0[r] * C2, t1 = p1[r] * C2;
                        if (MODE == M_FOX) { t0 += cq2 - cl[16 * (r >> 3) + (r & 7)]; t1 += cq2 - cl[32 + 16 * (r >> 3) + (r & 7)]; }
                        const int k_0 = kl + 16 * (r >> 3) + (r & 7);
                        t0 = (k_0 <= row) ? t0 : -INFINITY; t1 = (k_0 + 32 <= row) ? t1 : -INFINITY;
                        p0[r] = t0; p1[r] = t1; mx = fmaxf(mx, fmaxf(t0, t1));
                    }
                    mx = fmaxf(mx, __shfl_xor(mx, 32));
                    float m_new;
                    if (MODE == M_FOX) { m_run = fmaxf(m_run, mx); m_new = fminf(qb2, 48.0f); corr = 1.0f; }
                    else { m_new = fmaxf(m_run, mx); corr = __builtin_amdgcn_exp2f(m_run - m_new); m_run = m_new; }
                    float sum = 0.f;
#pragma unroll
                    for (int r = 0; r < 16; ++r) { const float e0 = __builtin_amdgcn_exp2f(p0[r] - m_new), e1 = __builtin_amdgcn_exp2f(p1[r] - m_new); sum += e0 + e1; p0[r] = e0; p1[r] = e1; }
                    l_run = l_run * corr + sum;
                } else {
                    if (MODE == M_FOX) {
                        typedef float f32x2 __attribute__((ext_vector_type(2)));
                        const float base = cq2 - fminf(qb2, 48.0f); const f32x2 basev = (f32x2){base, base}, c2v = (f32x2){C2, C2};
                        f32x2 sa = (f32x2){0.f, 0.f}, sb = (f32x2){0.f, 0.f};
#pragma unroll
                        for (int r = 0; r < 16; r += 2) {
                            const f32x2 ca = *(const LAS f32x2*)(cl + 16 * (r >> 3) + (r & 7)), cb = *(const LAS f32x2*)(cl + 32 + 16 * (r >> 3) + (r & 7));
                            const f32x2 ta = (f32x2){p0[r], p0[r + 1]} * c2v + (basev - ca), tb = (f32x2){p1[r], p1[r + 1]} * c2v + (basev - cb);
                            const f32x2 ea = (f32x2){__builtin_amdgcn_exp2f(ta.x), __builtin_amdgcn_exp2f(ta.y)}, eb = (f32x2){__builtin_amdgcn_exp2f(tb.x), __builtin_amdgcn_exp2f(tb.y)};
                            sa += ea; sb += eb; p0[r] = ea.x; p0[r + 1] = ea.y; p1[r] = eb.x; p1[r + 1] = eb.y;
                        }
                        corr = 1.0f; l_run += (sa.x + sa.y) + (sb.x + sb.y);
                    } else {
                    float mx = -INFINITY;
#pragma unroll
                    for (int r = 0; r < 16; ++r) mx = fmaxf(mx, fmaxf(p0[r], p1[r]));
                    mx *= C2;
                    if (MODE == M_MOBA) mx = rowsel ? mx : -INFINITY;
                    mx = fmaxf(mx, __shfl_xor(mx, 32));
                    const float m_new = fmaxf(m_run, mx); corr = __builtin_amdgcn_exp2f(m_run - m_new); m_run = m_new;
                    const float off = (MODE == M_MOBA && !rowsel) ? -INFINITY : -m_new;
                    float s0 = 0.f, s1 = 0.f;
#pragma unroll
                    for (int r = 0; r < 16; ++r) { const float e0 = __builtin_amdgcn_exp2f(fmaf(p0[r], C2, off)), e1 = __builtin_amdgcn_exp2f(fmaf(p1[r], C2, off)); s0 += e0; s1 += e1; p0[r] = e0; p1[r] = e1; }
                    l_run = l_run * corr + (s0 + s1);
                    }
                }
                if (__any(corr != 1.0f)) {
#pragma unroll
                    for (int r = 0; r < 16; ++r) { o0[r] *= corr; o1[r] *= corr; }
                }
            }
            pkP0 = pack8(p0, 0); pkP1 = pack8(p0, 8); pkP2 = pack8(p1, 0); pkP3 = pack8(p1, 8);
        } else {
        if (prev_active) {
            const LAS unsigned char* vb = lds + prevbuf + KB_BYTES + r32 * VT_STRIDE + hi * 16;
#define PVS(s, pk) do { const bf16x8 a0_ = *(const LAS bf16x8*)(vb + (s) * 32), a1_ = *(const LAS bf16x8*)(vb + 32 * VT_STRIDE + (s) * 32); \
            o0 = __builtin_amdgcn_mfma_f32_32x32x16_bf16(a0_, pk, o0, 0, 0, 0); o1 = __builtin_amdgcn_mfma_f32_32x32x16_bf16(a1_, pk, o1, 0, 0, 0); } while (0)
            PVS(0, pkP0); PVS(1, pkP1); PVS(2, pkP2); PVS(3, pkP3);
#undef PVS
        }
        }
        prev_active = active; prevbuf = 1 * BUF_BYTES;
        if (i + 1 < NT) STORET(2, k3, v3, c3);
        if (MODE == M_SB || MODE == M_FOX) {
            bool vote;
            if (MODE == M_SB) vote = __all(T < -151.0f) != 0;
            else { const float cn = (key0 > 0) ? A.cf[key0 - 1] * LOG2E : 0.f; vote = __all(qb2 + cq2 - cn < m_run - 151.0f) != 0; }
            if (lane == 0) ((LAS unsigned*)(lds + VOTE_OFF))[(i & 1) * 8 + wid] = (active && vote) ? 1u : 0u;
        }
        __syncthreads();
        if (MODE == M_SB || MODE == M_FOX) {
            const LAS unsigned* vv = (const LAS unsigned*)(lds + VOTE_OFF) + (i & 1) * 8;
            const unsigned all8 = (vv[0] & vv[1]) & (vv[2] & vv[3]) & (vv[4] & vv[5]) & (vv[6] & vv[7]);
            if (all8) break;
        }
        }
        { const int i = i0 + 2; if (i >= NT) break;
        const int key0 = KEY0(i);
        if (i + 3 < NT) LOADT(i + 3, k3, v3, c3);
        LAS unsigned char* buf = lds + 2 * BUF_BYTES;
        bool active;
        if (MODE == M_XA) active = true;
        else if (MODE == M_MOBA) active = (i < 4) ? (key0 <= w0 + 31) : (((wmask >> ((i - 4) >> 2)) & 1ull) != 0ull);
        else active = key0 <= w0 + 31;
        if (active) {
            f32x16 p0, p1;
#pragma unroll
            for (int r = 0; r < 16; ++r) { p0[r] = 0.f; p1[r] = 0.f; }
            LAS unsigned char* kb = buf + kperm * 16 + hi * 1024;
#pragma unroll
            for (int d0 = 0; d0 < 4; ++d0) {
                const bf16x8 kf0 = *(const LAS bf16x8*)(kb + d0 * 2048), kf1 = *(const LAS bf16x8*)(kb + d0 * 2048 + 512);
                p0 = __builtin_amdgcn_mfma_f32_32x32x16_bf16(kf0, qr[d0], p0, 0, 0, 0);
                p1 = __builtin_amdgcn_mfma_f32_32x32x16_bf16(kf1, qr[d0], p1, 0, 0, 0);
            }
        if (prev_active) {
            const LAS unsigned char* vb = lds + prevbuf + KB_BYTES + r32 * VT_STRIDE + hi * 16;
#define PVS(s, pk) do { const bf16x8 a0_ = *(const LAS bf16x8*)(vb + (s) * 32), a1_ = *(const LAS bf16x8*)(vb + 32 * VT_STRIDE + (s) * 32); \
            o0 = __builtin_amdgcn_mfma_f32_32x32x16_bf16(a0_, pk, o0, 0, 0, 0); o1 = __builtin_amdgcn_mfma_f32_32x32x16_bf16(a1_, pk, o1, 0, 0, 0); } while (0)
            PVS(0, pkP0); PVS(1, pkP1); PVS(2, pkP2); PVS(3, pkP3);
#undef PVS
        }
            const int kl = key0 + 8 * hi;
            if (MODE == M_SB) {
                const bool nm = key0 + 63 >= w0;
                f32x16 L0, L1; float gt[4];
#pragma unroll
                for (int g = 0; g < 4; ++g) gt[g] = 0.f;
#pragma unroll
                for (int r = 0; r < 16; ++r) {
                    { const float z2 = p0[r] * C2; p0[r] = z2; float l1 = -(fmaxf(z2, 0.f) + __builtin_amdgcn_logf(1.0f + __builtin_amdgcn_exp2f(-fabsf(z2))));
                      if (nm && !(kl + 16 * (r >> 3) + (r & 7) < row)) l1 = 0.f; L0[r] = l1; gt[r >> 3] += l1; }
                    { const float z2 = p1[r] * C2; p1[r] = z2; float l1 = -(fmaxf(z2, 0.f) + __builtin_amdgcn_logf(1.0f + __builtin_amdgcn_exp2f(-fabsf(z2))));
                      if (nm && !(kl + 32 + 16 * (r >> 3) + (r & 7) < row)) l1 = 0.f; L1[r] = l1; gt[2 + (r >> 3)] += l1; }
                }
                float pt[4], after[4]; float run = 0.f;
#pragma unroll
                for (int g = 0; g < 4; ++g) pt[g] = __shfl_xor(gt[g], 32);
#pragma unroll
                for (int g = 3; g >= 0; --g) { after[g] = run + (hi ? 0.f : pt[g]); run += gt[g] + pt[g]; }
#pragma unroll
                for (int g8 = 1; g8 >= 0; --g8) {
                    float s0 = T + after[g8], s1 = T + after[2 + g8];
#pragma unroll
                    for (int e = 7; e >= 0; --e) { const int r = 8 * g8 + e;
                        { const bool valid = !nm || (kl + 16 * g8 + e < row); const float a = valid ? __builtin_amdgcn_exp2f(p0[r] + L0[r] + s0) : 0.f; s0 += L0[r]; p0[r] = a; }
                        { const bool valid = !nm || (kl + 32 + 16 * g8 + e < row); const float a = valid ? __builtin_amdgcn_exp2f(p1[r] + L1[r] + s1) : 0.f; s1 += L1[r]; p1[r] = a; } }
                }
                T += run;
            } else {
                const bool nm = (MODE == M_FOX) ? (key0 + 63 > w0) : ((MODE == M_MOBA) ? (i < 4 && key0 + 63 > w0) : false);
                bool rowsel = true;
                if (MODE == M_MOBA) { if (i >= 4) { const int j = (i - 4) >> 2; rowsel = (i1 == j) | (i2 == j) | (i3 == j); } }
                const LAS float* cl = (const LAS float*)(buf + KB_BYTES + VT_BYTES) + 8 * hi;
                float corr;
                if (nm) {
                    float mx = -INFINITY;
#pragma unroll
                    for (int r = 0; r < 16; ++r) {
                        float t0 = p0[r] * C2, t1 = p1[r] * C2;
                        if (MODE == M_FOX) { t0 += cq2 - cl[16 * (r >> 3) + (r & 7)]; t1 += cq2 - cl[32 + 16 * (r >> 3) + (r & 7)]; }
                        const int k_0 = kl + 16 * (r >> 3) + (r & 7);
                        t0 = (k_0 <= row) ? t0 : -INFINITY; t1 = (k_0 + 32 <= row) ? t1 : -INFINITY;
                        p0[r] = t0; p1[r] = t1; mx = fmaxf(mx, fmaxf(t0, t1));
                    }
                    mx = fmaxf(mx, __shfl_xor(mx, 32));
                    float m_new;
                    if (MODE == M_FOX) { m_run = fmaxf(m_run, mx); m_new = fminf(qb2, 48.0f); corr = 1.0f; }
                    else { m_new = fmaxf(m_run, mx); corr = __builtin_amdgcn_exp2f(m_run - m_new); m_run = m_new; }
                    float sum = 0.f;
#pragma unroll
                    for (int r = 0; r < 16; ++r) { const float e0 = __builtin_amdgcn_exp2f(p0[r] - m_new), e1 = __builtin_amdgcn_exp2f(p1[r] - m_new); sum += e0 + e1; p0[r] = e0; p1[r] = e1; }
                    l_run = l_run * corr + sum;
                } else {
                    if (MODE == M_FOX) {
                        typedef float f32x2 __attribute__((ext_vector_type(2)));
                        const float base = cq2 - fminf(qb2, 48.0f); const f32x2 basev = (f32x2){base, base}, c2v = (f32x2){C2, C2};
                        f32x2 sa = (f32x2){0.f, 0.f}, sb = (f32x2){0.f, 0.f};
#pragma unroll
                        for (int r = 0; r < 16; r += 2) {
                            const f32x2 ca = *(const LAS f32x2*)(cl + 16 * (r >> 3) + (r & 7)), cb = *(const LAS f32x2*)(cl + 32 + 16 * (r >> 3) + (r & 7));
                            const f32x2 ta = (f32x2){p0[r], p0[r + 1]} * c2v + (basev - ca), tb = (f32x2){p1[r], p1[r + 1]} * c2v + (basev - cb);
                            const f32x2 ea = (f32x2){__builtin_amdgcn_exp2f(ta.x), __builtin_amdgcn_exp2f(ta.y)}, eb = (f32x2){__builtin_amdgcn_exp2f(tb.x), __builtin_amdgcn_exp2f(tb.y)};
                            sa += ea; sb += eb; p0[r] = ea.x; p0[r + 1] = ea.y; p1[r] = eb.x; p1[r + 1] = eb.y;
                        }
                        corr = 1.0f; l_run += (sa.x + sa.y) + (sb.x + sb.y);
                    } else {
                    float mx = -INFINITY;
#pragma unroll
                    for (int r = 0; r < 16; ++r) mx = fmaxf(mx, fmaxf(p0[r], p1[r]));
                    mx *= C2;
                    if (MODE == M_MOBA) mx = rowsel ? mx : -INFINITY;
                    mx = fmaxf(mx, __shfl_xor(mx, 32));
                    const float m_new = fmaxf(m_run, mx); corr = __builtin_amdgcn_exp2f(m_run - m_new); m_run = m_new;
                    const float off = (MODE == M_MOBA && !rowsel) ? -INFINITY : -m_new;
                    float s0 = 0.f, s1 = 0.f;
#pragma unroll
                    for (int r = 0; r < 16; ++r) { const float e0 = __builtin_amdgcn_exp2f(fmaf(p0[r], C2, off)), e1 = __builtin_amdgcn_exp2f(fmaf(p1[r], C2, off)); s0 += e0; s1 += e1; p0[r] = e0; p1[r] = e1; }
                    l_run = l_run * corr + (s0 + s1);
                    }
                }
                if (__any(corr != 1.0f)) {
#pragma unroll
                    for (int r = 0; r < 16; ++r) { o0[r] *= corr; o1[r] *= corr; }
                }
            }
            pkP0 = pack8(p0, 0); pkP1 = pack8(p0, 8); pkP2 = pack8(p1, 0); pkP3 = pack8(p1, 8);
        } else {
        if (prev_active) {
            const LAS unsigned char* vb = lds + prevbuf + KB_BYTES + r32 * VT_STRIDE + hi * 16;
#define PVS(s, pk) do { const bf16x8 a0_ = *(const LAS bf16x8*)(vb + (s) * 32), a1_ = *(const LAS bf16x8*)(vb + 32 * VT_STRIDE + (s) * 32); \
            o0 = __builtin_amdgcn_mfma_f32_32x32x16_bf16(a0_, pk, o0, 0, 0, 0); o1 = __builtin_amdgcn_mfma_f32_32x32x16_bf16(a1_, pk, o1, 0, 0, 0); } while (0)
            PVS(0, pkP0); PVS(1, pkP1); PVS(2, pkP2); PVS(3, pkP3);
#undef PVS
        }
        }
        prev_active = active; prevbuf = 2 * BUF_BYTES;
        if (i + 1 < NT) STORET(0, k1, v1, c1);
        if (MODE == M_SB || MODE == M_FOX) {
            bool vote;
            if (MODE == M_SB) vote = __all(T < -151.0f) != 0;
            else { const float cn = (key0 > 0) ? A.cf[key0 - 1] * LOG2E : 0.f; vote = __all(qb2 + cq2 - cn < m_run - 151.0f) != 0; }
            if (lane == 0) ((LAS unsigned*)(lds + VOTE_OFF))[(i & 1) * 8 + wid] = (active && vote) ? 1u : 0u;
        }
        __syncthreads();
        if (MODE == M_SB || MODE == M_FOX) {
            const LAS unsigned* vv = (const LAS unsigned*)(lds + VOTE_OFF) + (i & 1) * 8;
            const unsigned all8 = (vv[0] & vv[1]) & (vv[2] & vv[3]) & (vv[4] & vv[5]) & (vv[6] & vv[7]);
            if (all8) break;
        }
        }
    }
#undef KEY0
#undef LOADT
#undef STORET
    if (prev_active) {
        const LAS unsigned char* vb = lds + prevbuf + KB_BYTES + r32 * VT_STRIDE + hi * 16;
#define PVS(s, pk) do { const bf16x8 a0_ = *(const LAS bf16x8*)(vb + (s) * 32), a1_ = *(const LAS bf16x8*)(vb + 32 * VT_STRIDE + (s) * 32); \
        o0 = __builtin_amdgcn_mfma_f32_32x32x16_bf16(a0_, pk, o0, 0, 0, 0); o1 = __builtin_amdgcn_mfma_f32_32x32x16_bf16(a1_, pk, o1, 0, 0, 0); } while (0)
        PVS(0, pkP0); PVS(1, pkP1); PVS(2, pkP2); PVS(3, pkP3);
#undef PVS
    }
    float inv = 1.0f;
    if (MODE != M_SB) { const float l = l_run + __shfl_xor(l_run, 32); inv = 1.0f / l; if (MODE == M_MOBA) { if (hi == 0) A.lse[(size_t)row * 32] = m_run + __builtin_amdgcn_logf(l); } }
    bf16_t* op = A.O + (size_t)row * A.ldo + 4 * hi;
#pragma unroll
    for (int g = 0; g < 4; ++g) {
        pg8::store4(op + 8 * g, (f32x4){o0[4 * g] * inv, o0[4 * g + 1] * inv, o0[4 * g + 2] * inv, o0[4 * g + 3] * inv});
        pg8::store4(op + 32 + 8 * g, (f32x4){o1[4 * g] * inv, o1[4 * g + 1] * inv, o1[4 * g + 2] * inv, o1[4 * g + 3] * inv});
    }
}

__device__ __forceinline__ void moba_routed_unit(LAS unsigned char* lds, const bf16_t* Qh, const bf16_t* Kh, const bf16_t* Vh, const int* selh, bf16_t* parth, float* lseh, int j, int b0, int b1) {
    int tid_ = threadIdx.x; asm volatile("" : "+v"(tid_)); const int tid = tid_, lane = tid & 63, wid = __builtin_amdgcn_readfirstlane(tid >> 6), r32 = lane & 31, hi = lane >> 5;
    LAS int* list = (LAS int*)(lds + 71680); LAS int* cnt = (LAS int*)(lds + 71680 + 16384);
    if (tid == 0) *cnt = 0;
    u32x4 kk[4], vv[4];
#pragma unroll
    for (int tl = 0; tl < 4; ++tl) { const size_t ro = (size_t)(256 * j + 64 * tl + lane) * 1024 + wid * 8; kk[tl] = *(const u32x4*)(Kh + ro); vv[tl] = *(const u32x4*)(Vh + ro); }
    __syncthreads();
    typedef int i32x4 __attribute__((ext_vector_type(4)));
    for (int t = 256 * b0 + tid; t < 256 * b1; t += 512) {
        const i32x4 s = *(const i32x4*)(selh + (size_t)t * 4);
        if (s.x == j) { const int p = __hip_atomic_fetch_add(cnt, 1, __ATOMIC_RELAXED, __HIP_MEMORY_SCOPE_WORKGROUP); list[p] = t; }
        if (s.y == j) { const int p = __hip_atomic_fetch_add(cnt, 1, __ATOMIC_RELAXED, __HIP_MEMORY_SCOPE_WORKGROUP); list[p] = t | (1 << 16); }
        if (s.z == j) { const int p = __hip_atomic_fetch_add(cnt, 1, __ATOMIC_RELAXED, __HIP_MEMORY_SCOPE_WORKGROUP); list[p] = t | (2 << 16); }
    }
#pragma unroll
    for (int tl = 0; tl < 4; ++tl) { LAS unsigned char* bb_ = lds + tl * BUF_BYTES; *(LAS u32x4*)(bb_ + wid * 1024 + lane * 16) = kk[tl];
        LAS unsigned short* vt_ = (LAS unsigned short*)(bb_ + KB_BYTES + (8 * wid) * VT_STRIDE + lane * 2); const u32x4 vreg = vv[tl];
        vt_[0 * 72] = (unsigned short)(vreg.x & 0xffffu); vt_[1 * 72] = (unsigned short)(vreg.x >> 16); vt_[2 * 72] = (unsigned short)(vreg.y & 0xffffu); vt_[3 * 72] = (unsigned short)(vreg.y >> 16);
        vt_[4 * 72] = (unsigned short)(vreg.z & 0xffffu); vt_[5 * 72] = (unsigned short)(vreg.z >> 16); vt_[6 * 72] = (unsigned short)(vreg.w & 0xffffu); vt_[7 * 72] = (unsigned short)(vreg.w >> 16); }
    __syncthreads();
    const int n = *cnt;
    const int kperm = (r32 & ~15) | (r32 & 3) | ((r32 & 4) << 1) | ((r32 & 8) >> 1);
    for (int g = wid; g * 32 < n; g += 8) {
        const int mi = g * 32 + r32; const bool valid = mi < n; const int e = list[valid ? mi : 0]; const int t = e & 0xffff, slot = e >> 16;
        bf16x8 qr[4];
#pragma unroll
        for (int d0 = 0; d0 < 4; ++d0) qr[d0] = *(const bf16x8*)(Qh + (size_t)t * 1024 + d0 * 16 + hi * 8);
        f32x16 o0, o1;
#pragma unroll
        for (int r = 0; r < 16; ++r) { o0[r] = 0.f; o1[r] = 0.f; }
        float m_run = -1e30f, l_run = 0.f;
#pragma unroll 1
        for (int tl = 0; tl < 4; ++tl) {
            LAS unsigned char* buf = lds + tl * BUF_BYTES;
            f32x16 p0, p1;
#pragma unroll
            for (int r = 0; r < 16; ++r) { p0[r] = 0.f; p1[r] = 0.f; }
            LAS unsigned char* kb = buf + kperm * 16 + hi * 1024;
#pragma unroll
            for (int d0 = 0; d0 < 4; ++d0) {
                const bf16x8 kf0 = *(const LAS bf16x8*)(kb + d0 * 2048), kf1 = *(const LAS bf16x8*)(kb + d0 * 2048 + 512);
                p0 = __builtin_amdgcn_mfma_f32_32x32x16_bf16(kf0, qr[d0], p0, 0, 0, 0);
                p1 = __builtin_amdgcn_mfma_f32_32x32x16_bf16(kf1, qr[d0], p1, 0, 0, 0);
            }
            float mx = -INFINITY;
#pragma unroll
            for (int r = 0; r < 16; ++r) mx = fmaxf(mx, fmaxf(p0[r], p1[r]));
            mx *= C2; mx = fmaxf(mx, __shfl_xor(mx, 32));
            const float m_new = fmaxf(m_run, mx), corr = __builtin_amdgcn_exp2f(m_run - m_new); m_run = m_new;
            float s0 = 0.f, s1 = 0.f;
#pragma unroll
            for (int r = 0; r < 16; ++r) { const float e0 = __builtin_amdgcn_exp2f(fmaf(p0[r], C2, -m_new)), e1 = __builtin_amdgcn_exp2f(fmaf(p1[r], C2, -m_new)); s0 += e0; s1 += e1; p0[r] = e0; p1[r] = e1; }
            l_run = l_run * corr + (s0 + s1);
            if (__any(corr != 1.0f)) {
#pragma unroll
                for (int r = 0; r < 16; ++r) { o0[r] *= corr; o1[r] *= corr; }
            }
            const bf16x8 pk0 = pack8(p0, 0), pk1 = pack8(p0, 8), pk2 = pack8(p1, 0), pk3 = pack8(p1, 8);
            const LAS unsigned char* vb = buf + KB_BYTES + r32 * VT_STRIDE + hi * 16;
#define PVS(s, pk) do { const bf16x8 a0_ = *(const LAS bf16x8*)(vb + (s) * 32), a1_ = *(const LAS bf16x8*)(vb + 32 * VT_STRIDE + (s) * 32); \
            o0 = __builtin_amdgcn_mfma_f32_32x32x16_bf16(a0_, pk, o0, 0, 0, 0); o1 = __builtin_amdgcn_mfma_f32_32x32x16_bf16(a1_, pk, o1, 0, 0, 0); } while (0)
            PVS(0, pk0); PVS(1, pk1); PVS(2, pk2); PVS(3, pk3);
#undef PVS
        }
        const float l = l_run + __shfl_xor(l_run, 32), inv = 1.0f / l;
        if (valid) {
            bf16_t* op = parth + ((size_t)t * 32 + slot) * 64 + 4 * hi;
#pragma unroll
            for (int g4 = 0; g4 < 4; ++g4) {
                pg8::store4(op + 8 * g4, (f32x4){o0[4 * g4] * inv, o0[4 * g4 + 1] * inv, o0[4 * g4 + 2] * inv, o0[4 * g4 + 3] * inv});
                pg8::store4(op + 32 + 8 * g4, (f32x4){o1[4 * g4] * inv, o1[4 * g4 + 1] * inv, o1[4 * g4 + 2] * inv, o1[4 * g4 + 3] * inv});
            }
            if (hi == 0) lseh[(size_t)t * 32 + slot] = m_run + __builtin_amdgcn_logf(l);
        }
    }
    __syncthreads();
}
}
using pg8::bf16_t; using pg8::f32x4; using pg8::u32x4;
constexpr int S = 16384, D = 1024, DFF = 2816, NUP = 5632, MEM = 256;
constexpr size_t MiB = 1u << 20;
constexpr size_t WS_SSQ = 0;
constexpr size_t WS_KPART = 512 * 1024;
constexpr size_t WS_KMX = 1 * MiB;
constexpr size_t WS_WFT = 1 * MiB + 196608;
constexpr size_t WS_DUMMY = 1 * MiB + 131072;
constexpr size_t WS_CNT = 1 * MiB + 4096;
constexpr size_t WS_BAR = 1 * MiB + 65536;
constexpr size_t WS_LOGF = 2 * MiB, WS_CF = 3 * MiB;
constexpr size_t WS_ROPEC = 4 * MiB, WS_ROPES = 6 * MiB;
constexpr size_t WS_MN = 8 * MiB;
constexpr size_t WS_MKV = 9 * MiB;
constexpr size_t WS_XQ = 10 * MiB, WS_XO = 18 * MiB;
constexpr size_t WS_WIN0 = 26 * MiB, WS_WOUT0 = 32 * MiB, WS_WIN1 = 34 * MiB, WS_WOUT1 = WS_WIN1 + 3328 * 1024 * 2, WS_WXQ = WS_WOUT1 + 2 * MiB, WS_WXKV = WS_WXQ + 1 * MiB, WS_WXO = WS_WXKV + 2 * MiB,
                 WS_WUP = WS_WXO + 1 * MiB, WS_WDN = WS_WUP + 22 * MiB, WS_WEND = WS_WDN + 11 * MiB;
static_assert(WS_WEND <= 80 * MiB, "weights");
constexpr size_t WS_XB = 81 * MiB;
constexpr size_t WS_SEL = 242 * MiB, WS_LSE = 244 * MiB;
constexpr size_t WS_Q = 114 * MiB, WS_K = 146 * MiB, WS_V = 178 * MiB, WS_O = 210 * MiB, WS_ACT = 114 * MiB, WS_END = 246 * MiB;

#ifndef SC_MIX0
#define SC_MIX0 1.0f
#endif
#ifndef SC_MIX1
#define SC_MIX1 1.0f
#endif
#ifndef SC_XA
#define SC_XA 1.0f
#endif
#ifndef SC_FFN
#define SC_FFN 1.0f
#endif
#define RLX_AGENT __ATOMIC_RELAXED, __HIP_MEMORY_SCOPE_AGENT
#define XB_TMO      128
#define XB_XCNT(j)  (256  + 64 * (j))
#define XB_XSUB(j)  (1280 + 64 * (j))
#define XB_XGEN(j)  (2304 + 64 * (j))
#define XB_TOP      3328
#define XB_TOPGEN   3392
#define XCD_BAR_WORDS 3456
#define XB_SPIN_CAP (1u << 18)

__device__ __forceinline__ unsigned xb_ld(unsigned* p)              { return __hip_atomic_load(p, __ATOMIC_RELAXED, __HIP_MEMORY_SCOPE_AGENT); }
__device__ __forceinline__ unsigned xb_add(unsigned* p, unsigned v) { return __hip_atomic_fetch_add(p, v, __ATOMIC_RELAXED, __HIP_MEMORY_SCOPE_AGENT); }
__device__ __forceinline__ unsigned xb_xcc_id() { return (unsigned)__builtin_amdgcn_s_getreg((3 << 11) | 20) & 0xFu; }
#define XB_SPIN(cond, bar) do { unsigned _sp = 0; while (cond) { __builtin_amdgcn_s_sleep(1); \
    if ((++_sp & 255u) == 0u) { if (xb_ld(&(bar)[XB_TMO])) break; if (_sp > XB_SPIN_CAP) { atomicAdd(&(bar)[XB_TMO], 1u); break; } } } } while (0)

struct XcdBarrier {
    unsigned* bar; unsigned x;
    volatile LAS unsigned* st;
};

__device__ __forceinline__ XcdBarrier xcd_barrier_post(unsigned* bar, volatile LAS unsigned* st) {
    XcdBarrier b; b.bar = bar; b.x = xb_xcc_id(); b.st = st;
    if (threadIdx.x == 0) (void)xb_add(&bar[XB_XCNT(b.x)], 1u);
    return b;
}
__device__ __forceinline__ void xcd_barrier_complete(unsigned* bar, unsigned x, unsigned& nloc, unsigned& nx) {
    const unsigned G = gridDim.x * gridDim.y * gridDim.z;
    unsigned sum, cnt, mine, sp = 0u;
    for (;;) {
        sum = 0u; cnt = 0u; mine = 0u;
#pragma unroll
        for (unsigned j = 0; j < 16; ++j) { const unsigned c = xb_ld(&bar[XB_XCNT(j)]); sum += c; cnt += (c > 0u) ? 1u : 0u; mine = (j == x) ? c : mine; }
        if (sum == G) break;
        __builtin_amdgcn_s_sleep(1);
        if ((++sp & 255u) == 0u) { if (xb_ld(&bar[XB_TMO])) break; if (sp > XB_SPIN_CAP) { atomicAdd(&bar[XB_TMO], 1u); break; } }
    }
    nloc = mine > 0u ? mine : 1u; nx = cnt > 0u ? cnt : 1u;
}

__device__ __forceinline__ void xcd_barrier(const XcdBarrier& b) {
    asm volatile("s_waitcnt vmcnt(0)" ::: "memory");
    __syncthreads();
    if (threadIdx.x == 0) {
        unsigned* bar = b.bar;
        __builtin_amdgcn_s_waitcnt(0);
        unsigned nloc = b.st[0], nx = b.st[1];
        if (nloc == 0u) { xcd_barrier_complete(bar, b.x, nloc, nx); b.st[0] = nloc; b.st[1] = nx; }
        const unsigned old = xb_add(&bar[XB_XSUB(b.x)], 1u);
        const unsigned gen = old / nloc;
        if (old + 1u == (gen + 1u) * nloc) {
            __builtin_amdgcn_fence(__ATOMIC_RELEASE, "agent");
            asm volatile("s_waitcnt vmcnt(0)" ::: "memory");
            const unsigned og = xb_add(&bar[XB_TOP], 1u);
            const unsigned tg = og / nx;
            if (og + 1u == (tg + 1u) * nx) xb_add(&bar[XB_TOPGEN], 1u);
            else XB_SPIN(xb_ld(&bar[XB_TOPGEN]) == tg, bar);
            __builtin_amdgcn_fence(__ATOMIC_ACQUIRE, "agent");
            xb_add(&bar[XB_XGEN(b.x)], 1u);
            asm volatile("s_waitcnt vmcnt(0)" ::: "memory");
        } else {
            XB_SPIN(xb_ld(&bar[XB_XGEN(b.x)]) == gen, bar);
            __builtin_amdgcn_fence(__ATOMIC_ACQUIRE, "agent");
            asm volatile("s_waitcnt vmcnt(0)" ::: "memory");
        }
    }
    __syncthreads();
}

#ifndef REP_OUT
#define REP_OUT 1
#endif
#ifndef REP_XQ
#define REP_XQ 1
#endif
#ifndef REP_XO
#define REP_XO 1
#endif
#ifndef REP_DN
#define REP_DN 1
#endif
#ifndef REP_PRO
#define REP_PRO 1
#endif
#ifndef REP_QKV
#define REP_QKV 1
#endif
#ifndef REP_ATT0
#define REP_ATT0 1
#endif
#ifndef REP_FOX
#define REP_FOX 1
#endif
#ifndef REP_UP
#define REP_UP 1
#endif
#ifndef REP_SYNC
#define REP_SYNC 1
#endif
#ifndef REP_XA
#define REP_XA 1
#endif
struct Args { const float* in[20]; float* out; unsigned char* ws; };

__device__ __forceinline__ unsigned f2bf(float f) { unsigned u = __builtin_bit_cast(unsigned, f); return (u + 0x7fffu + ((u >> 16) & 1u)) >> 16; }
__device__ __forceinline__ unsigned pk2(float lo, float hi) { return f2bf(lo) | (f2bf(hi) << 16); }
__device__ __forceinline__ float wave_sum(float v) {
#pragma unroll
    for (int o = 1; o < 64; o <<= 1) v += __shfl_xor(v, o);
    return v;
}
__device__ __forceinline__ int colmap(int mode, int p) {
    if (mode == 1) { if ((p >= 512 && p < 1024) || (p >= 1536 && p < 2048)) { const int w = p & 63; return (p & ~63) + 32 * ((w >> 4) & 1) + 16 * (w >> 5) + (w & 15); } return p; }
    if (mode == 2) return ((p >> 7) & 1) * 2816 + (p >> 8) * 128 + (p & 127);
    return p;
}
__device__ __forceinline__ void conv_weight(const float* W, int ldw, int K, int Nphys, int Nvalid, int mode, const float* g, bf16_t* WT, LAS float* scr, int gw, int NGW, int lane, int& rot) {
    const int nblk = Nphys / 32, items = (K / 64) * nblk;
    const int g0 = (gw - rot % NGW + NGW) % NGW; rot += items;
    for (int it = g0; it < items; it += NGW) {
        const int kb = it / nblk, nb = it % nblk, k0 = 64 * kb, n0 = 32 * nb;
        const int prow = n0 + (lane & 31); const bool ok = prow < Nvalid; const int col = ok ? colmap(mode, prow) : 0;
        float wv_[32];
#pragma unroll
        for (int i = 0; i < 32; ++i) { const int kk = 2 * i + (lane >> 5); wv_[i] = ok ? W[(size_t)(k0 + kk) * ldw + col] : 0.f; }
#pragma unroll
        for (int i = 0; i < 32; ++i) { const int kk = 2 * i + (lane >> 5); float v = wv_[i]; if (g) v *= g[k0 + kk]; scr[kk * 33 + (lane & 31)] = v; }
        asm volatile("s_waitcnt lgkmcnt(0)" ::: "memory");
        const int c = lane & 7;
#pragma unroll
        for (int j = 0; j < 4; ++j) { const int n = (lane >> 3) + 8 * j; const LAS float* s = scr + (8 * c) * 33 + n;
            u32x4 o; o.x = pk2(s[0 * 33], s[1 * 33]); o.y = pk2(s[2 * 33], s[3 * 33]); o.z = pk2(s[4 * 33], s[5 * 33]); o.w = pk2(s[6 * 33], s[7 * 33]);
            *(u32x4*)(WT + (size_t)(n0 + n) * K + k0 + 8 * c) = o; }
        asm volatile("s_waitcnt lgkmcnt(0)" ::: "memory");
    }
}

template <class Epi>
__device__ __forceinline__ void run_gemm(LAS unsigned char* lds, const bf16_t* A, const bf16_t* Bt, int Mtiles, int N, int K, int a_w1, int a_h, int a_t, const Epi& E, int cshift = 0) {
    pg8::Gemm g{A, Bt, Mtiles * 256, N, K, a_w1, a_h, a_t};
    pg8::StaticOrder So; So.init(Mtiles * 256, N, (int)gridDim.x, (int)blockIdx.x - cshift);
    pg8::gemm_phase<Epi, pg8::StaticOrder, true, true>(lds, g, So, E);
}

template <int MODE>
__device__ __forceinline__ void attn_units(LAS unsigned char* lds, unsigned* counter, int idx0, int nunits, int nheads, int head0, bool head_major, const bf16_t* Q, int ldq, const bf16_t* K, const bf16_t* V, int ldkv, bf16_t* O, int ldo,
                                           const float* cf, const unsigned* kmx, const float* kpart, int* sel = nullptr, float* lse = nullptr) {
    LAS int* slot = (LAS int*)(lds + 147456 - 128);
    for (;;) {
        int idx;
        if (counter) {
            if (threadIdx.x == 0) *slot = (int)__hip_atomic_fetch_add(counter, 1u, __ATOMIC_RELAXED, __HIP_MEMORY_SCOPE_AGENT);
            __syncthreads(); idx = *slot - idx0; __syncthreads();
            if (idx >= nunits) break;
            if (idx < 0) continue;
        } else { idx = (int)blockIdx.x; if (idx >= nunits) break; }
        const int h = head_major ? (nheads - 1 - idx / 64) : (idx % nheads), qb = head_major ? (63 - idx % 64) : (63 - idx / nheads), hh = head0 + h;
        att::AttnArgs a; a.Q = Q + hh * 64; a.ldq = ldq; a.K = K + hh * 64; a.V = V + hh * 64; a.ldkv = ldkv; a.O = O + hh * 64; a.ldo = ldo;
        a.cf = cf ? cf + (size_t)hh * S : nullptr; a.kmax2 = kmx ? (__uint_as_float(kmx[2 * hh]) + __uint_as_float(kmx[2 * hh + 1])) * 1.02f : 0.f;
        a.kpart = kpart ? kpart + (size_t)h * 64 * 256 : nullptr;
        a.sel = sel ? sel + (size_t)h * S * 4 : nullptr; a.lse = lse ? lse + h * 4 + 3 : nullptr;
        if (MODE == att::M_MOBA) { a.O = O + (h * 4 + 3) * 64; }
        att::attn_unit<MODE>(lds, a, qb);
        if (!counter) break;
    }
}

typedef const __attribute__((address_space(4))) char* kargp_t;
__device__ __forceinline__ const void* kin(int i) { size_t o = (size_t)i * 8; asm volatile("" : "+s"(o)); return *(const void* const __attribute__((address_space(4)))*)((kargp_t)__builtin_amdgcn_kernarg_segment_ptr() + o); }
__device__ __forceinline__ unsigned char* wsoff(size_t off) { unsigned char* w = (unsigned char*)kin(21); asm volatile("" : "+s"(off)); return w + off; }
#define INF(i) ((const float*)kin(i))
#define OUTP ((float*)kin(20))
#define WSP(T, off) ((T*)wsoff(off))

#define GSYNC() do { XcdBarrier b_; b_.bar = WSP(unsigned, WS_BAR); b_.x = xb_xcc_id(); b_.st = (volatile LAS unsigned*)(lds + 147456 - 64); xcd_barrier(b_); } while (0)
__global__ void __launch_bounds__(512, 2) fwd_kernel(Args args) {
    extern __shared__ __attribute__((aligned(16))) unsigned char lds_raw[];
    LAS unsigned char* lds = (LAS unsigned char*)lds_raw;
    cg::grid_group grid = cg::this_grid();
    (void)args;
    if (threadIdx.x == 0) { volatile LAS unsigned* st_ = (volatile LAS unsigned*)(lds + 147456 - 64); st_[0] = 0u; st_[1] = 0u; }
#pragma unroll 1
    for (int rep_ = 0; rep_ < REP_PRO; ++rep_) {
        int tid_ = threadIdx.x; asm volatile("" : "+v"(tid_)); const int tid = tid_, lane = tid & 63, wave = __builtin_amdgcn_readfirstlane(tid >> 6);
        const int G = (int)gridDim.x, gw = (int)blockIdx.x * 8 + wave, NGW = G * 8, gt = (int)blockIdx.x * 512 + tid, NGT = G * 512;
        LAS float* scr = (LAS float*)(lds + wave * 16384); int rot = 0;
        conv_weight(INF(7), 3072, 1024, 3072, 3072, 1, INF(3), WSP(bf16_t, WS_WIN0), scr, gw, NGW, lane, rot);
        conv_weight(INF(8), 1024, 1024, 1024, 1024, 0, nullptr, WSP(bf16_t, WS_WOUT0), scr, gw, NGW, lane, rot);
        conv_weight(INF(12), 256, 1024, 256, 256, 0, INF(4), WSP(bf16_t, WS_WXQ), scr, gw, NGW, lane, rot);
#pragma unroll 1
        for (int l = 0; l < 2; ++l) conv_weight(INF(13) + (size_t)l * 1024 * 512, 512, 1024, 512, 512, 0, nullptr, WSP(bf16_t, WS_WXKV) + (size_t)l * 512 * 1024, scr, gw, NGW, lane, rot);
        conv_weight(INF(14), 1024, 256, 1024, 1024, 0, nullptr, WSP(bf16_t, WS_WXO), scr, gw, NGW, lane, rot);
        conv_weight(INF(15), NUP, 1024, NUP, NUP, 2, INF(6), WSP(bf16_t, WS_WUP), scr, gw, NGW, lane, rot);
        conv_weight(INF(18), 1024, DFF, 1024, 1024, 0, nullptr, WSP(bf16_t, WS_WDN), scr, gw, NGW, lane, rot);
        {
            const float* x = INF(0); float* ssq = WSP(float, WS_SSQ); bf16_t* XB = WSP(bf16_t, WS_XB);
            for (int m = gw; m < S; m += NGW) {
                const f32x4* xr = (const f32x4*)(x + (size_t)m * D) + lane; f32x4 v[4]; float s = 0.f;
#pragma unroll
                for (int j = 0; j < 4; ++j) { v[j] = xr[64 * j]; s += (v[j][0] * v[j][0] + v[j][1] * v[j][1]) + (v[j][2] * v[j][2] + v[j][3] * v[j][3]); }
                s = wave_sum(s); if (lane == 0) ssq[m] = s;
                unsigned long long* o8 = (unsigned long long*)(XB + (size_t)m * D) + lane;
#pragma unroll
                for (int j = 0; j < 4; ++j) o8[64 * j] = (unsigned long long)pk2(v[j][0], v[j][1]) | ((unsigned long long)pk2(v[j][2], v[j][3]) << 32);
            }
            for (int idx = gt; idx < 6 * S; idx += NGT) ssq[S + idx] = 0.f;
            for (int idx = gt; idx < 2 * D / 2; idx += NGT) ((unsigned*)(XB - 2 * D))[idx] = 0u;
            for (int idx = gt; idx < 256 * D / 2; idx += NGT) ((unsigned*)(XB + (size_t)S * D))[idx] = 0u;
            if (gt < 32) WSP(unsigned, WS_KMX)[gt] = 0u;
            if (gt < 128) WSP(unsigned, WS_CNT)[gt] = 0u;
            for (int idx = gt; idx < XCD_BAR_WORDS; idx += NGT) WSP(unsigned, WS_BAR)[idx] = 0u;
        }
        {
            const float* mem = INF(1); const float* g_mem = INF(5); bf16_t* MN = WSP(bf16_t, WS_MN);
            for (int m = gw; m < MEM; m += NGW) {
                const f32x4* xr = (const f32x4*)(mem + (size_t)m * D) + lane; f32x4 v[4]; float s = 0.f;
#pragma unroll
                for (int j = 0; j < 4; ++j) { v[j] = xr[64 * j]; s += (v[j][0] * v[j][0] + v[j][1] * v[j][1]) + (v[j][2] * v[j][2] + v[j][3] * v[j][3]); }
                s = wave_sum(s); const float rs = rsqrtf(s * (1.0f / 1024.0f) + 1e-6f);
#pragma unroll
                for (int l = 0; l < 2; ++l) { unsigned long long* o8 = (unsigned long long*)(MN + ((size_t)l * MEM + m) * D) + lane;
#pragma unroll
                    for (int j = 0; j < 4; ++j) { const f32x4 gg = ((const f32x4*)(g_mem + l * 1024) + lane)[64 * j];
                        o8[64 * j] = (unsigned long long)pk2(v[j][0] * rs * gg[0], v[j][1] * rs * gg[1]) | ((unsigned long long)pk2(v[j][2] * rs * gg[2], v[j][3] * rs * gg[3]) << 32); } }
            }
        }
        {
            const int* pos = (const int*)kin(2); float* ropec = WSP(float, WS_ROPEC); float* ropes = WSP(float, WS_ROPES);
            for (int idx = gt; idx < S * 32; idx += NGT) {
                const int t = idx >> 5, i = idx & 31;
                const float invf = (float)exp2(-(double)i * (13.287712379549449 / 32.0));
                const float ang = (float)pos[t] * invf;
                const double a = (double)ang; const double n = rint(a * 0.63661977236758134308); double rr = fma(-n, 1.57079632679489655800e+00, a); rr = fma(-n, 6.12323399573676603587e-17, rr);
                const double r2 = rr * rr;
                const double sn = rr * (1.0 + r2 * (-1.0 / 6 + r2 * (1.0 / 120 + r2 * (-1.0 / 5040 + r2 * (1.0 / 362880 + r2 * (-1.0 / 39916800 + r2 * (1.0 / 6227020800.0)))))));
                const double cs = 1.0 + r2 * (-0.5 + r2 * (1.0 / 24 + r2 * (-1.0 / 720 + r2 * (1.0 / 40320 + r2 * (-1.0 / 3628800 + r2 * (1.0 / 479001600.0 + r2 * (-1.0 / 87178291200.0)))))));
                const int qd = ((int)(long long)n) & 3;
                const double co = (qd == 0) ? cs : (qd == 1) ? -sn : (qd == 2) ? -cs : sn, si = (qd == 0) ? sn : (qd == 1) ? cs : (qd == 2) ? -sn : -cs;
                ropec[idx] = (float)co; ropes[idx] = (float)si;
            }
        }
    }
    grid.sync();
    if (threadIdx.x == 0) (void)xb_add(&WSP(unsigned, WS_BAR)[XB_XCNT(xb_xcc_id())], 1u);
#pragma unroll 1
    for (int layer = 0; layer < 2; ++layer) {
#pragma unroll 1
        for (int rep_ = 0; rep_ < REP_QKV; ++rep_)
        if (layer == 0) {
            { pg8::EpiQKV0 E{WSP(bf16_t, WS_Q), (size_t)(WS_K - WS_Q) / 2, WSP(float, WS_SSQ), WSP(float, WS_ROPEC), WSP(float, WS_ROPES), WSP(float, WS_KPART)};
              run_gemm(lds, WSP(bf16_t, WS_XB), WSP(bf16_t, WS_WIN0), S / 256, 3072, 1024, 64, 128, 256, E); }
        } else {
            {
                int tid_ = threadIdx.x; asm volatile("" : "+v"(tid_)); const int tid = tid_, lane = tid & 63, wv = __builtin_amdgcn_readfirstlane(tid >> 6), r32 = lane & 31, hi = lane >> 5;
                const bf16_t* XBp = WSP(bf16_t, WS_XB); const bf16_t* WF = WSP(bf16_t, WS_WFT); const float* ssq3 = WSP(float, WS_SSQ) + (size_t)3 * S; const float* bfg = INF(10); float* lf = WSP(float, WS_LOGF);
                LAS float* red = (LAS float*)lds;
                for (int rb = (int)blockIdx.x * 64; rb < S; rb += (int)gridDim.x * 64) {
                    att::f32x16 a0, a1;
#pragma unroll
                    for (int r = 0; r < 16; ++r) { a0[r] = 0.f; a1[r] = 0.f; }
                    pg8::bf16x8 af0[8], af1[8], bfr[8];
#pragma unroll
                    for (int s = 0; s < 8; ++s) { const int ko = wv * 128 + 16 * s + 8 * hi;
                        bfr[s] = *(const pg8::bf16x8*)(WF + (size_t)r32 * 1024 + ko); af0[s] = *(const pg8::bf16x8*)(XBp + (size_t)(rb + r32) * 1024 + ko); af1[s] = *(const pg8::bf16x8*)(XBp + (size_t)(rb + 32 + r32) * 1024 + ko); }
#pragma unroll
                    for (int s = 0; s < 8; ++s) { a0 = __builtin_amdgcn_mfma_f32_32x32x16_bf16(af0[s], bfr[s], a0, 0, 0, 0); a1 = __builtin_amdgcn_mfma_f32_32x32x16_bf16(af1[s], bfr[s], a1, 0, 0, 0); }
                    if (r32 < 16) {
#pragma unroll
                        for (int r = 0; r < 16; ++r) { const int i = (r & 3) + 8 * (r >> 2) + 4 * hi; red[(wv * 64 + i) * 16 + r32] = a0[r]; red[(wv * 64 + 32 + i) * 16 + r32] = a1[r]; }
                    }
                    __syncthreads();
                    for (int o = tid; o < 1024; o += 512) { const int tok = o >> 4, h = o & 15; float sum = 0.f;
#pragma unroll
                        for (int w = 0; w < 8; ++w) sum += red[(w * 64 + tok) * 16 + h];
                        const int row = rb + tok; const float x = sum * pg8::rstd_of(ssq3, row) + bfg[h];
                        lf[(size_t)h * S + row] = fminf(x, 0.f) - log1pf(expf(-fabsf(x))); }
                    __syncthreads();
                }
            }
            pg8::EpiBf E{WSP(bf16_t, WS_Q), 1024, WSP(float, WS_SSQ) + (size_t)3 * S, 4, (size_t)(WS_K - WS_Q) / 2, nullptr, nullptr, WSP(unsigned, WS_KMX)};
            run_gemm(lds, WSP(bf16_t, WS_XB), WSP(bf16_t, WS_WIN1), S / 256, 3072, 1024, 64, 128, 256, E);
        }
        GSYNC();
        if (layer == 0) {
            attn_units<att::M_MOBA>(lds, WSP(unsigned, WS_CNT), 0, 512, 8, 8, false, WSP(bf16_t, WS_Q), 1024, WSP(bf16_t, WS_K), WSP(bf16_t, WS_V), 1024, (bf16_t*)OUTP, 2048, nullptr, nullptr, WSP(float, WS_KPART), WSP(int, WS_SEL), WSP(float, WS_LSE));
            attn_units<att::M_SB>(lds, WSP(unsigned, WS_CNT) + 32, 0, 512, 8, 0, false, WSP(bf16_t, WS_Q), 1024, WSP(bf16_t, WS_K), WSP(bf16_t, WS_V), 1024, WSP(bf16_t, WS_O), 1024, nullptr, nullptr, nullptr);
            GSYNC();
            {
                LAS int* slot = (LAS int*)(lds + 147456 - 128);
                for (;;) {
                    if (threadIdx.x == 0) *slot = (int)__hip_atomic_fetch_add(WSP(unsigned, WS_CNT) + 96, 1u, __ATOMIC_RELAXED, __HIP_MEMORY_SCOPE_AGENT);
                    __syncthreads(); const int idx = *slot; __syncthreads();
                    if (idx >= 1248) break;
                    const int h8 = idx & 7; int u = idx >> 3, j = 0;
                    while (u >= ((63 - j + 15) >> 4)) { u -= ((63 - j + 15) >> 4); ++j; }
                    const int b0 = j + 1 + 16 * u, b1 = (b0 + 16 < 64) ? b0 + 16 : 64;
                    att::moba_routed_unit(lds, WSP(bf16_t, WS_Q) + (8 + h8) * 64, WSP(bf16_t, WS_K) + (8 + h8) * 64, WSP(bf16_t, WS_V) + (8 + h8) * 64, WSP(int, WS_SEL) + (size_t)h8 * S * 4,
                                          (bf16_t*)OUTP + h8 * 4 * 64, WSP(float, WS_LSE) + h8 * 4, j, b0, b1);
                }
            }
            GSYNC();
            {
                int tid_ = threadIdx.x; asm volatile("" : "+v"(tid_)); const int tid = tid_, lane = tid & 63, wave = __builtin_amdgcn_readfirstlane(tid >> 6);
                const int gw = (int)blockIdx.x * 8 + wave, NGW = (int)gridDim.x * 8;
                const bf16_t* part = (const bf16_t*)OUTP; const float* lse = WSP(float, WS_LSE); bf16_t* Ob = WSP(bf16_t, WS_O);
                for (int p = gw * 8 + (lane >> 3); p < S * 8; p += NGW * 8) {
                    const int t = p >> 3, h8 = p & 7, ch = lane & 7; const int own = t >> 8, nv = own < 3 ? own : 3;
                    const f32x4 ls = *(const f32x4*)(lse + (size_t)p * 4);
                    float mx = ls[3];
                    if (nv > 0) mx = fmaxf(mx, ls[0]); if (nv > 1) mx = fmaxf(mx, ls[1]); if (nv > 2) mx = fmaxf(mx, ls[2]);
                    const float w0 = nv > 0 ? __builtin_amdgcn_exp2f(ls[0] - mx) : 0.f, w1 = nv > 1 ? __builtin_amdgcn_exp2f(ls[1] - mx) : 0.f, w2 = nv > 2 ? __builtin_amdgcn_exp2f(ls[2] - mx) : 0.f, w3 = __builtin_amdgcn_exp2f(ls[3] - mx);
                    const float wi = 1.0f / ((w0 + w1) + (w2 + w3));
                    float acc8[8];
#pragma unroll
                    for (int e = 0; e < 8; ++e) acc8[e] = 0.f;
#pragma unroll
                    for (int s = 0; s < 4; ++s) {
                        const float w = (s == 0) ? w0 : (s == 1) ? w1 : (s == 2) ? w2 : w3;
                        if (s == 3 || s < nv) {
                            const pg8::bf16x8 v = *(const pg8::bf16x8*)(part + ((size_t)p * 4 + s) * 64 + ch * 8);
#pragma unroll
                            for (int e = 0; e < 8; ++e) acc8[e] += w * att::bf2f(v[e]);
                        }
                    }
                    pg8::store8(Ob + (size_t)t * 1024 + (8 + h8) * 64 + ch * 8, (f32x4){acc8[0] * wi, acc8[1] * wi, acc8[2] * wi, acc8[3] * wi}, (f32x4){acc8[4] * wi, acc8[5] * wi, acc8[6] * wi, acc8[7] * wi});
                }
            }
        } else {
            {
                int tid_ = threadIdx.x; asm volatile("" : "+v"(tid_)); const int tid = tid_, lane = tid & 63, wv = tid >> 6;
                LAS double* sc = (LAS double*)lds;
                for (int wgi = (int)blockIdx.x; wgi < 256; wgi += (int)gridDim.x) {
                    const int h = wgi >> 4, seg = wgi & 15;
                    const float* src = WSP(float, WS_LOGF) + (size_t)h * S;
                    double part = 0.0;
                    for (int i = tid; i < seg * 1024; i += 512) part += (double)src[i];
#pragma unroll
                    for (int o = 32; o >= 1; o >>= 1) part += __shfl_xor(part, o);
                    const int e0 = seg * 1024 + 2 * tid; const double a = (double)src[e0], b = (double)src[e0 + 1];
                    double incl = a + b;
#pragma unroll
                    for (int o = 1; o < 64; o <<= 1) { const double t = __shfl_up(incl, o); if (lane >= o) incl += t; }
                    if (lane == 0) sc[wv] = part;
                    if (lane == 63) sc[8 + wv] = incl;
                    __syncthreads();
                    double before = 0.0;
#pragma unroll
                    for (int k = 0; k < 8; ++k) before += sc[k];
                    for (int k = 0; k < wv; ++k) before += sc[8 + k];
                    const double excl = before + (incl - (a + b));
                    float* dst = WSP(float, WS_CF) + (size_t)h * S + e0;
                    dst[0] = (float)(excl + a); dst[1] = (float)(excl + a + b);
                    __syncthreads();
                }
            }
            GSYNC();
#pragma unroll 1
            for (int rep_ = 0; rep_ < REP_FOX; ++rep_)
            attn_units<att::M_FOX>(lds, WSP(unsigned, WS_CNT) + 64, 0, 1024, 16, 0, true, WSP(bf16_t, WS_Q), 1024, WSP(bf16_t, WS_K), WSP(bf16_t, WS_V), 1024, WSP(bf16_t, WS_O), 1024, WSP(float, WS_CF), WSP(unsigned, WS_KMX), nullptr);
        }
        GSYNC();
#pragma unroll 1
        for (int rep_ = REP_OUT - 1; rep_ >= 0; --rep_)
        { pg8::EpiRes E{(layer == 0 && rep_ == 0) ? INF(0) : (const float*)OUTP, OUTP, WSP(bf16_t, WS_XB), rep_ ? WSP(float, WS_DUMMY) : WSP(float, WS_SSQ) + (size_t)(3 * layer + 1) * S, rep_ ? 0.0f : (layer == 0 ? SC_MIX0 : SC_MIX1)};
          run_gemm(lds, WSP(bf16_t, WS_O), layer == 0 ? WSP(bf16_t, WS_WOUT0) : WSP(bf16_t, WS_WOUT1), S / 256, 1024, 1024, 64, 128, 256, E); }
        GSYNC();
#pragma unroll 1
        for (int rep_ = 0; rep_ < REP_XQ; ++rep_)
        { pg8::EpiBf E{WSP(bf16_t, WS_XQ), 256, WSP(float, WS_SSQ) + (size_t)(3 * layer + 1) * S, 0, 0, nullptr, nullptr, nullptr};
          run_gemm(lds, WSP(bf16_t, WS_XB), WSP(bf16_t, WS_WXQ) + (size_t)layer * 256 * 1024, S / 256, 256, 1024, 64, 128, 256, E); }
        if ((int)blockIdx.x >= 68) {
            int tid_ = threadIdx.x; asm volatile("" : "+v"(tid_)); const int tid = tid_, lane = tid & 63, wave = __builtin_amdgcn_readfirstlane(tid >> 6);
            const int gw = ((int)blockIdx.x - 68) * 8 + wave, NGW = ((int)gridDim.x - 68) * 8, gt = ((int)blockIdx.x - 68) * 512 + tid, NGT = ((int)gridDim.x - 68) * 512;
            LAS float* scr = (LAS float*)(lds + wave * 16384); int rot = 0;
            if (layer == 0) {
            conv_weight(INF(9), 3088, 1024, 3072, 3072, 0, INF(3) + 1024, WSP(bf16_t, WS_WIN1), scr, gw, NGW, lane, rot);
            { const float* wi = INF(9); const float* gm = INF(3) + 1024; bf16_t* wf = WSP(bf16_t, WS_WFT);
              for (int idx = gt; idx < 32 * 1024; idx += NGT) { const int n = idx >> 10, k = idx & 1023; wf[idx] = (bf16_t)f2bf(n < 16 ? gm[k] * wi[(size_t)k * 3088 + 3072 + n] : 0.f); } }
            conv_weight(INF(11), 1024, 1024, 1024, 1024, 0, nullptr, WSP(bf16_t, WS_WOUT1), scr, gw, NGW, lane, rot);
            conv_weight(INF(12) + (size_t)1024 * 256, 256, 1024, 256, 256, 0, INF(4) + 1024, WSP(bf16_t, WS_WXQ) + (size_t)256 * 1024, scr, gw, NGW, lane, rot);
            conv_weight(INF(14) + (size_t)256 * 1024, 1024, 256, 1024, 1024, 0, nullptr, WSP(bf16_t, WS_WXO) + (size_t)1024 * 256, scr, gw, NGW, lane, rot);
            } else {
            conv_weight(INF(15) + (size_t)1024 * NUP, NUP, 1024, NUP, NUP, 2, INF(6) + 1024, WSP(bf16_t, WS_WUP) + (size_t)NUP * 1024, scr, gw, NGW, lane, rot);
            conv_weight(INF(18) + (size_t)DFF * 1024, 1024, DFF, 1024, 1024, 0, nullptr, WSP(bf16_t, WS_WDN) + (size_t)1024 * DFF, scr, gw, NGW, lane, rot);
            }
        }
        if (layer == 0 && (int)blockIdx.x >= 64 && (int)blockIdx.x < 68) {
            const int l = ((int)blockIdx.x - 64) >> 1;
            pg8::EpiBf E2{WSP(bf16_t, WS_MKV) + (size_t)l * MEM * 512, 512, nullptr, 0, 0, nullptr, nullptr, nullptr};
            run_gemm(lds, WSP(bf16_t, WS_MN) + (size_t)l * MEM * D, WSP(bf16_t, WS_WXKV) + (size_t)l * 512 * 1024, 1, 512, 1024, 64, 128, 256, E2, 64 + 2 * l);
        }
        GSYNC();
#pragma unroll 1
        for (int rep_ = 0; rep_ < REP_XA; ++rep_)
        attn_units<att::M_XA>(lds, nullptr, 0, 256, 4, 0, false, WSP(bf16_t, WS_XQ), 256, WSP(bf16_t, WS_MKV) + (size_t)layer * MEM * 512, WSP(bf16_t, WS_MKV) + (size_t)layer * MEM * 512 + 256, 512, WSP(bf16_t, WS_XO), 256, nullptr, nullptr, nullptr);
        GSYNC();
#pragma unroll 1
        for (int rep_ = REP_XO - 1; rep_ >= 0; --rep_)
        { pg8::EpiRes E{OUTP, OUTP, WSP(bf16_t, WS_XB), rep_ ? WSP(float, WS_DUMMY) : WSP(float, WS_SSQ) + (size_t)(3 * layer + 2) * S, rep_ ? 0.0f : SC_XA};
          run_gemm(lds, WSP(bf16_t, WS_XO), WSP(bf16_t, WS_WXO) + (size_t)layer * 1024 * 256, S / 256, 1024, 256, 64, 128, 256, E); }
        GSYNC();
#pragma unroll 1
        for (int rep_ = 0; rep_ < REP_UP; ++rep_)
        { pg8::EpiUpConv E{WSP(bf16_t, WS_ACT), WSP(float, WS_SSQ) + (size_t)(3 * layer + 2) * S, INF(16) + (size_t)layer * 3 * NUP, INF(17) + (size_t)layer * NUP};
          run_gemm(lds, WSP(bf16_t, WS_XB) - 2 * D, WSP(bf16_t, WS_WUP) + (size_t)layer * NUP * 1024, 66, NUP, 1024, 126, 64, 252, E); }
        GSYNC();
#pragma unroll 1
        for (int rep_ = REP_DN - 1; rep_ >= 0; --rep_)
        { pg8::EpiRes E{OUTP, OUTP, layer == 1 ? (bf16_t*)nullptr : WSP(bf16_t, WS_XB), rep_ ? WSP(float, WS_DUMMY) : WSP(float, WS_SSQ) + (size_t)(3 * layer + 3) * S, rep_ ? 0.0f : SC_FFN};
          run_gemm(lds, WSP(bf16_t, WS_ACT), WSP(bf16_t, WS_WDN) + (size_t)layer * 1024 * DFF, S / 256, 1024, DFF, 64, 128, 256, E); }
        GSYNC();
#pragma unroll 1
        for (int rep_ = 1; rep_ < REP_SYNC; ++rep_) { GSYNC(); GSYNC(); GSYNC(); GSYNC(); GSYNC(); }
    }
    {
        int tid_ = threadIdx.x; asm volatile("" : "+v"(tid_)); const int tid = tid_, lane = tid & 63, wave = __builtin_amdgcn_readfirstlane(tid >> 6);
        const int gw = (int)blockIdx.x * 8 + wave, NGW = (int)gridDim.x * 8;
        const float* ssq_fin = WSP(float, WS_SSQ) + (size_t)6 * S; const float* gf = INF(19); float* out = OUTP;
        for (int m = gw; m < S; m += NGW) {
            const float rs = rsqrtf(ssq_fin[m] * (1.0f / 1024.0f) + 1e-6f);
            f32x4* xr = (f32x4*)(out + (size_t)m * D) + lane;
#pragma unroll
            for (int j = 0; j < 4; ++j) { const f32x4 gg = ((const f32x4*)gf + lane)[64 * j]; xr[64 * j] = xr[64 * j] * rs * gg; }
        }
    }
}

extern "C" void kernel_launch(void* const* d_in, const int* in_sizes, int n_in, void* d_out, int out_size, void* d_ws, size_t ws_size, hipStream_t stream) {
    static int grid = 0;
    constexpr int LDSB = 147456;
    if (grid == 0) {
        if (n_in != 20 || out_size != S * D || ws_size < WS_END) { fprintf(stderr, "kernel_launch: unexpected shapes (n_in %d out %d ws %zu)\n", n_in, out_size, ws_size); grid = -1; return; }
        int dev = 0, cus = 0, per = 0;
        hipGetDevice(&dev); hipDeviceGetAttribute(&cus, hipDeviceAttributeMultiprocessorCount, dev);
        hipFuncSetAttribute((const void*)fwd_kernel, hipFuncAttributeMaxDynamicSharedMemorySize, LDSB);
        hipOccupancyMaxActiveBlocksPerMultiprocessor(&per, (const void*)fwd_kernel, 512, LDSB);
        (void)hipGetLastError();
        grid = cus;
        if (per < 1) fprintf(stderr, "kernel_launch: occupancy query reports %d blocks/CU\n", per);
    }
    if (grid < 0) return;
    Args a{};
    for (int i = 0; i < 20; ++i) a.in[i] = (const float*)d_in[i];
    a.out = (float*)d_out; a.ws = (unsigned char*)d_ws;
    void* kargs[] = {&a};
    hipError_t e = hipLaunchCooperativeKernel((const void*)fwd_kernel, dim3(grid), dim3(512), kargs, LDSB, stream);
    if (e != hipSuccess) fprintf(stderr, "cooperative launch failed: %s (grid %d)\n", hipGetErrorString(e), grid);
}
```
